# Optimizing an MI355X kernel written in HIP

```python
import math
import jax
import jax.numpy as jnp
from jax import lax
import numpy as np

D_MODEL = 2048
BATCH = 2
SEQ = 4096
DEPTH = 4
DEC_BATCH = 32
DEC_SEQ = 8
PAST_LEN = 16384
PAGE_SIZE = 128

N_MIXERS = 3
N_A = (DEPTH + 2) // 3
N_B = (DEPTH + 1) // 3
N_C = DEPTH // 3
RMS_EPS = 1e-6
D_FF = 5632
POOL_WINDOWS = (2, 4, 8, 16)
POOL_GROUPS = 4
POOL_GROUP_DIM = D_MODEL // POOL_GROUPS
POOL_BUF = max(POOL_WINDOWS) - 1
HEAD_DIM = 64
N_HEADS = D_MODEL // HEAD_DIM
N_KV_HEADS = 4
GQA_GROUP = N_HEADS // N_KV_HEADS
ATT_DIM = N_HEADS * HEAD_DIM
KV_DIM = N_KV_HEADS * HEAD_DIM
QKV_DIM = ATT_DIM + 2 * KV_DIM
WINDOW = 128
ATT_SCALE = HEAD_DIM ** -0.5
T5_BUCKETS = 32
T5_MAX_DISTANCE = 128
NEG_INF = -1e30
RWKV_N = 64
RWKV_HEADS = D_MODEL // RWKV_N
DECAY_LORA = 96
AAA_LORA = 96
GATE_LORA = 256
GN_EPS = 64e-5

kernel_name = "hybrid_pool_swa_rwkv7_macaron_step"


def rms_norm(x, g):
    xf = x.astype(jnp.float32)
    y = xf * lax.rsqrt(jnp.mean(xf * xf, axis=-1, keepdims=True) + RMS_EPS)
    return (y * g).astype(x.dtype)


def swiglu(x, w_gate, w_up, w_down):
    return (jax.nn.silu(x @ w_gate) * (x @ w_up)) @ w_down


def pool_mix(u, prefix, pos0, w_pool, scale):
    B, T, D = u.shape
    xe = u if prefix is None else jnp.concatenate([prefix.astype(u.dtype), u], axis=1)
    P = xe.shape[1] - T
    cs = jnp.cumsum(xe.astype(jnp.float32), axis=1)
    cs = jnp.concatenate([jnp.zeros((B, 1, D), jnp.float32), cs], axis=1)
    hi = P + 1 + jnp.arange(T)
    pos = pos0 + jnp.arange(T)
    means = []
    for gi, w in enumerate(POOL_WINDOWS):
        cs_g = cs[..., gi * POOL_GROUP_DIM:(gi + 1) * POOL_GROUP_DIM]
        lo = jnp.maximum(hi - w, 0)
        cnt = jnp.minimum(w, pos + 1).astype(jnp.float32)
        means.append((cs_g[:, hi] - cs_g[:, lo]) / cnt[None, :, None])
    mean = jnp.stack(means, axis=2)
    diff = mean - u.reshape(B, T, POOL_GROUPS, POOL_GROUP_DIM).astype(jnp.float32)
    out = jnp.einsum('btgc,gcd->btgd', diff.astype(u.dtype), w_pool).reshape(B, T, D)
    return out * scale, xe[:, -POOL_BUF:]


def t5_bucket(dist):
    dist = jnp.maximum(dist, 0)
    exact = T5_BUCKETS // 2
    ratio = jnp.log(jnp.maximum(dist, 1).astype(jnp.float32) / exact) / math.log(T5_MAX_DISTANCE / exact)
    large = jnp.minimum(exact + (ratio * (T5_BUCKETS - exact)).astype(jnp.int32), T5_BUCKETS - 1)
    return jnp.where(dist < exact, dist, large)


def rel_bias_for(dist, rel_bias):
    b = rel_bias.astype(jnp.float32)[t5_bucket(dist)]
    return jnp.transpose(b, (2, 0, 1)).reshape(N_KV_HEADS, GQA_GROUP, *dist.shape)


def swa_qkv(u, w_qkv, b_qkv):
    B, T, _ = u.shape
    qkv = u @ w_qkv + b_qkv
    q = qkv[..., :ATT_DIM].reshape(B, T, N_KV_HEADS, GQA_GROUP, HEAD_DIM)
    k = qkv[..., ATT_DIM:ATT_DIM + KV_DIM].reshape(B, T, N_KV_HEADS, HEAD_DIM)
    v = qkv[..., ATT_DIM + KV_DIM:].reshape(B, T, N_KV_HEADS, HEAD_DIM)
    return q, k, v


def sink_attend(q, k, v, bias, valid, sinks):
    s = jnp.einsum('...qhgd,...khd->...hgqk', q, k).astype(jnp.float32) * ATT_SCALE + bias
    s = jnp.where(valid, s, NEG_INF)
    sink = sinks.astype(jnp.float32).reshape(N_KV_HEADS, GQA_GROUP, 1, 1)
    m = jnp.maximum(jnp.max(s, axis=-1, keepdims=True), sink)
    p = jnp.exp(s - m)
    p = p / (jnp.sum(p, axis=-1, keepdims=True) + jnp.exp(sink - m))
    return jnp.einsum('...hgqk,...khd->...qhgd', p.astype(v.dtype), v)


def swa_prompt(u, w_qkv, b_qkv, w_o, b_o, sinks, rel_bias):
    B, T, _ = u.shape
    q, k, v = swa_qkv(u, w_qkv, b_qkv)
    nb = T // WINDOW
    qb = q.reshape(B, nb, WINDOW, N_KV_HEADS, GQA_GROUP, HEAD_DIM)

    def band(t):
        tb = t.reshape(B, nb, WINDOW, N_KV_HEADS, HEAD_DIM)
        prev = jnp.concatenate([jnp.zeros_like(tb[:, :1]), tb[:, :-1]], axis=1)
        return jnp.concatenate([prev, tb], axis=2)

    qi = jnp.arange(WINDOW)[:, None]
    kj = jnp.arange(2 * WINDOW)[None, :]
    dist = qi + WINDOW - kj
    blk = jnp.arange(nb)[:, None, None]
    valid = (dist >= 0) & (dist < WINDOW) & ((blk > 0) | (kj >= WINDOW))
    o = sink_attend(qb, band(k), band(v), rel_bias_for(dist, rel_bias), valid[:, None, None], sinks)
    o = o.reshape(B, T, ATT_DIM) @ w_o + b_o
    return o, k[:, -WINDOW:], v[:, -WINDOW:]


def swa_sample(u, k_buf, v_buf, w_qkv, b_qkv, w_o, b_o, sinks, rel_bias):
    B, T, _ = u.shape
    q, k, v = swa_qkv(u, w_qkv, b_qkv)
    kf = jnp.concatenate([k_buf.astype(k.dtype), k], axis=1)
    vf = jnp.concatenate([v_buf.astype(v.dtype), v], axis=1)
    nbuf = k_buf.shape[1]
    qi = jnp.arange(T)[:, None]
    kj = jnp.arange(nbuf + T)[None, :]
    dist = qi + nbuf - kj
    key_pos = PAST_LEN - nbuf + kj
    valid = (dist >= 0) & (dist < WINDOW) & (key_pos >= 0)
    o = sink_attend(q, kf, vf, rel_bias_for(dist, rel_bias), valid, sinks)
    o = o.reshape(B, T, ATT_DIM) @ w_o + b_o
    return o, kf[:, -WINDOW:], vf[:, -WINDOW:]


def rwkv7_mix(u, shift_prev, wkv0, mu, w_r, w_k, w_v, w_o, w0, w1, w2, a0, a1, a2, g1, g2,
              k_k, k_a, r_k, ln_w, ln_b):
    B, T, D = u.shape
    u_prev = jnp.concatenate([shift_prev[:, None].astype(u.dtype), u[:, :-1]], axis=1)
    dx = u_prev - u
    xr, xw, xk, xv, xa, xg = (u + dx * mu[i] for i in range(6))
    r = xr @ w_r
    k = xk @ w_k
    v = xv @ w_v
    logw = -jax.nn.softplus(-(w0 + jnp.tanh(xw @ w1) @ w2).astype(jnp.float32)) - 0.5
    decay = jnp.exp(-jnp.exp(logw))
    a = jax.nn.sigmoid((a0 + (xa @ a1) @ a2).astype(jnp.float32))
    g = jax.nn.sigmoid(xg @ g1) @ g2

    def heads(t):
        return t.astype(jnp.float32).reshape(*t.shape[:-1], RWKV_HEADS, RWKV_N)

    r, k, v, decay, a = heads(r), heads(k), heads(v), heads(decay), heads(a)
    kk = k * heads(k_k)
    kk = kk / jnp.maximum(jnp.sqrt(jnp.sum(kk * kk, axis=-1, keepdims=True)), 1e-12)
    kmod = k * (1.0 + (a - 1.0) * heads(k_a))

    def step(S, inp):
        r_t, w_t, k_t, v_t, kk_t, b_t = inp
        sa = jnp.einsum('bhvk,bhk->bhv', S, -kk_t)
        S = S * w_t[:, :, None, :] + sa[..., None] * b_t[:, :, None, :] + v_t[..., None] * k_t[:, :, None, :]
        return S, jnp.einsum('bhvk,bhk->bhv', S, r_t)

    tm = lambda t: jnp.swapaxes(t, 0, 1)
    S_final, y = lax.scan(step, wkv0.astype(jnp.float32),
                          (tm(r), tm(decay), tm(kmod), tm(v), tm(kk), tm(kk * a)))
    y = tm(y)
    mean = jnp.mean(y, axis=-1, keepdims=True)
    var = jnp.mean(jnp.square(y - mean), axis=-1, keepdims=True)
    y = ((y - mean) * lax.rsqrt(var + GN_EPS)).reshape(B, T, D) * ln_w + ln_b
    y = y + (jnp.sum(r * kmod * r_k, axis=-1, keepdims=True) * v).reshape(B, T, D)
    out = (y.astype(u.dtype) * g) @ w_o
    return out, u[:, -1], S_final


def setup_inputs(seed: int = 0) -> dict:
    keys = iter(jax.random.split(jax.random.key(seed), 48))

    def nrm(shape, scale):
        return jax.random.normal(next(keys), shape, jnp.float32) * scale

    def gain(shape):
        return 1.0 + nrm(shape, 0.05)

    D = D_MODEL
    return {
        "x_prompt": nrm((BATCH, SEQ, D), 1.0),
        "x_sample": nrm((DEC_BATCH, DEC_SEQ, D), 1.0),
        "state_pool": nrm((N_A, DEC_BATCH, POOL_BUF, D), 1.0),
        "cache_win_k": nrm((N_B, DEC_BATCH, WINDOW, N_KV_HEADS, HEAD_DIM), 1.0),
        "cache_win_v": nrm((N_B, DEC_BATCH, WINDOW, N_KV_HEADS, HEAD_DIM), 1.0),
        "state_shift": nrm((N_C, DEC_BATCH, D), 1.0),
        "state_wkv": nrm((N_C, DEC_BATCH, RWKV_HEADS, RWKV_N, RWKV_N), 0.3),
        "norm_ffn1": gain((DEPTH, D)),
        "norm_mix": gain((DEPTH, D)),
        "norm_ffn2": gain((DEPTH, D)),
        "norm_final": gain((D,)),
        "ffn_w_gate": nrm((DEPTH, 2, D, D_FF), D ** -0.5),
        "ffn_w_up": nrm((DEPTH, 2, D, D_FF), D ** -0.5),
        "ffn_w_down": nrm((DEPTH, 2, D_FF, D), D_FF ** -0.5),
        "pool_w": nrm((N_A, POOL_GROUPS, POOL_GROUP_DIM, POOL_GROUP_DIM), POOL_GROUP_DIM ** -0.5),
        "pool_scale": 0.5 + nrm((N_A, D), 0.05),
        "att_w_qkv": nrm((N_B, D, QKV_DIM), D ** -0.5),
        "att_b_qkv": nrm((N_B, QKV_DIM), 0.02),
        "att_w_o": nrm((N_B, ATT_DIM, D), ATT_DIM ** -0.5),
        "att_b_o": nrm((N_B, D), 0.02),
        "att_sinks": nrm((N_B, N_HEADS), 1.0),
        "rel_bias": nrm((T5_BUCKETS, N_HEADS), 0.5),
        "rwkv_mu": jax.random.uniform(next(keys), (N_C, 6, D), jnp.float32),
        "rwkv_w_r": nrm((N_C, D, D), D ** -0.5),
        "rwkv_w_k": nrm((N_C, D, D), D ** -0.5),
        "rwkv_w_v": nrm((N_C, D, D), D ** -0.5),
        "rwkv_w_o": nrm((N_C, D, D), D ** -0.5),
        "rwkv_w0": nrm((N_C, D), 0.5),
        "rwkv_w1": nrm((N_C, D, DECAY_LORA), D ** -0.5),
        "rwkv_w2": nrm((N_C, DECAY_LORA, D), 0.5 * DECAY_LORA ** -0.5),
        "rwkv_a0": nrm((N_C, D), 0.3),
        "rwkv_a1": nrm((N_C, D, AAA_LORA), D ** -0.5),
        "rwkv_a2": nrm((N_C, AAA_LORA, D), 0.5 * AAA_LORA ** -0.5),
        "rwkv_g1": nrm((N_C, D, GATE_LORA), D ** -0.5),
        "rwkv_g2": nrm((N_C, GATE_LORA, D), GATE_LORA ** -0.5),
        "rwkv_k_k": 0.85 + nrm((N_C, D), 0.05),
        "rwkv_k_a": 1.0 + nrm((N_C, D), 0.05),
        "rwkv_r_k": nrm((N_C, RWKV_HEADS, RWKV_N), 0.1),
        "rwkv_ln_w": gain((N_C, D)),
        "rwkv_ln_b": nrm((N_C, D), 0.02),
    }


def reference(x_prompt, x_sample, state_pool, cache_win_k, cache_win_v, state_shift, state_wkv,
              norm_ffn1, norm_mix, norm_ffn2, norm_final, ffn_w_gate, ffn_w_up, ffn_w_down,
              pool_w, pool_scale, att_w_qkv, att_b_qkv, att_w_o, att_b_o, att_sinks, rel_bias,
              rwkv_mu, rwkv_w_r, rwkv_w_k, rwkv_w_v, rwkv_w_o, rwkv_w0, rwkv_w1, rwkv_w2,
              rwkv_a0, rwkv_a1, rwkv_a2, rwkv_g1, rwkv_g2, rwkv_k_k, rwkv_k_a, rwkv_r_k,
              rwkv_ln_w, rwkv_ln_b):
    xp, xs = x_prompt, x_sample
    pool_p, pool_s, wk_p, wv_p, wk_s, wv_s, sh_p, sh_s, wkv_p, wkv_s = ([] for _ in range(10))
    for l in range(DEPTH):
        j = l // N_MIXERS
        kind = l % N_MIXERS
        xp = xp + 0.5 * swiglu(rms_norm(xp, norm_ffn1[l]), ffn_w_gate[l, 0], ffn_w_up[l, 0], ffn_w_down[l, 0])
        xs = xs + 0.5 * swiglu(rms_norm(xs, norm_ffn1[l]), ffn_w_gate[l, 0], ffn_w_up[l, 0], ffn_w_down[l, 0])
        up = rms_norm(xp, norm_mix[l])
        us = rms_norm(xs, norm_mix[l])
        if kind == 0:
            mp, bp = pool_mix(up, None, 0, pool_w[j], pool_scale[j])
            ms, bs = pool_mix(us, state_pool[j], PAST_LEN, pool_w[j], pool_scale[j])
            pool_p.append(bp)
            pool_s.append(bs)
        elif kind == 1:
            att = (att_w_qkv[j], att_b_qkv[j], att_w_o[j], att_b_o[j], att_sinks[j], rel_bias)
            mp, kp, vp = swa_prompt(up, *att)
            ms, ks_, vs_ = swa_sample(us, cache_win_k[j], cache_win_v[j], *att)
            wk_p.append(kp)
            wv_p.append(vp)
            wk_s.append(ks_)
            wv_s.append(vs_)
        else:
            rw = (rwkv_mu[j], rwkv_w_r[j], rwkv_w_k[j], rwkv_w_v[j], rwkv_w_o[j], rwkv_w0[j], rwkv_w1[j],
                  rwkv_w2[j], rwkv_a0[j], rwkv_a1[j], rwkv_a2[j], rwkv_g1[j], rwkv_g2[j], rwkv_k_k[j],
                  rwkv_k_a[j], rwkv_r_k[j], rwkv_ln_w[j], rwkv_ln_b[j])
            zero_shift = jnp.zeros((up.shape[0], D_MODEL), up.dtype)
            zero_wkv = jnp.zeros((up.shape[0], RWKV_HEADS, RWKV_N, RWKV_N), jnp.float32)
            mp, shp, sp = rwkv7_mix(up, zero_shift, zero_wkv, *rw)
            ms, shs, ss = rwkv7_mix(us, state_shift[j], state_wkv[j], *rw)
            sh_p.append(shp)
            sh_s.append(shs)
            wkv_p.append(sp)
            wkv_s.append(ss)
        xp = xp + mp
        xs = xs + ms
        xp = xp + 0.5 * swiglu(rms_norm(xp, norm_ffn2[l]), ffn_w_gate[l, 1], ffn_w_up[l, 1], ffn_w_down[l, 1])
        xs = xs + 0.5 * swiglu(rms_norm(xs, norm_ffn2[l]), ffn_w_gate[l, 1], ffn_w_up[l, 1], ffn_w_down[l, 1])
    y_prompt = rms_norm(xp, norm_final)
    y_sample = rms_norm(xs, norm_final)
    return (y_prompt, y_sample,
            jnp.stack(pool_p), jnp.stack(pool_s),
            jnp.stack(wk_p), jnp.stack(wv_p), jnp.stack(wk_s), jnp.stack(wv_s),
            jnp.stack(sh_p), jnp.stack(sh_s),
            jnp.stack(wkv_p), jnp.stack(wkv_s))
```

```cpp
#include <hip/hip_runtime.h>
#include <cstdio>
#include <cstdint>

#ifndef N_LAUNCH_MODE
#define N_LAUNCH_MODE 0
#endif

#ifndef REP_CONV
#define REP_CONV 1
#endif
#ifndef REP_GU
#define REP_GU 1
#endif
#ifndef REP_DN
#define REP_DN 1
#endif
#ifndef REP_SCAN
#define REP_SCAN 1
#endif
#ifndef REP_CK1
#define REP_CK1 1
#endif
#ifndef REP_OTHER
#define REP_OTHER 1
#endif
#define LAS __attribute__((address_space(3)))
typedef unsigned short bf16_t;
typedef short bf16x8 __attribute__((ext_vector_type(8)));
typedef float f32x4 __attribute__((ext_vector_type(4)));
typedef float f32x2 __attribute__((ext_vector_type(2)));
typedef unsigned u32x4 __attribute__((ext_vector_type(4)));
typedef unsigned u32x2 __attribute__((ext_vector_type(2)));
typedef unsigned long long u64;
constexpr int KS_DN = 11, KSUB_DN = 512, KS_WO = 4, KSUB_WO = 512, KS_POOL = 2, KSUB_POOL = 256;
#ifndef XR_DN
#define XR_DN 0
#endif
#ifndef XR_WO
#define XR_WO 1
#endif
#ifndef XR_POOL
#define XR_POOL 1
#endif
#ifndef XR_LORA
#define XR_LORA 1
#endif
static_assert(XR_DN == 0, "the extra-row epilogue updates x in place (no partial slab): the down projection keeps its split-K sample sub-units, whose idle workgroups convert weights");
constexpr int KSE_DN = XR_DN ? 0 : KS_DN, KSE_WO = XR_WO ? 0 : KS_WO, KSE_POOL = XR_POOL ? 0 : KS_POOL, NP_DN = XR_DN ? 1 : KS_DN, NP_WO = XR_WO ? 1 : KS_WO, NP_POOL = XR_POOL ? 1 : KS_POOL;
constexpr float SS_SCALE = 1048576.0f, SS_INV = 1.0f / 1048576.0f;
__device__ __forceinline__ float ss_rstd(u64 v) { return 1.0f / sqrtf((float)v * (SS_INV / 2048.0f) + 1e-6f); }

constexpr int D = 2048, FF = 5632, MP = 8192, MS = 256, M = MP + MS, SEQ = 4096, NWAVES = 8, NTHREADS = 512, GRID = 256;
constexpr int NHEAD = 32, HD = 64, QKVD = 2560, DEPTH = 4;
constexpr float RMS_EPS = 1e-6f, GN_EPS = 64e-5f;
constexpr size_t O_YP = 0, O_YS = O_YP + (size_t)MP * D, O_POOLP = O_YS + (size_t)MS * D, O_POOLS = O_POOLP + 2 * 2 * 15 * D, O_WKP = O_POOLS + (size_t)2 * 32 * 15 * D,
                 O_WVP = O_WKP + 2 * 128 * 256, O_WKS = O_WVP + 2 * 128 * 256, O_WVS = O_WKS + 32 * 128 * 256, O_SHP = O_WVS + 32 * 128 * 256, O_SHS = O_SHP + 2 * D,
                 O_WKVP = O_SHS + 32 * D, O_WKVS = O_WKVP + (size_t)2 * 32 * 4096, O_END = O_WKVS + (size_t)32 * 32 * 4096;
constexpr size_t MiB = 1u << 20;
constexpr size_t WS_CTL = 0, CTL_ZERO_BYTES = 1 * MiB;
constexpr size_t WS_WGU = 2 * MiB, WGU_BYTES = (size_t)2 * FF * D * 2;
constexpr size_t WS_WD = WS_WGU + 4 * WGU_BYTES, WD_BYTES = (size_t)D * FF * 2;
constexpr size_t WS_WMIX = WS_WD + 4 * WD_BYTES;
constexpr size_t WS_X = WS_WMIX + 40 * MiB, ROWF_BYTES = (size_t)M * D * 4;
constexpr size_t WS_WMIX2 = WS_X;
static_assert(ROWF_BYTES >= 40 * MiB, "second mixer-weight region");
constexpr size_t WS_U = WS_X + ROWF_BYTES;
constexpr size_t WS_XB = WS_U + ROWF_BYTES, ROWB_BYTES = (size_t)M * D * 2;
constexpr size_t WS_BIG = WS_XB + ROWB_BYTES;
constexpr size_t WS_ACT = WS_BIG, WS_QKV = WS_BIG, WS_MIX6 = WS_BIG;
constexpr size_t WS_RKV = WS_MIX6 + 6 * ROWB_BYTES, WS_LUP = WS_RKV + 3 * ROWF_BYTES, WS_Y = WS_LUP + 3 * ROWF_BYTES, WS_HL = WS_Y + ROWF_BYTES,
                 WS_BONUS = WS_HL + (size_t)M * 768 * 2, WS_PART = WS_BONUS + 2 * MiB, WS_CKB = WS_PART + 24 * MiB, WS_XR = WS_CKB + 128 * MiB, WS_SS = WS_XR + ROWB_BYTES, WS_END = WS_SS + 1 * MiB;
static_assert((size_t)3 * M * 8 <= 1 * MiB, "SS buffers");
constexpr size_t WS_CKA = WS_MIX6;
static_assert(6 * ROWB_BYTES >= 128 * MiB, "CKA fits over MIX6");
constexpr size_t WM_POOL = 0;
constexpr size_t WM_QKV = 0, WM_AO = (size_t)QKVD * D * 2;
constexpr size_t WM_RW = 0, WM_L2 = (size_t)6912 * D * 2, WM_RO = WM_L2 + (size_t)6144 * 256 * 2;
static_assert(WM_RO + (size_t)D * D * 2 <= 40 * MiB, "mixer weights fit");
constexpr int RING_BYTES = 131072, LDS_BYTES = 163840, MISC_OFF = LDS_BYTES - 256;

constexpr int CW_BAR = 4096;

typedef __bf16 bf16x2_t __attribute__((ext_vector_type(2)));
__device__ __forceinline__ unsigned cvt_pk_bf16(float lo, float hi) { const f32x2 v = {lo, hi}; return __builtin_bit_cast(unsigned, __builtin_convertvector(v, bf16x2_t)); }
__device__ __forceinline__ float bf2f(unsigned short b) { return __uint_as_float(((unsigned)b) << 16); }
__device__ __forceinline__ f32x4 ld_bf4(const bf16_t* p) { const u32x2 w = *(const u32x2*)p; return (f32x4){__uint_as_float(w.x << 16), __uint_as_float(w.x & 0xffff0000u), __uint_as_float(w.y << 16), __uint_as_float(w.y & 0xffff0000u)}; }
__device__ __forceinline__ float wave_sum(float v) {
#pragma unroll
    for (int o = 1; o < 64; o <<= 1) v += __shfl_xor(v, o);
    return v;
}
__device__ __forceinline__ float dpp_ror(float x, int   n);
template <int N> __device__ __forceinline__ float dpp_ror_t(float x) { return __int_as_float(__builtin_amdgcn_update_dpp(0, __float_as_int(x), 0x120 + N, 0xf, 0xf, false)); }
__device__ __forceinline__ float row16_sum(float x) { x += dpp_ror_t<8>(x); x += dpp_ror_t<4>(x); x += dpp_ror_t<2>(x); x += dpp_ror_t<1>(x); return x; }
__device__ __forceinline__ float row16_max(float x) { x = fmaxf(x, dpp_ror_t<8>(x)); x = fmaxf(x, dpp_ror_t<4>(x)); x = fmaxf(x, dpp_ror_t<2>(x)); x = fmaxf(x, dpp_ror_t<1>(x)); return x; }
__device__ __forceinline__ float wave_sum_fast(float x) { x = row16_sum(x); x += __shfl_xor(x, 16); x += __shfl_xor(x, 32); return x; }
__device__ __forceinline__ float fast_exp(float x) { return __builtin_amdgcn_exp2f(x * 1.4426950408889634f); }
__device__ __forceinline__ float fast_sigmoid(float x) { return __builtin_amdgcn_rcpf(1.0f + fast_exp(-x)); }
__device__ __forceinline__ float fast_tanh(float x) { return 1.0f - 2.0f * __builtin_amdgcn_rcpf(1.0f + fast_exp(2.0f * x)); }

#define XB_TMO      128
#define XB_XCNT(j)  (256  + 64 * (j))
#define XB_XSUB(j)  (1280 + 64 * (j))
#define XB_XGEN(j)  (2304 + 64 * (j))
#define XB_TOP      3328
#define XB_TOPGEN   3392
#define XCD_BAR_WORDS 3456
#define XB_SPIN_CAP (1u << 18)
__device__ __forceinline__ unsigned xb_ld(unsigned* p)              { return __hip_atomic_load(p, __ATOMIC_RELAXED, __HIP_MEMORY_SCOPE_AGENT); }
__device__ __forceinline__ unsigned xb_add(unsigned* p, unsigned v) { return __hip_atomic_fetch_add(p, v, __ATOMIC_RELAXED, __HIP_MEMORY_SCOPE_AGENT); }
__device__ __forceinline__ unsigned xb_xcc_id() { return (unsigned)__builtin_amdgcn_s_getreg((3 << 11) | 20) & 0xFu; }
#define XB_SPIN(cond, bar) do { unsigned _sp = 0; while (cond) { __builtin_amdgcn_s_sleep(1); \
    if ((++_sp & 255u) == 0u) { if (xb_ld(&(bar)[XB_TMO])) break; if (_sp > XB_SPIN_CAP) { atomicAdd(&(bar)[XB_TMO], 1u); break; } } } } while (0)
struct XcdBarrier { unsigned* bar; unsigned x; volatile LAS unsigned* st; };
__device__ __forceinline__ XcdBarrier xcd_barrier_post(unsigned* bar, volatile LAS unsigned* st) {
    XcdBarrier b; b.bar = bar; b.x = xb_xcc_id(); b.st = st;
    if (threadIdx.x == 0) (void)xb_add(&bar[XB_XCNT(b.x)], 1u);
    return b;
}
__device__ __forceinline__ void xcd_barrier_complete(unsigned* bar, unsigned x, unsigned& nloc, unsigned& nx) {
    const unsigned G = gridDim.x * gridDim.y * gridDim.z;
    unsigned sum, cnt, mine, sp = 0u;
    for (;;) {
        sum = 0u; cnt = 0u; mine = 0u;
#pragma unroll
        for (unsigned j = 0; j < 16; ++j) { const unsigned c = xb_ld(&bar[XB_XCNT(j)]); sum += c; cnt += (c > 0u) ? 1u : 0u; mine = (j == x) ? c : mine; }
        if (sum == G) break;
        __builtin_amdgcn_s_sleep(1);
        if ((++sp & 255u) == 0u) { if (xb_ld(&bar[XB_TMO])) break; if (sp > XB_SPIN_CAP) { atomicAdd(&bar[XB_TMO], 1u); break; } }
    }
    nloc = mine > 0u ? mine : 1u; nx = cnt > 0u ? cnt : 1u;
}
__device__ __forceinline__ void xcd_barrier(const XcdBarrier& b) {
    asm volatile("s_waitcnt vmcnt(0)" ::: "memory");
    __syncthreads();
    if (threadIdx.x == 0) {
        unsigned* bar = b.bar; asm volatile("" : "+s"(bar));
        __builtin_amdgcn_s_waitcnt(0);
        unsigned nloc = b.st[0], nx = b.st[1];
        if (nloc == 0u) { xcd_barrier_complete(bar, b.x, nloc, nx); b.st[0] = nloc; b.st[1] = nx; }
        const unsigned old = xb_add(&bar[XB_XSUB(b.x)], 1u);
        const unsigned gen = old / nloc;
        if (old + 1u == (gen + 1u) * nloc) {
            __builtin_amdgcn_fence(__ATOMIC_RELEASE, "agent");
            asm volatile("s_waitcnt vmcnt(0)" ::: "memory");
            const unsigned og = xb_add(&bar[XB_TOP], 1u);
            const unsigned tg = og / nx;
            if (og + 1u == (tg + 1u) * nx) xb_add(&bar[XB_TOPGEN], 1u);
            else XB_SPIN(xb_ld(&bar[XB_TOPGEN]) == tg, bar);
            __builtin_amdgcn_fence(__ATOMIC_ACQUIRE, "agent");
            xb_add(&bar[XB_XGEN(b.x)], 1u);
            asm volatile("s_waitcnt vmcnt(0)" ::: "memory");
        } else {
            XB_SPIN(xb_ld(&bar[XB_XGEN(b.x)]) == gen, bar);
            __builtin_amdgcn_fence(__ATOMIC_ACQUIRE, "agent");
            asm volatile("s_waitcnt vmcnt(0)" ::: "memory");
        }
    }
    __syncthreads();
}

namespace g8 {
constexpr int BM = 256, BK = 64, HALF = 128, HTB = HALF * BK * 2, STAGE_BYTES = 8 * HTB, NXCD = 8, WGM = 8;
__host__ __device__ __forceinline__ int lds_byte(int r, int c) { const int st = (r >> 4) * 2 + (c >> 5), rr = r & 15, cc = c & 31, ob = rr * 64 + cc * 2; return st * 1024 + (ob ^ (((ob >> 9) & 1) << 5)); }
__host__ __device__ __forceinline__ void stage_rc(int b, int& R, int& C) { const int st = b / 1024, sb = b % 1024, swz = sb ^ (((sb >> 9) & 1) << 5); R = (st >> 1) * 16 + swz / 64; C = (st & 1) * 32 + (swz % 64) / 2; }
__host__ __device__ __forceinline__ int perm32(int rho) { const int n = rho >> 4, i = rho & 15; return 8 * (i >> 2) + 4 * n + (i & 3); }

struct Unit { const char* A; const char* B; int pm, pn, nt, part; };
struct Tiler {
    int nM, nN, nwg, G, c;
    __device__ void init(int nM_, int nN_, int G_, int c_) { nM = nM_; nN = nN_; nwg = nM * nN; G = G_; c = c_; }
    __device__ bool tile(int i, int& pm, int& pn) const {
        const long L = (long)i * G + c; if (L >= nwg) return false;
        int wgid = (int)L; { const int q = nwg / NXCD, r = nwg % NXCD, xcd = wgid % NXCD, off = wgid / NXCD; wgid = (xcd < r ? xcd * (q + 1) : r * (q + 1) + (xcd - r) * q) + off; }
        const int nig = WGM * nN, gid = wgid / nig, fm = gid * WGM, gsz = (nM - fm) < WGM ? (nM - fm) : WGM;
        pm = fm + ((wgid % nig) % gsz); pn = (wgid % nig) / gsz; return true;
    }
};
template <int MODE> struct Sched {
    Tiler T; const char* A; const char* B; int lda, ldb, nt;
    int KS, Ksub;
    __device__ __forceinline__ bool next(int i, Unit& u) const {
        int pm, pn;
        u.nt = nt; u.part = -1;
        if (KS > 0) {
            const long L = (long)i * T.G + T.c;
            if (L >= T.nwg) { const int sub = (int)(L - T.nwg); if (sub >= T.nN * KS) return false;
                pn = sub % T.nN; const int ks = sub / T.nN; u.pm = T.nM; u.pn = pn; u.nt = Ksub / BK; u.part = ks;
                size_t ao = (size_t)T.nM * BM * lda * 2 + (size_t)ks * Ksub * 2; if (MODE == 1) ao += (size_t)(pn >> 1) * 512 * 2;
                u.A = A + ao; u.B = B + (size_t)pn * BM * ldb * 2 + (size_t)ks * Ksub * 2; return true; }
        }
        if (!T.tile(i, pm, pn)) return false;
        u.pm = pm; u.pn = pn;
        size_t ao = (size_t)pm * BM * lda * 2;
        if (MODE == 1) ao += (size_t)(pn >> 1) * 512 * 2;
        if (MODE == 2) { const int slot = pn < 24 ? (pn >> 3) : (pn - 24 + 3); ao += (size_t)slot * M * D * 2; }
        if (MODE == 3) ao += (size_t)(pn >> 3) * 256 * 2;
        u.A = A + ao; u.B = B + (size_t)pn * BM * ldb * 2; return true;
    }
};

constexpr int XBASE = 8 * HALF * BK * 2 + 8192, XBUF = 4096;
template <bool ALIGN_EPI, bool SP2, bool XROWS = false, class Epi, class SchedT>
__device__ __forceinline__ void gemm_phase(LAS unsigned char* lds, const int lda, const int ldb, const SchedT& S, const Epi& E) {
    static_assert(SP2 || !XROWS, "extra rows: two-phase schedule only");
    int tid = threadIdx.x; asm volatile("" : "+v"(tid));
    const int wid = __builtin_amdgcn_readfirstlane(tid >> 6), lane = tid & 63, wr = wid >> 2, wc = wid & 3, fr = lane & 15, fq = lane >> 4;
    unsigned voffA, voffB;
    { int R, C; stage_rc(tid * 16, R, C); const int Rb = Epi::PERM ? ((R & ~31) + perm32(R & 31)) : R;
        voffA = (unsigned)(R * lda + C) * 2u; voffB = (unsigned)(Rb * ldb + C) * 2u; }
    const size_t q64voffA = (size_t)64 * lda * 2, q64voffB = (size_t)64 * ldb * 2;
    const size_t kstep = (size_t)(BK * 2);
    const size_t hstepA = (size_t)HALF * lda * 2, hstepB = (size_t)HALF * ldb * 2;
    const unsigned ldsw = (unsigned)wid * 1024u;
    const int aoff = lds_byte(wr * 64 + fr, fq * 8), boff = lds_byte(wc * 32 + fr, fq * 8);
    long xoffu = 0; int ldsx = 0;
    if constexpr (XROWS) { const int sub = wid & 1, kt = (wid >> 1) & 1;
        xoffu = (long)kt * (BK * 2) - (long)(wid >> 1) * 16 * lda * 2; ldsx = XBASE + kt * 2048 + sub * 1024; }
#define PG8_XPTR(u) ((u).A + ((size_t)(MP - (u).pm * BM) + 8 * (u).pm) * lda * 2)
#define PG8_XSTAGE(buf, gbase) do { if constexpr (XROWS) __builtin_amdgcn_global_load_lds((const unsigned*)((const char*)(gbase) + xoffu + voffA), (LAS unsigned*)(lds + ldsx + (buf) * XBUF), 16, 0, 0); } while (0)
#define PG8_LDX(kt, k) do { if constexpr (XROWS) Ax = *(const LAS bf16x8*)(lds + (XBASE + xb * XBUF + (kt) * 2048 + (k) * 1024 - wc * 4096) + boff); } while (0)
#define PG8_XMMA(k) do { if constexpr (XROWS) { __builtin_amdgcn_s_setprio(1); if (wr == 0) { _Pragma("unroll") for (int n = 0; n < 2; ++n) xacc[n] = __builtin_amdgcn_mfma_f32_16x16x32_bf16(B0[n][k], Ax, xacc[n], 0, 0, 0); } \
        else { _Pragma("unroll") for (int n = 0; n < 2; ++n) xacc[n] = __builtin_amdgcn_mfma_f32_16x16x32_bf16(B1[n][k], Ax, xacc[n], 0, 0, 0); } __builtin_amdgcn_s_setprio(0); } } while (0)
#define PG8_SA(b, h) (((b) * 2 + (h)) * HTB)
#define PG8_SB(b, h) ((4 + (b) * 2 + (h)) * HTB)
#define PG8_STAGE(bufoff, gbase, voff) do { \
        __builtin_amdgcn_global_load_lds((const unsigned*)((const char*)(gbase) + (voff)), (LAS unsigned*)(lds + (bufoff) + ldsw), 16, 0, 0); \
        __builtin_amdgcn_global_load_lds((const unsigned*)((const char*)(gbase) + q64##voff + (voff)), (LAS unsigned*)(lds + (bufoff) + ldsw + 8192), 16, 0, 0); } while (0)
#define PG8_LDA(dst, b, h) do { _Pragma("unroll") for (int m = 0; m < 4; ++m) _Pragma("unroll") for (int k = 0; k < 2; ++k) dst[m][k] = *(const LAS bf16x8*)(lds + PG8_SA(b, h) + aoff + m * 2048 + k * 1024); } while (0)
#define PG8_LDB(dst, b, h) do { _Pragma("unroll") for (int n = 0; n < 2; ++n) _Pragma("unroll") for (int k = 0; k < 2; ++k) dst[n][k] = *(const LAS bf16x8*)(lds + PG8_SB(b, h) + boff + n * 2048 + k * 1024); } while (0)
#define PG8_MMA(ai, bj, At, Bt) do { __builtin_amdgcn_s_setprio(1); _Pragma("unroll") for (int m = 0; m < 4; ++m) _Pragma("unroll") for (int n = 0; n < 2; ++n) _Pragma("unroll") for (int k = 0; k < 2; ++k) \
        acc[ai][bj][m][n] = __builtin_amdgcn_mfma_f32_16x16x32_bf16(Bt[n][k], At[m][k], acc[ai][bj][m][n], 0, 0, 0); __builtin_amdgcn_s_setprio(0); } while (0)
#define PG8_WAIT_V(n) asm volatile("s_waitcnt vmcnt(" #n ")" ::: "memory")
#define PG8_WAIT_L(n) asm volatile("s_waitcnt lgkmcnt(" #n ")" ::: "memory")
#define PG8_BAR __builtin_amdgcn_s_barrier()
#define PG8_SCHED __builtin_amdgcn_sched_barrier(0)
    Unit cur, nxt; int ui = 0;
    E.prefetch(S, lds, tid);
    if (!S.next(0, cur)) return;
    f32x4 acc[2][2][4][2];
#pragma unroll
    for (int a = 0; a < 2; ++a)
#pragma unroll
        for (int b = 0; b < 2; ++b)
#pragma unroll
            for (int m = 0; m < 4; ++m)
#pragma unroll
                for (int n = 0; n < 2; ++n) acc[a][b][m][n] = (f32x4){0.f, 0.f, 0.f, 0.f};
    bf16x8 At[4][2], B0[2][2], B1[2][2];
    bf16x8 Ax; f32x4 xacc[2]; int xb = 0;
    if constexpr (XROWS) { xacc[0] = (f32x4){0.f, 0.f, 0.f, 0.f}; xacc[1] = (f32x4){0.f, 0.f, 0.f, 0.f}; }
    const char* cA = cur.A; const char* cB = cur.B;
    const char* cX = PG8_XPTR(cur);
    if constexpr (SP2) {
        PG8_XSTAGE(0, cX);
        PG8_STAGE(PG8_SB(0, 0), cB, voffB); PG8_STAGE(PG8_SB(0, 1), cB + hstepB, voffB); PG8_STAGE(PG8_SA(0, 0), cA, voffA); PG8_STAGE(PG8_SA(0, 1), cA + hstepA, voffA);
        if (wr == 1) PG8_BAR;
        PG8_WAIT_V(2); PG8_BAR;
        PG8_STAGE(PG8_SB(1, 0), cB + kstep, voffB); PG8_STAGE(PG8_SA(1, 0), cA + kstep, voffA); PG8_STAGE(PG8_SB(1, 1), cB + hstepB + kstep, voffB);
        PG8_WAIT_V(6); PG8_BAR;
    } else {
        PG8_STAGE(PG8_SB(0, 0), cB, voffB); PG8_STAGE(PG8_SA(0, 0), cA, voffA); PG8_STAGE(PG8_SB(0, 1), cB + hstepB, voffB); PG8_STAGE(PG8_SA(0, 1), cA + hstepA, voffA);
        if (wr == 1) PG8_BAR;
        PG8_WAIT_V(4); PG8_BAR;
        PG8_STAGE(PG8_SB(1, 0), cB + kstep, voffB); PG8_STAGE(PG8_SA(1, 0), cA + kstep, voffA); PG8_STAGE(PG8_SB(1, 1), cB + hstepB + kstep, voffB);
        PG8_WAIT_V(6); PG8_BAR;
    }
    for (;;) {
        const bool has_next = S.next(ui + 1, nxt);
        const char* nA = has_next ? nxt.A : cA; const char* nB = has_next ? nxt.B : cB;
        const char* nX = has_next ? PG8_XPTR(nxt) : cX;
        const int nt = cur.nt;
#pragma nounroll
        for (int t = 0; t < nt; t += 2) {
            const bool last = (t == nt - 2);
            const char* a1 = cA + (size_t)(t + 1) * kstep;
            const char* a2 = last ? nA : cA + (size_t)(t + 2) * kstep; const char* b2 = last ? nB : cB + (size_t)(t + 2) * kstep;
            const char* a3 = a2 + kstep; const char* b3 = b2 + kstep;
            if constexpr (SP2) {
            const char* x2 = last ? nX : cX + (size_t)(t + 2) * kstep;
            PG8_LDB(B0, 0, 0); PG8_LDB(B1, 0, 1); PG8_LDX(0, 0); PG8_SCHED; PG8_LDA(At, 0, 0); PG8_STAGE(PG8_SA(1, 1), a1 + hstepA, voffA); PG8_XSTAGE(xb ^ 1, x2);
            if constexpr (XROWS) PG8_WAIT_V(9); else PG8_WAIT_V(8);
            PG8_WAIT_L(0); PG8_BAR; PG8_MMA(0, 0, At, B0); PG8_MMA(0, 1, At, B1); PG8_XMMA(0); PG8_BAR; PG8_SCHED;
            PG8_LDA(At, 0, 1); PG8_LDX(0, 1); PG8_STAGE(PG8_SB(0, 0), b2, voffB); PG8_STAGE(PG8_SB(0, 1), b2 + hstepB, voffB); PG8_STAGE(PG8_SA(0, 0), a2, voffA);
            if constexpr (XROWS) PG8_WAIT_V(9); else PG8_WAIT_V(8);
            PG8_WAIT_L(0); PG8_BAR; PG8_MMA(1, 0, At, B0); PG8_MMA(1, 1, At, B1); PG8_XMMA(1); PG8_BAR; PG8_SCHED;
            PG8_LDB(B0, 1, 0); PG8_LDB(B1, 1, 1); PG8_LDX(1, 0); PG8_SCHED; PG8_LDA(At, 1, 0); PG8_STAGE(PG8_SA(0, 1), a2 + hstepA, voffA);
            PG8_WAIT_V(8); PG8_WAIT_L(0); PG8_BAR; PG8_MMA(0, 0, At, B0); PG8_MMA(0, 1, At, B1); PG8_XMMA(0); PG8_BAR; PG8_SCHED;
            PG8_LDA(At, 1, 1); PG8_LDX(1, 1); PG8_STAGE(PG8_SB(1, 0), b3, voffB); PG8_STAGE(PG8_SB(1, 1), b3 + hstepB, voffB); PG8_STAGE(PG8_SA(1, 0), a3, voffA);
            PG8_WAIT_V(8); PG8_WAIT_L(0); PG8_BAR; PG8_MMA(1, 0, At, B0); PG8_MMA(1, 1, At, B1); PG8_XMMA(1); PG8_BAR; PG8_SCHED;
            xb ^= 1;
            } else {
            PG8_LDB(B0, 0, 0); PG8_SCHED; PG8_LDA(At, 0, 0); PG8_STAGE(PG8_SA(1, 1), a1 + hstepA, voffA);
            PG8_WAIT_L(8); PG8_BAR; PG8_WAIT_L(0); PG8_MMA(0, 0, At, B0); PG8_BAR; PG8_SCHED;
            PG8_LDB(B1, 0, 1); PG8_STAGE(PG8_SB(0, 0), b2, voffB);
            PG8_BAR; PG8_WAIT_L(0); PG8_MMA(0, 1, At, B1); PG8_BAR;
            PG8_LDA(At, 0, 1); PG8_STAGE(PG8_SA(0, 0), a2, voffA);
            PG8_BAR; PG8_WAIT_L(0); PG8_MMA(1, 0, At, B0); PG8_BAR; PG8_SCHED;
            PG8_STAGE(PG8_SB(0, 1), b2 + hstepB, voffB);
            PG8_WAIT_V(6); PG8_BAR; PG8_MMA(1, 1, At, B1); PG8_BAR;
            PG8_LDB(B0, 1, 0); PG8_SCHED; PG8_LDA(At, 1, 0); PG8_STAGE(PG8_SA(0, 1), a2 + hstepA, voffA);
            PG8_WAIT_L(8); PG8_BAR; PG8_WAIT_L(0); PG8_MMA(0, 0, At, B0); PG8_BAR; PG8_SCHED;
            PG8_LDB(B1, 1, 1); PG8_STAGE(PG8_SB(1, 0), b3, voffB);
            PG8_BAR; PG8_WAIT_L(0); PG8_MMA(0, 1, At, B1); PG8_BAR;
            PG8_LDA(At, 1, 1); PG8_STAGE(PG8_SA(1, 0), a3, voffA);
            PG8_BAR; PG8_WAIT_L(0); PG8_MMA(1, 0, At, B0); PG8_BAR; PG8_SCHED;
            PG8_STAGE(PG8_SB(1, 1), b3 + hstepB, voffB);
            PG8_WAIT_V(6); PG8_BAR; PG8_MMA(1, 1, At, B1); PG8_BAR;
                    }
        }
        if constexpr (ALIGN_EPI) { if (wr == 0) PG8_BAR; }
        E(acc, cur, wr, wc, fr, fq, ui, lds);
        if constexpr (XROWS) { E.xrows(xacc, cur, wr, wc, fr, fq, ui, lds); xacc[0] = (f32x4){0.f, 0.f, 0.f, 0.f}; xacc[1] = (f32x4){0.f, 0.f, 0.f, 0.f}; }
        if (!has_next) break;
#pragma unroll
        for (int a = 0; a < 2; ++a)
#pragma unroll
            for (int b = 0; b < 2; ++b)
#pragma unroll
                for (int m = 0; m < 4; ++m)
#pragma unroll
                    for (int n = 0; n < 2; ++n) acc[a][b][m][n] = (f32x4){0.f, 0.f, 0.f, 0.f};
        cur = nxt; cA = nA; cB = nB; cX = nX; ++ui;
        if constexpr (ALIGN_EPI) { if (wr == 1) PG8_BAR; }
    }
    PG8_WAIT_V(0);
    if constexpr (!ALIGN_EPI) { if (wr == 0) PG8_BAR; }
    PG8_BAR;
#undef PG8_XPTR
#undef PG8_XSTAGE
#undef PG8_LDX
#undef PG8_XMMA
#undef PG8_SA
#undef PG8_SB
#undef PG8_STAGE
#undef PG8_LDA
#undef PG8_LDB
#undef PG8_MMA
#undef PG8_WAIT_V
#undef PG8_WAIT_L
#undef PG8_BAR
#undef PG8_SCHED
}

struct EpiSwiGLU {
    static constexpr bool PERM = true;
    template <class SchedT> __device__ __forceinline__ void prefetch(const SchedT& S, LAS unsigned char* lds, int tid) const {
        const u64* SS = (const u64*)(ws + WS_SS) + (size_t)ssidx * M; LAS float* RS = (LAS float*)(lds + STAGE_BYTES);
        for (int q = tid; q < 8 * 256; q += NTHREADS) { Unit u; if (S.next(q >> 8, u)) RS[q] = ss_rstd(SS[u.pm * BM + (q & 255)]); }
        asm volatile("s_waitcnt vmcnt(0) lgkmcnt(0)" ::: "memory");
    }
    unsigned char* ws; int ssidx;
    __device__ __forceinline__ void operator()(const f32x4 (&acc)[2][2][4][2], const Unit& u, int wr, int wc, int fr, int fq, int ui, LAS unsigned char* lds) const {
        bf16_t* O = (bf16_t*)(ws + WS_ACT);
        const int row0 = u.pm * BM + wr * 64 + fr, col0 = u.pn * 128 + wc * 32 + 8 * fq;
#pragma unroll
        for (int ai = 0; ai < 2; ++ai)
#pragma unroll
            for (int m = 0; m < 4; ++m) { bf16_t* rowp = O + (size_t)(row0 + ai * HALF + m * 16) * FF + col0;
                const float rs = ((const LAS float*)(lds + STAGE_BYTES))[ui * 256 + wr * 64 + fr + ai * HALF + m * 16];
                float h[8];
#pragma unroll
                for (int n = 0; n < 2; ++n)
#pragma unroll
                    for (int j = 0; j < 4; ++j) { const float g = acc[ai][0][m][n][j] * rs, up = acc[ai][1][m][n][j] * rs; h[n * 4 + j] = g * fast_sigmoid(g) * up; }
                u32x4 w; w.x = cvt_pk_bf16(h[0], h[1]); w.y = cvt_pk_bf16(h[2], h[3]); w.z = cvt_pk_bf16(h[4], h[5]); w.w = cvt_pk_bf16(h[6], h[7]);
                *(u32x4*)rowp = w; }
    }
};
struct EpiResid {
    static constexpr bool PERM = false;
    template <class SchedT> __device__ __forceinline__ void prefetch(const SchedT& S, LAS unsigned char* lds, int tid) const {
        if (bias) { LAS float* BS = (LAS float*)(lds + STAGE_BYTES);
            for (int q = tid; q < 8 * 256; q += NTHREADS) { Unit u; if (S.next(q >> 8, u)) BS[q] = u.part <= 0 ? bias[u.pn * BM + (q & 255)] : 0.f; }
            asm volatile("s_waitcnt vmcnt(0) lgkmcnt(0)" ::: "memory"); }
    }
    __device__ __forceinline__ void xrows(const f32x4 (&xacc)[2], const Unit& u, int wr, int wc, int fr, int fq, int ui, LAS unsigned char* lds) const {
        bf16_t* XR = (bf16_t*)(ws + WS_XR); u64* SS = (u64*)(ws + WS_SS) + (size_t)ssidx * M;
        const int row = MP + 8 * u.pm + (fr & 7);
        float ssq = 0.f;
        if (fr < 8) { bf16_t* p = XR + (size_t)row * D + u.pn * BM + wr * HALF + wc * 32 + 4 * fq;
            u32x2 o[2];
#pragma unroll
            for (int n = 0; n < 2; ++n) o[n] = *(const u32x2*)(p + n * 16);
#pragma unroll
            for (int n = 0; n < 2; ++n) { const f32x4 bv = bias ? *(const LAS f32x4*)((const LAS float*)(lds + STAGE_BYTES) + ui * 256 + wr * HALF + wc * 32 + n * 16 + 4 * fq) : (f32x4){0.f, 0.f, 0.f, 0.f};
                const f32x4 xold = (f32x4){__uint_as_float(o[n].x << 16), __uint_as_float(o[n].x & 0xffff0000u), __uint_as_float(o[n].y << 16), __uint_as_float(o[n].y & 0xffff0000u)};
                const f32x4 xn = xold + xacc[n] * alpha + bv;
                u32x2 w; w.x = cvt_pk_bf16(xn.x, xn.y); w.y = cvt_pk_bf16(xn.z, xn.w); *(u32x2*)(p + n * 16) = w;
                const f32x4 xr = (f32x4){__uint_as_float(w.x << 16), __uint_as_float(w.x & 0xffff0000u), __uint_as_float(w.y << 16), __uint_as_float(w.y & 0xffff0000u)};
                ssq += (xr.x * xr.x + xr.y * xr.y) + (xr.z * xr.z + xr.w * xr.w); } }
        ssq += __shfl_xor(ssq, 16); ssq += __shfl_xor(ssq, 32);
        if (fq == 0 && fr < 8) atomicAdd(SS + row, (u64)(ssq * SS_SCALE));
        asm volatile("" ::: "memory");
    }
    unsigned char* ws; const float* bias; float alpha; int ssidx; int wxr;
    __device__ __forceinline__ void operator()(const f32x4 (&acc)[2][2][4][2], const Unit& u, int wr, int wc, int fr, int fq, int ui, LAS unsigned char* lds) const {
        float* PART = (float*)(ws + WS_PART); bf16_t* XR = (bf16_t*)(ws + WS_XR); u64* SS = (u64*)(ws + WS_SS) + (size_t)ssidx * M;
        const int row0 = u.pm * BM + wr * 64 + fr, col0 = u.pn * BM + wc * 32 + 4 * fq;
        f32x4 bv[2][2];
#pragma unroll
        for (int bj = 0; bj < 2; ++bj)
#pragma unroll
            for (int n = 0; n < 2; ++n) bv[bj][n] = bias ? *(const LAS f32x4*)((const LAS float*)(lds + STAGE_BYTES) + ui * 256 + wc * 32 + 4 * fq + bj * HALF + n * 16) : (f32x4){0.f, 0.f, 0.f, 0.f};
        if (u.part >= 0) {
            float* base = PART + ((size_t)u.part * 256 + wr * 64 + fr) * D + col0;
#pragma unroll
            for (int ai = 0; ai < 2; ++ai)
#pragma unroll
                for (int m = 0; m < 4; ++m) { float* rowp = base + (size_t)(ai * HALF + m * 16) * D;
#pragma unroll
                    for (int bj = 0; bj < 2; ++bj)
#pragma unroll
                        for (int n = 0; n < 2; ++n) *(f32x4*)(rowp + bj * HALF + n * 16) = acc[ai][bj][m][n] * alpha + bv[bj][n]; }
            return;
        }
#pragma unroll
        for (int ai = 0; ai < 2; ++ai) {
            u32x2 xo[4][2][2];
#pragma unroll
            for (int m = 0; m < 4; ++m)
#pragma unroll
                for (int bj = 0; bj < 2; ++bj)
#pragma unroll
                    for (int n = 0; n < 2; ++n) xo[m][bj][n] = *(const u32x2*)(XR + (size_t)(row0 + ai * HALF + m * 16) * D + col0 + bj * HALF + n * 16);
#pragma unroll
            for (int m = 0; m < 4; ++m) { const size_t ro = (size_t)(row0 + ai * HALF + m * 16) * D + col0; float ssq = 0.f;
#pragma unroll
                for (int bj = 0; bj < 2; ++bj)
#pragma unroll
                    for (int n = 0; n < 2; ++n) { const u32x2 o = xo[m][bj][n];
                        const f32x4 xold = (f32x4){__uint_as_float(o.x << 16), __uint_as_float(o.x & 0xffff0000u), __uint_as_float(o.y << 16), __uint_as_float(o.y & 0xffff0000u)};
                        const f32x4 xn = xold + acc[ai][bj][m][n] * alpha + bv[bj][n];
                        u32x2 w; w.x = cvt_pk_bf16(xn.x, xn.y); w.y = cvt_pk_bf16(xn.z, xn.w); *(u32x2*)(XR + ro + bj * HALF + n * 16) = w;
                        const f32x4 xr = (f32x4){__uint_as_float(w.x << 16), __uint_as_float(w.x & 0xffff0000u), __uint_as_float(w.y << 16), __uint_as_float(w.y & 0xffff0000u)};
                        ssq += (xr.x * xr.x + xr.y * xr.y) + (xr.z * xr.z + xr.w * xr.w); }
                ssq += __shfl_xor(ssq, 16); ssq += __shfl_xor(ssq, 32);
                if (fq == 0) atomicAdd(SS + row0 + ai * HALF + m * 16, (u64)(ssq * SS_SCALE)); }
            asm volatile("" ::: "memory"); }
    }
};
struct EpiQKV {
    static constexpr bool PERM = true;
    template <class SchedT> __device__ __forceinline__ void prefetch(const SchedT& S, LAS unsigned char* lds, int tid) const {
        const u64* SS = (const u64*)(ws + WS_SS) + (size_t)ssidx * M; LAS float* RS = (LAS float*)(lds + STAGE_BYTES);
        for (int q = tid; q < 8 * 256; q += NTHREADS) { Unit u; if (S.next(q >> 8, u)) RS[q] = ss_rstd(SS[u.pm * BM + (q & 255)]); }
        asm volatile("s_waitcnt vmcnt(0) lgkmcnt(0)" ::: "memory");
    }
    unsigned char* ws; const float* bias; int ssidx;
    __device__ __forceinline__ void operator()(const f32x4 (&acc)[2][2][4][2], const Unit& u, int wr, int wc, int fr, int fq, int ui, LAS unsigned char* lds) const {
        bf16_t* O = (bf16_t*)(ws + WS_QKV);
        const int row0 = u.pm * BM + wr * 64 + fr, col0 = u.pn * BM + wc * 32 + 8 * fq;
        f32x4 bv[2][2];
#pragma unroll
        for (int bj = 0; bj < 2; ++bj)
#pragma unroll
            for (int n = 0; n < 2; ++n) bv[bj][n] = *(const f32x4*)(bias + col0 + bj * HALF + 4 * n);
#pragma unroll
        for (int ai = 0; ai < 2; ++ai)
#pragma unroll
            for (int m = 0; m < 4; ++m) { bf16_t* rowp = O + (size_t)(row0 + ai * HALF + m * 16) * QKVD + col0;
                const float rs = ((const LAS float*)(lds + STAGE_BYTES))[ui * 256 + wr * 64 + fr + ai * HALF + m * 16];
#pragma unroll
                for (int bj = 0; bj < 2; ++bj) { const f32x4 v0 = acc[ai][bj][m][0] * rs + bv[bj][0], v1 = acc[ai][bj][m][1] * rs + bv[bj][1];
                    u32x4 w; w.x = cvt_pk_bf16(v0[0], v0[1]); w.y = cvt_pk_bf16(v0[2], v0[3]); w.z = cvt_pk_bf16(v1[0], v1[1]); w.w = cvt_pk_bf16(v1[2], v1[3]);
                    *(u32x4*)(rowp + bj * HALF) = w; } }
    }
};
struct EpiRwkv1 {
    static constexpr bool PERM = false;
    template <class SchedT> __device__ __forceinline__ void prefetch(const SchedT&, LAS unsigned char*, int) const {}
    float* RKV; bf16_t* HL;
    __device__ __forceinline__ void operator()(const f32x4 (&acc)[2][2][4][2], const Unit& u, int wr, int wc, int fr, int fq, int ui, LAS unsigned char* lds) const {
        const int row0 = u.pm * BM + wr * 64 + fr, cin = wc * 32 + 4 * fq;
        if (u.pn < 24) {
            bf16_t* base = (bf16_t*)RKV + (size_t)(u.pn >> 3) * M * D + (u.pn & 7) * BM + cin;
#pragma unroll
            for (int ai = 0; ai < 2; ++ai)
#pragma unroll
                for (int m = 0; m < 4; ++m) { bf16_t* rowp = base + (size_t)(row0 + ai * HALF + m * 16) * D;
#pragma unroll
                    for (int bj = 0; bj < 2; ++bj)
#pragma unroll
                        for (int n = 0; n < 2; ++n) { const f32x4 v = acc[ai][bj][m][n]; u32x2 w; w.x = cvt_pk_bf16(v[0], v[1]); w.y = cvt_pk_bf16(v[2], v[3]); *(u32x2*)(rowp + bj * HALF + n * 16) = w; } }
        } else {
            const int which = u.pn - 24;
            bf16_t* base = HL + which * 256 + cin;
#pragma unroll
            for (int ai = 0; ai < 2; ++ai)
#pragma unroll
                for (int m = 0; m < 4; ++m) { bf16_t* rowp = base + (size_t)(row0 + ai * HALF + m * 16) * 768;
#pragma unroll
                    for (int bj = 0; bj < 2; ++bj)
#pragma unroll
                        for (int n = 0; n < 2; ++n) { f32x4 v = acc[ai][bj][m][n];
                            if (which == 0) {
#pragma unroll
                                for (int j = 0; j < 4; ++j) v[j] = fast_tanh(v[j]);
                            } else if (which == 2) {
#pragma unroll
                                for (int j = 0; j < 4; ++j) v[j] = fast_sigmoid(v[j]);
                            }
                            u32x2 w; w.x = cvt_pk_bf16(v[0], v[1]); w.y = cvt_pk_bf16(v[2], v[3]);
                            *(u32x2*)(rowp + bj * HALF + n * 16) = w; }
                    asm volatile("" ::: "memory"); }
        }
    }
};
struct EpiLoraUp {
    static constexpr bool PERM = false;
    template <class SchedT> __device__ __forceinline__ void prefetch(const SchedT&, LAS unsigned char*, int) const {}
    float* LUP; const float* w0; const float* a0;
    __device__ __forceinline__ void xrows(const f32x4 (&xacc)[2], const Unit& u, int wr, int wc, int fr, int fq, int ui, LAS unsigned char* lds) const {
        const int which = u.pn >> 3, row = MP + 8 * u.pm + (fr & 7), col0 = (u.pn & 7) * BM + wr * HALF + wc * 32 + 4 * fq;
        const float* addp = which == 0 ? w0 : a0;
        if (fr < 8) {
#pragma unroll
            for (int n = 0; n < 2; ++n) { f32x4 v = xacc[n]; if (which < 2) v += *(const f32x4*)(addp + col0 + n * 16);
                if (which < 2) {
#pragma unroll
                    for (int j = 0; j < 4; ++j) v[j] = fast_sigmoid(v[j]);
                    if (which == 0) {
#pragma unroll
                        for (int j = 0; j < 4; ++j) v[j] = fast_exp(-0.6065306597126334f * v[j]);
                    }
                    *(f32x4*)(LUP + (size_t)which * M * D + (size_t)row * D + col0 + n * 16) = v;
                } else { u32x2 w; w.x = cvt_pk_bf16(v[0], v[1]); w.y = cvt_pk_bf16(v[2], v[3]);
                    *(u32x2*)((bf16_t*)(LUP + (size_t)2 * M * D) + (size_t)row * D + col0 + n * 16) = w; } } }
        asm volatile("" ::: "memory");
    }
    __device__ __forceinline__ void operator()(const f32x4 (&acc)[2][2][4][2], const Unit& u, int wr, int wc, int fr, int fq, int ui, LAS unsigned char* lds) const {
        const int which = u.pn >> 3, row0 = u.pm * BM + wr * 64 + fr, col0 = (u.pn & 7) * BM + wc * 32 + 4 * fq;
        const float* addp = which == 0 ? w0 : a0;
        f32x4 bv[2][2];
#pragma unroll
        for (int bj = 0; bj < 2; ++bj)
#pragma unroll
            for (int n = 0; n < 2; ++n) bv[bj][n] = which < 2 ? *(const f32x4*)(addp + col0 + bj * HALF + n * 16) : (f32x4){0.f, 0.f, 0.f, 0.f};
        float* base = LUP + (size_t)which * M * D + col0;
#pragma unroll
        for (int ai = 0; ai < 2; ++ai)
#pragma unroll
            for (int m = 0; m < 4; ++m) { float* rowp = base + (size_t)(row0 + ai * HALF + m * 16) * D;
#pragma unroll
                for (int bj = 0; bj < 2; ++bj)
#pragma unroll
                    for (int n = 0; n < 2; ++n) { f32x4 v = acc[ai][bj][m][n] + bv[bj][n];
                        if (which < 2) {
#pragma unroll
                            for (int j = 0; j < 4; ++j) v[j] = fast_sigmoid(v[j]);
                            if (which == 0) {
#pragma unroll
                                for (int j = 0; j < 4; ++j) v[j] = fast_exp(-0.6065306597126334f * v[j]);
                            }
                            *(f32x4*)(rowp + bj * HALF + n * 16) = v;
                        } else {
                            u32x2 w; w.x = cvt_pk_bf16(v[0], v[1]); w.y = cvt_pk_bf16(v[2], v[3]);
                            *(u32x2*)((bf16_t*)(LUP + (size_t)2 * M * D) + (size_t)(row0 + ai * HALF + m * 16) * D + col0 + bj * HALF + n * 16) = w; } }
                asm volatile("" ::: "memory"); }
    }
};
}

struct Args { const float* in[40]; float* out; unsigned char* ws; int lo, hi; };
enum { I_XP = 0, I_XS, I_SPOOL, I_CK, I_CV, I_SSHIFT, I_SWKV, I_NF1, I_NMIX, I_NF2, I_NFIN, I_WG, I_WU, I_WDN, I_PW, I_PSC, I_AQKV, I_ABQKV, I_AWO, I_ABO, I_SINK, I_RELB,
       I_MU, I_RWR, I_RWK, I_RWV, I_RWO, I_W0, I_W1, I_W2, I_A0, I_A1, I_A2, I_G1, I_G2, I_KK, I_KA, I_RK, I_LNW, I_LNB };

struct Frame {
    LAS unsigned char* lds; const Args* a; unsigned char* ws; float* out;
    float* X; float* U; bf16_t* XB;
};

struct ConvT { f32x4 v[8]; const float* nscale; const float* kscale; bf16_t* dst; int dld, k0, n, Ns; };
__device__ __forceinline__ void conv_tile_load(ConvT& c, const float* __restrict__ src, int Ks, int Ns, int k0, int n0, bf16_t* __restrict__ dst, int dld, const float* __restrict__ nscale, int lane, const float* __restrict__ kscale) {
    const int kg = lane >> 3, ng = lane & 7, n = n0 + 4 * ng;
#pragma unroll
    for (int i = 0; i < 8; ++i) { const int k = k0 + 8 * kg + i; c.v[i] = (k < Ks && n < Ns) ? *(const f32x4*)(src + (size_t)k * Ns + n) : (f32x4){0.f, 0.f, 0.f, 0.f}; }
    c.nscale = nscale; c.kscale = kscale; c.dst = dst; c.dld = dld; c.k0 = k0; c.n = n; c.Ns = Ns;
}
__device__ __forceinline__ void conv_tile_finish(ConvT& c, int lane) {
    const int kg = lane >> 3, ng = lane & 7;
    if (c.kscale) {
        const f32x4 g0 = *(const f32x4*)(c.kscale + c.k0 + 8 * kg), g1 = *(const f32x4*)(c.kscale + c.k0 + 8 * kg + 4);
        c.v[0] *= g0.x; c.v[1] *= g0.y; c.v[2] *= g0.z; c.v[3] *= g0.w; c.v[4] *= g1.x; c.v[5] *= g1.y; c.v[6] *= g1.z; c.v[7] *= g1.w; }
    f32x4 sc = (f32x4){1.f, 1.f, 1.f, 1.f};
    if (c.nscale && c.n < c.Ns) sc = *(const f32x4*)(c.nscale + c.n);
#pragma unroll
    for (int s = 0; s < 4; ++s) { const float q = sc[s];
        u32x4 o; o.x = cvt_pk_bf16(c.v[0][s] * q, c.v[1][s] * q); o.y = cvt_pk_bf16(c.v[2][s] * q, c.v[3][s] * q); o.z = cvt_pk_bf16(c.v[4][s] * q, c.v[5][s] * q); o.w = cvt_pk_bf16(c.v[6][s] * q, c.v[7][s] * q);
        *(u32x4*)(c.dst + (size_t)(4 * ng + s) * c.dld + 8 * kg) = o; }
}
__device__ __forceinline__ void conv_tile(const float* __restrict__ src, int Ks, int Ns, int k0, int n0, bf16_t* __restrict__ dst, int dld, const float* __restrict__ nscale, int lane, const float* __restrict__ kscale = nullptr) {
    ConvT c; conv_tile_load(c, src, Ks, Ns, k0, n0, dst, dld, nscale, lane, kscale); conv_tile_finish(c, lane);
}
__device__ __forceinline__ void conv_plain(const float* src, int Ks, int Ns, int KT, int NT, bf16_t* dst, int dld, int it, int lane, const float* nscale = nullptr, const float* kscale = nullptr) {
    const int kb = it / NT, nb = it % NT;
    conv_tile(src, Ks, Ns, kb * 64, nb * 32, dst + (size_t)(nb * 32) * dld + kb * 64, dld, nscale, lane, kscale);
}
__device__ __forceinline__ void conv_gateup(const float* src, int half, bf16_t* dst, int it, int lane, const float* gain) {
    constexpr int NT = FF / 32; const int kb = it / NT, nb = it % NT, n0 = nb * 32;
    conv_tile(src, D, FF, kb * 64, n0, dst + (size_t)((n0 >> 7) * 256 + half * 128 + (n0 & 127)) * D + kb * 64, D, nullptr, lane, gain);
}

#ifndef EARLY_PCT
#define EARLY_PCT (XR_DN ? 100 : 50)
#endif
#ifndef EARLY2_PCT
#define EARLY2_PCT 100
#endif
constexpr int T_HALF = 3 * (D / 64) * (FF / 32), EARLY_GU = (int)((long long)T_HALF * EARLY_PCT / 100), EARLY_TILES = (int)((long long)T_HALF * EARLY2_PCT / 100);
constexpr int T_HALF0 = 2 * (D / 64) * (FF / 32), EARLY_GU0 = EARLY_GU - (T_HALF - T_HALF0) * 3 / 4;
static_assert(EARLY_GU0 > 0, "first-layer split");
static_assert(EARLY_GU <= EARLY_TILES && EARLY_TILES == T_HALF, "early conversion split: everything not done in the gate/up tail is done in the down tail");
constexpr int QKV_FULL = (M / 256) * (QKVD / 256) % GRID;
constexpr int DN_FULL = 8 * KS_DN;
constexpr int GU_UNITS = (M / 256) * (2 * FF / 256), GU_FULL = GU_UNITS % GRID;
static_assert(GU_FULL > 0, "idle workgroups in the last gate/up round");
__device__ __forceinline__ void conv_ffn_tile(const Frame& F, int l, int which, int r, int LANE) {
    const Args& a = *F.a;
    constexpr int T_GU = (D / 64) * (FF / 32);
    const size_t wo = (size_t)(l * 2 + which) * D * FF; const int wb = (l & 1) * 2 + which;
    bf16_t* wgu = (bf16_t*)(F.ws + WS_WGU + wb * WGU_BYTES); bf16_t* wd = (bf16_t*)(F.ws + WS_WD + wb * WD_BYTES);
    const float* gain = a.in[which == 0 ? I_NF1 : I_NF2] + (size_t)l * D;
    if (r < T_GU) { conv_gateup(a.in[I_WG] + wo, 0, wgu, r, LANE, gain); return; } r -= T_GU;
    if (r < T_GU) { conv_gateup(a.in[I_WU] + wo, 1, wgu, r, LANE, gain); return; } r -= T_GU;
    conv_plain(a.in[I_WDN] + wo, FF, D, FF / 64, D / 32, wd, FF, r, LANE);
}
__device__ __forceinline__ void conv_ffn_tile_load(ConvT& c, const Frame& F, int l, int which, int r, int LANE) {
    const Args& a = *F.a;
    constexpr int T_GU = (D / 64) * (FF / 32), NT = FF / 32;
    const size_t wo = (size_t)(l * 2 + which) * D * FF; const int wb = (l & 1) * 2 + which;
    bf16_t* wgu = (bf16_t*)(F.ws + WS_WGU + wb * WGU_BYTES); bf16_t* wd = (bf16_t*)(F.ws + WS_WD + wb * WD_BYTES);
    const float* gain = a.in[which == 0 ? I_NF1 : I_NF2] + (size_t)l * D;
    if (r < 2 * T_GU) { const int half = r >= T_GU ? 1 : 0; r -= half * T_GU; const int kb = r / NT, nb = r % NT, n0 = nb * 32;
        conv_tile_load(c, a.in[half ? I_WU : I_WG] + wo, D, FF, kb * 64, n0, wgu + (size_t)((n0 >> 7) * 256 + half * 128 + (n0 & 127)) * D + kb * 64, D, nullptr, LANE, gain); return; }
    r -= 2 * T_GU; { const int NTd = D / 32, kb = r / NTd, nb = r % NTd;
        conv_tile_load(c, a.in[I_WDN] + wo, FF, D, kb * 64, nb * 32, wd + (size_t)(nb * 32) * FF + kb * 64, FF, nullptr, LANE, nullptr); }
}
__device__ __forceinline__ void early_convert(const Frame& F, int lnext, int which, int first, int last, int wg0) {
    int tid_ = threadIdx.x; asm volatile("" : "+v"(tid_)); int bid_ = blockIdx.x; asm volatile("" : "+s"(bid_));
    const int LANE = tid_ & 63, WAVE = __builtin_amdgcn_readfirstlane(tid_ >> 6), BID = bid_;
    const int gw = (BID - wg0) * NWAVES + WAVE, NGW = (GRID - wg0) * NWAVES;
    for (int r = first + gw; r < last; r += 2 * NGW) {
        ConvT c0, c1; const bool two = r + NGW < last;
        conv_ffn_tile_load(c0, F, lnext, which, r, LANE);
        if (two) conv_ffn_tile_load(c1, F, lnext, which, r + NGW, LANE);
        conv_tile_finish(c0, LANE);
        if (two) conv_tile_finish(c1, LANE);
    }
}
__device__ __forceinline__ void phase_convert(const Frame& F, int l, int wg0) {
    int tid_ = threadIdx.x; asm volatile("" : "+v"(tid_)); int bid_ = blockIdx.x; asm volatile("" : "+s"(bid_));
    const int TID = tid_, LANE = tid_ & 63, WAVE = __builtin_amdgcn_readfirstlane(tid_ >> 6), BID = bid_; (void)TID; (void)LANE; (void)WAVE; (void)BID;

    const Args& a = *F.a; const int kind = l % 3, j = l / 3;
    if (BID < wg0) return;
    const int gw = (BID - wg0) * NWAVES + WAVE, NGW = (GRID - wg0) * NWAVES;
    constexpr int T_GU = (D / 64) * (FF / 32), T_DN = (FF / 64) * (D / 32);
    const int T_FFN = l == 0 ? T_HALF0 : 0;
    int nmix = 0;
    if (kind == 0) nmix = 4 * (512 / 64) * (512 / 32);
    else if (kind == 1) nmix = (D / 64) * (QKVD / 32) + (D / 64) * (D / 32);
    else nmix = 4 * (D / 64) * (D / 32) + 3 * (D / 64) * (256 / 32) + 3 * (256 / 64) * (D / 32);
    const int total = T_FFN + nmix;
    for (int it = gw; it < total; it += NGW) {
        int r = it;
        if (r < T_FFN) {
            conv_ffn_tile(F, l, 0, r, LANE); continue;
        }
        r -= T_FFN;
        unsigned char* wm = F.ws + (kind == 2 ? WS_WMIX2 : WS_WMIX);
        if (kind == 0) {
            const int g = r / 128; r -= g * 128;
            conv_plain(a.in[I_PW] + ((size_t)(j * 4 + g) * 512) * 512, 512, 512, 8, 16, (bf16_t*)(wm + WM_POOL) + (size_t)g * 512 * 512, 512, r, LANE, a.in[I_PSC] + (size_t)j * D + g * 512);
        } else if (kind == 1) {
            constexpr int T_Q = (D / 64) * (QKVD / 32);
            if (r < T_Q) { conv_plain(a.in[I_AQKV] + (size_t)j * D * QKVD, D, QKVD, D / 64, QKVD / 32, (bf16_t*)(wm + WM_QKV), D, r, LANE, nullptr, a.in[I_NMIX] + (size_t)l * D); continue; } r -= T_Q;
            conv_plain(a.in[I_AWO] + (size_t)j * D * D, D, D, D / 64, D / 32, (bf16_t*)(wm + WM_AO), D, r, LANE);
        } else {
            constexpr int T_SQ = (D / 64) * (D / 32), T_L1 = (D / 64) * (256 / 32), T_L2 = (256 / 64) * (D / 32);
            bf16_t* rw = (bf16_t*)(wm + WM_RW); bf16_t* l2 = (bf16_t*)(wm + WM_L2); bf16_t* ro = (bf16_t*)(wm + WM_RO);
            if (r < T_SQ) { conv_plain(a.in[I_RWR] + (size_t)j * D * D, D, D, D / 64, D / 32, rw, D, r, LANE); continue; } r -= T_SQ;
            if (r < T_SQ) { conv_plain(a.in[I_RWK] + (size_t)j * D * D, D, D, D / 64, D / 32, rw + (size_t)2048 * D, D, r, LANE); continue; } r -= T_SQ;
            if (r < T_SQ) { conv_plain(a.in[I_RWV] + (size_t)j * D * D, D, D, D / 64, D / 32, rw + (size_t)4096 * D, D, r, LANE); continue; } r -= T_SQ;
            if (r < T_SQ) { conv_plain(a.in[I_RWO] + (size_t)j * D * D, D, D, D / 64, D / 32, ro, D, r, LANE); continue; } r -= T_SQ;
            if (r < T_L1) { conv_plain(a.in[I_W1] + (size_t)j * D * 96, D, 96, D / 64, 8, rw + (size_t)6144 * D, D, r, LANE); continue; } r -= T_L1;
            if (r < T_L1) { conv_plain(a.in[I_A1] + (size_t)j * D * 96, D, 96, D / 64, 8, rw + (size_t)6400 * D, D, r, LANE); continue; } r -= T_L1;
            if (r < T_L1) { conv_plain(a.in[I_G1] + (size_t)j * D * 256, D, 256, D / 64, 8, rw + (size_t)6656 * D, D, r, LANE); continue; } r -= T_L1;
            if (r < T_L2) { conv_plain(a.in[I_W2] + (size_t)j * 96 * D, 96, D, 4, D / 32, l2, 256, r, LANE); continue; } r -= T_L2;
            if (r < T_L2) { conv_plain(a.in[I_A2] + (size_t)j * 96 * D, 96, D, 4, D / 32, l2 + (size_t)2048 * 256, 256, r, LANE); continue; } r -= T_L2;
            conv_plain(a.in[I_G2] + (size_t)j * 256 * D, 256, D, 4, D / 32, l2 + (size_t)4096 * 256, 256, r, LANE);
        }
    }
}

struct RowV { f32x4 v[8]; };
__device__ __forceinline__ float row_sumsq(const RowV& r) { float s = 0.f;
#pragma unroll
    for (int jj = 0; jj < 8; ++jj) s += (r.v[jj].x * r.v[jj].x + r.v[jj].y * r.v[jj].y) + (r.v[jj].z * r.v[jj].z + r.v[jj].w * r.v[jj].w);
    return wave_sum(s); }
__device__ __forceinline__ void row_store_x(const Frame& F, int m, const RowV& r, float ss, u64* SSb, int LANE, bool writeX) {
    bf16_t* XR = (bf16_t*)(F.ws + WS_XR);
#pragma unroll
    for (int jj = 0; jj < 8; ++jj) { const size_t off = (size_t)m * D + 4 * (LANE + 64 * jj);
        u32x2 w; w.x = cvt_pk_bf16(r.v[jj].x, r.v[jj].y); w.y = cvt_pk_bf16(r.v[jj].z, r.v[jj].w); *(u32x2*)(XR + off) = w; }
    if (LANE == 0) SSb[m] = (u64)(ss * SS_SCALE);
}
template <int NP> __device__ __forceinline__ float sample_fold_row_t(const Frame& F, int m, RowV& r, int LANE) {
    const float* pp = (const float*)(F.ws + WS_PART) + (size_t)(m - MP) * D;
#pragma unroll
    for (int e = 0; e < 8; ++e) r.v[e] = ld_bf4((const bf16_t*)(F.ws + WS_XR) + (size_t)m * D + 4 * (LANE + 64 * e));
#pragma unroll
    for (int jb = 0; jb < 3; ++jb) {
        f32x4 t[NP > 0 ? NP : 1][3];
#pragma unroll
        for (int p = 0; p < NP; ++p)
#pragma unroll
            for (int e = 0; e < 3; ++e) if (3 * jb + e < 8) t[p][e] = *(const f32x4*)(pp + (size_t)p * 256 * D + 4 * (LANE + 64 * (3 * jb + e)));
#pragma unroll
        for (int p = 0; p < NP; ++p)
#pragma unroll
            for (int e = 0; e < 3; ++e) if (3 * jb + e < 8) r.v[3 * jb + e] += t[p][e];
        asm volatile("" ::: "memory");
    }
    return row_sumsq(r);
}
__device__ __forceinline__ float sample_fold_row(const Frame& F, int m, int nparts, RowV& r, int LANE) {
    if (nparts == 1) return sample_fold_row_t<1>(F, m, r, LANE);
    if (nparts == KS_DN) return sample_fold_row_t<KS_DN>(F, m, r, LANE);
    if (nparts == KS_WO) return sample_fold_row_t<KS_WO>(F, m, r, LANE);
    return sample_fold_row_t<KS_POOL>(F, m, r, LANE);
}
__device__ __forceinline__ void zero_ss(u64* SSb, int TID, int BID) { for (int i = BID * NTHREADS + TID; i < M; i += GRID * NTHREADS) SSb[i] = 0ull; }
#define PH_IDS int tid_ = threadIdx.x; asm volatile("" : "+v"(tid_)); int bid_ = blockIdx.x; asm volatile("" : "+s"(bid_)); \
    const int TID = tid_, LANE = tid_ & 63, WAVE = __builtin_amdgcn_readfirstlane(tid_ >> 6), BID = bid_; (void)TID; (void)LANE; (void)WAVE; (void)BID;
__device__ __forceinline__ u64* ss_buf(const Frame& F, int site) { return (u64*)(F.ws + WS_SS) + (size_t)(site % 3) * M; }

__device__ __forceinline__ void phase_first(const Frame& F) {
    PH_IDS
    const Args& a = *F.a;
    const int gw = BID * NWAVES + WAVE, NGW = gridDim.x * NWAVES;
    for (int m = gw; m < M; m += NGW) {
        const float* src = m < MP ? a.in[I_XP] + (size_t)m * D : a.in[I_XS] + (size_t)(m - MP) * D;
        RowV r;
#pragma unroll
        for (int jj = 0; jj < 8; ++jj) r.v[jj] = *(const f32x4*)(src + 4 * (LANE + 64 * jj));
        const float ss = row_sumsq(r);
        row_store_x(F, m, r, ss, ss_buf(F, 0), LANE, true);
    }
    zero_ss(ss_buf(F, 1), TID, BID);
}
__device__ __forceinline__ void phase_samplefold(const Frame& F, int site, int nparts, bool zero2 = false) {
    PH_IDS
    if (BID < 32) { const int m = MP + BID * 8 + WAVE; RowV r; const float ss = sample_fold_row(F, m, nparts, r, LANE); row_store_x(F, m, r, ss, ss_buf(F, site), LANE, true); }
    zero_ss(ss_buf(F, site + 1), TID, BID);
    if (zero2) zero_ss(ss_buf(F, site + 2), TID, BID);
}
__device__ __forceinline__ void phase_final(const Frame& F, int site, int nparts) {
    PH_IDS
    const Args& a = *F.a;
    const int gw = BID * NWAVES + WAVE, NGW = gridDim.x * NWAVES;
    const u64* SSb = ss_buf(F, site);
    f32x4 g[8];
#pragma unroll
    for (int jj = 0; jj < 8; ++jj) g[jj] = *(const f32x4*)(a.in[I_NFIN] + 4 * (LANE + 64 * jj));
    const bf16_t* XRp = (const bf16_t*)(F.ws + WS_XR);
    if (gw < MS) { const int m = MP + gw; RowV r; const float ss = sample_fold_row(F, m, nparts, r, LANE); const float rstd = 1.0f / sqrtf(ss * (1.0f / D) + RMS_EPS);
#pragma unroll
        for (int jj = 0; jj < 8; ++jj) *(f32x4*)(F.out + (size_t)m * D + 4 * (LANE + 64 * jj)) = r.v[jj] * rstd * g[jj]; }
    static_assert(MP % (GRID * NWAVES) == 0, "prompt rows per wave");
    RowV r; float rstd = ss_rstd(SSb[gw]);
#pragma unroll
    for (int jj = 0; jj < 8; ++jj) r.v[jj] = ld_bf4(XRp + (size_t)gw * D + 4 * (LANE + 64 * jj));
    for (int m = gw; m < MP; m += NGW) {
        RowV rn; float rsn = 0.f; const int mn = m + NGW;
        if (mn < MP) { rsn = ss_rstd(SSb[mn]);
#pragma unroll
            for (int jj = 0; jj < 8; ++jj) rn.v[jj] = ld_bf4(XRp + (size_t)mn * D + 4 * (LANE + 64 * jj)); }
#pragma unroll
        for (int jj = 0; jj < 8; ++jj) *(f32x4*)(F.out + (size_t)m * D + 4 * (LANE + 64 * jj)) = r.v[jj] * rstd * g[jj];
        if (mn < MP) {
#pragma unroll
            for (int jj = 0; jj < 8; ++jj) r.v[jj] = rn.v[jj];
            rstd = rsn; }
    }
}

__device__ __forceinline__ void phase_poolprep(const Frame& F, int l, int site, int nparts) {
    PH_IDS
    const Args& a = *F.a; const int j = l / 3;
    const int gw = BID * NWAVES + WAVE, NGW = gridDim.x * NWAVES;
    const u64* SSb = ss_buf(F, site);
    const float* gain = a.in[I_NMIX] + (size_t)l * D;
    const float* prefix_all = a.in[I_SPOOL] + (size_t)j * 32 * 15 * D;
    f32x4 g[8];
#pragma unroll
    for (int jj = 0; jj < 8; ++jj) g[jj] = *(const f32x4*)(gain + 4 * (LANE + 64 * jj));
    if (BID < 32) {
        const int b = BID, t = WAVE, m = MP + b * 8 + t;
        RowV r; const float ss = sample_fold_row(F, m, nparts, r, LANE); row_store_x(F, m, r, ss, ss_buf(F, site), LANE, true);
        const float rstd = 1.0f / sqrtf(ss * (1.0f / D) + RMS_EPS);
        LAS float* U8 = (LAS float*)F.lds;
#pragma unroll
        for (int jj = 0; jj < 8; ++jj) { r.v[jj] = r.v[jj] * rstd * g[jj]; *(LAS f32x4*)(U8 + t * D + 4 * (LANE + 64 * jj)) = r.v[jj]; }
        __syncthreads();
        const float* pf = prefix_all + (size_t)b * 15 * D;
        float* ps = F.out + O_POOLS + ((size_t)(j * 32 + b) * 15) * D;
#pragma unroll
        for (int jj = 0; jj < 8; ++jj) { const int w = 2 << (jj >> 1); const int col = 4 * (LANE + 64 * jj);
            const f32x4 u = r.v[jj]; f32x4 sacc = u;
            for (int d = 1; d < w; ++d) { const int tt = t - d; sacc += tt >= 0 ? *(const LAS f32x4*)(U8 + tt * D + col) : *(const f32x4*)(pf + (size_t)(15 + tt) * D + col); }
            const f32x4 df = sacc * (1.0f / (float)w) - u;
            u32x2 wv; wv.x = cvt_pk_bf16(df.x, df.y); wv.y = cvt_pk_bf16(df.z, df.w); *(u32x2*)(F.XB + (size_t)m * D + col) = wv;
            *(f32x4*)(ps + (size_t)(7 + t) * D + col) = u;
            if (t < 7) *(f32x4*)(ps + (size_t)t * D + col) = *(const f32x4*)(pf + (size_t)(8 + t) * D + col); }
        __syncthreads();
    }
    {
        LAS f32x4* tile = (LAS f32x4*)F.lds;
        LAS float* rsl = (LAS float*)(F.lds + 47 * 2048);
        for (int rb = BID; rb < MP / 32; rb += gridDim.x) {
            const int m0 = rb * 32, b = m0 >> 12, t0 = m0 & 4095;
            if (TID < 47) { const int t = t0 - 15 + TID; rsl[TID] = t >= 0 ? ss_rstd(SSb[b * SEQ + t]) : 0.f; }
            u32x2 raw[12];
#define PP_LOAD(gi_) do { const int H_ = (2 << (gi_)) - 1, R_ = 32 + H_; _Pragma("unroll") for (int k = 0; k < 12; ++k) { const int idx = TID + k * NTHREADS, r = idx >> 7, c4 = idx & 127, t = t0 - H_ + r; \
                raw[k] = (u32x2){0u, 0u}; if (idx < R_ * 128 && t >= 0) raw[k] = *(const u32x2*)((const bf16_t*)(F.ws + WS_XR) + (size_t)(b * SEQ + t) * D + (gi_) * 512 + 4 * c4); } } while (0)
            PP_LOAD(0);
            __syncthreads();
#pragma unroll 1
            for (int gi = 0; gi < 4; ++gi) {
                const int w = 2 << gi, H = w - 1, R = 32 + H;
#pragma unroll
                for (int k = 0; k < 12; ++k) { const int idx = TID + k * NTHREADS, r = idx >> 7;
                    if (idx < R * 128) tile[idx] = (f32x4){__uint_as_float(raw[k].x << 16), __uint_as_float(raw[k].x & 0xffff0000u), __uint_as_float(raw[k].y << 16), __uint_as_float(raw[k].y & 0xffff0000u)} * rsl[15 - H + r]; }
                __syncthreads();
                if (gi < 3) PP_LOAD(gi + 1);
                { const int c4 = TID & 127, rq = TID >> 7, col = gi * 512 + 4 * c4;
                  const f32x4 gv = *(const f32x4*)(gain + col);
                  f32x4 sacc = (f32x4){0.f, 0.f, 0.f, 0.f};
                  for (int d = 0; d < H; ++d) sacc += tile[(rq * 8 + d) * 128 + c4];
#pragma unroll
                  for (int rr = 0; rr < 8; ++rr) { const int r = rq * 8 + rr + H, t = t0 + rq * 8 + rr, m = m0 + rq * 8 + rr;
                      const f32x4 u = tile[r * 128 + c4];
                      sacc += u;
                      const int cnt = t + 1 < w ? t + 1 : w;
                      const f32x4 ug = u * gv, df = sacc * gv * (1.0f / (float)cnt) - ug;
                      u32x2 wv; wv.x = cvt_pk_bf16(df.x, df.y); wv.y = cvt_pk_bf16(df.z, df.w); *(u32x2*)(F.XB + (size_t)m * D + col) = wv;
                      if (t >= SEQ - 15) *(f32x4*)(F.out + O_POOLP + ((size_t)(j * 2 + b) * 15 + (t - (SEQ - 15))) * D + col) = ug;
                      sacc -= tile[(r - H) * 128 + c4]; } }
                __syncthreads();
            }
#undef PP_LOAD
        }
    }
    zero_ss(ss_buf(F, site + 1), TID, BID); zero_ss(ss_buf(F, site + 2), TID, BID);
}

__device__ __forceinline__ void rwkv_mix_store(const Frame& F, int m, int col, const f32x4& u, const f32x4& p, const float* mu) {
    bf16_t* mix6 = (bf16_t*)(F.ws + WS_MIX6);
    const f32x4 dx = p - u;
#pragma unroll
    for (int s = 0; s < 6; ++s) { const int mi = s == 0 ? 0 : s == 1 ? 2 : s == 2 ? 3 : s == 3 ? 1 : s;
        const f32x4 o = u + dx * *(const f32x4*)(mu + (size_t)mi * D + col);
        u32x2 wv; wv.x = cvt_pk_bf16(o.x, o.y); wv.y = cvt_pk_bf16(o.z, o.w); *(u32x2*)(mix6 + ((size_t)s * M + m) * D + col) = wv; }
}
__device__ __forceinline__ void phase_rwkvmix(const Frame& F, int l, int site, int nparts) {
    PH_IDS
    const Args& a = *F.a; const int j = l / 3;
    const int gw = BID * NWAVES + WAVE, NGW = gridDim.x * NWAVES;
    const u64* SSb = ss_buf(F, site);
    const float* gain = a.in[I_NMIX] + (size_t)l * D;
    const float* mu = a.in[I_MU] + (size_t)j * 6 * D;
    f32x4 g[8];
#pragma unroll
    for (int jj = 0; jj < 8; ++jj) g[jj] = *(const f32x4*)(gain + 4 * (LANE + 64 * jj));
    if (BID < 32) {
        const int b = BID, t = WAVE, m = MP + b * 8 + t;
        RowV r; const float ss = sample_fold_row(F, m, nparts, r, LANE); row_store_x(F, m, r, ss, ss_buf(F, site), LANE, true);
        const float rstd = 1.0f / sqrtf(ss * (1.0f / D) + RMS_EPS);
        LAS float* U8 = (LAS float*)F.lds;
#pragma unroll
        for (int jj = 0; jj < 8; ++jj) { r.v[jj] = r.v[jj] * rstd * g[jj]; *(LAS f32x4*)(U8 + t * D + 4 * (LANE + 64 * jj)) = r.v[jj]; }
        __syncthreads();
#pragma unroll
        for (int jj = 0; jj < 8; ++jj) { const int col = 4 * (LANE + 64 * jj);
            const f32x4 p = t > 0 ? *(const LAS f32x4*)(U8 + (t - 1) * D + col) : *(const f32x4*)(a.in[I_SSHIFT] + ((size_t)j * 32 + b) * D + col);
            rwkv_mix_store(F, m, col, r.v[jj], p, mu);
            if (t == 7) *(f32x4*)(F.out + O_SHS + ((size_t)j * 32 + b) * D + col) = r.v[jj]; }
        __syncthreads();
    }
    for (int rb = BID; rb < MP / 32; rb += gridDim.x) {
        const int half = WAVE >> 2, wq = WAVE & 3, col = 8 * (LANE + 64 * wq);
        const int m0 = rb * 32 + 16 * half, b = m0 >> 12, t0 = m0 & 4095;
        bf16_t* mix6 = (bf16_t*)(F.ws + WS_MIX6); const bf16_t* XRp = (const bf16_t*)(F.ws + WS_XR);
        f32x4 mu6[6][2];
#pragma unroll
        for (int s6 = 0; s6 < 6; ++s6) { const int mi = s6 == 0 ? 0 : s6 == 1 ? 2 : s6 == 2 ? 3 : s6 == 3 ? 1 : s6; mu6[s6][0] = *(const f32x4*)(mu + (size_t)mi * D + col); mu6[s6][1] = *(const f32x4*)(mu + (size_t)mi * D + col + 4); }
        const f32x4 gv0 = *(const f32x4*)(gain + col), gv1 = *(const f32x4*)(gain + col + 4);
#define RM_UNPACK(w_, lo_, hi_) do { lo_ = (f32x4){__uint_as_float((w_).x << 16), __uint_as_float((w_).x & 0xffff0000u), __uint_as_float((w_).y << 16), __uint_as_float((w_).y & 0xffff0000u)}; \
        hi_ = (f32x4){__uint_as_float((w_).z << 16), __uint_as_float((w_).z & 0xffff0000u), __uint_as_float((w_).w << 16), __uint_as_float((w_).w & 0xffff0000u)}; } while (0)
        u32x4 raw[16]; float rs[16]; u32x4 rawp = (u32x4){0u, 0u, 0u, 0u}; float rsp = 0.f;
        if (t0 > 0) { rawp = *(const u32x4*)(XRp + (size_t)(m0 - 1) * D + col); rsp = ss_rstd(SSb[m0 - 1]); }
#pragma unroll
        for (int q = 0; q < 16; ++q) { raw[q] = *(const u32x4*)(XRp + (size_t)(m0 + q) * D + col); rs[q] = ss_rstd(SSb[m0 + q]); }
        f32x4 p0, p1; RM_UNPACK(rawp, p0, p1); p0 = p0 * rsp * gv0; p1 = p1 * rsp * gv1;
#pragma unroll
        for (int q = 0; q < 16; ++q) { const int m = m0 + q;
            f32x4 u0, u1; RM_UNPACK(raw[q], u0, u1); u0 = u0 * rs[q] * gv0; u1 = u1 * rs[q] * gv1;
            const f32x4 d0 = p0 - u0, d1 = p1 - u1;
#pragma unroll
            for (int s6 = 0; s6 < 6; ++s6) { const f32x4 o0 = u0 + d0 * mu6[s6][0], o1 = u1 + d1 * mu6[s6][1];
                u32x4 wv; wv.x = cvt_pk_bf16(o0.x, o0.y); wv.y = cvt_pk_bf16(o0.z, o0.w); wv.z = cvt_pk_bf16(o1.x, o1.y); wv.w = cvt_pk_bf16(o1.z, o1.w); *(u32x4*)(mix6 + ((size_t)s6 * M + m) * D + col) = wv; }
            if (t0 + q == SEQ - 1) { float* so = F.out + O_SHP + ((size_t)j * 2 + b) * D + col; *(f32x4*)so = u0; *(f32x4*)(so + 4) = u1; }
            p0 = u0; p1 = u1; }
#undef RM_UNPACK
    }
    zero_ss(ss_buf(F, site + 1), TID, BID); zero_ss(ss_buf(F, site + 2), TID, BID);
}

#ifndef GEMM_ALIGN
#define GEMM_ALIGN true
#endif
#ifndef GEMM_SP2
#define GEMM_SP2 true
#endif
constexpr int AT_KP = 144, AT_VP = 560, AT_PP = 336;
constexpr int AT_K = 0, AT_V = AT_K + 256 * AT_KP, AT_P = AT_V + 64 * AT_VP, AT_B = AT_P + 8 * 16 * AT_PP, AT_END = AT_B + 8 * 128 * 4;
static_assert(AT_END <= RING_BYTES, "attention LDS");
__device__ __forceinline__ void phase_attn(const Frame& F, int j) {
    int tid_ = threadIdx.x; asm volatile("" : "+v"(tid_)); int bid_ = blockIdx.x; asm volatile("" : "+s"(bid_));
    const int TID = tid_, LANE = tid_ & 63, WAVE = __builtin_amdgcn_readfirstlane(tid_ >> 6), BID = bid_; (void)TID; (void)LANE; (void)WAVE; (void)BID;

    const Args& a = *F.a;
    const bf16_t* QKV = (const bf16_t*)(F.ws + WS_QKV);
    LAS unsigned char* lds = F.lds;
    const int lane = LANE, g = WAVE, fr = lane & 15, fq = lane >> 4;
    for (int unit = BID; unit < 256 + 128; unit += gridDim.x) {
        const bool samp = unit >= 256;
        int b, kvh, qblk;
        if (!samp) { b = unit >> 7; kvh = (unit >> 5) & 3; qblk = unit & 31; } else { b = (unit - 256) >> 2; kvh = (unit - 256) & 3; qblk = 1; }
        __syncthreads();
        for (int i = TID; i < 8 * 128; i += NTHREADS) { const int gg = i >> 7, dist = i & 127;
            int bk = dist; if (dist >= 16) { bk = 16 + (int)(logf((float)dist * (1.0f / 16.0f)) / 2.0794415416798357f * 16.0f); bk = bk > 31 ? 31 : bk; }
            ((LAS float*)(lds + AT_B))[i] = a.in[I_RELB][bk * 32 + kvh * 8 + gg]; }
        static_assert(256 * 8 == 4 * NTHREADS, "K/V staging pieces per thread");
#pragma unroll 1
        for (int ih = 0; ih < 2; ++ih) {
        u32x4 kva[2], vva[2];
        if (!samp) {
#pragma unroll
            for (int it = 0; it < 2; ++it) { const int i = TID + (2 * ih + it) * NTHREADS, key = i >> 3, c8 = i & 7, pos = qblk * 128 - 128 + key;
                kva[it] = (u32x4){0u, 0u, 0u, 0u}; vva[it] = kva[it];
                if (pos >= 0) { const bf16_t* rp = QKV + (size_t)(b * SEQ + pos) * QKVD + D + kvh * 64 + c8 * 8; kva[it] = *(const u32x4*)rp; vva[it] = *(const u32x4*)(rp + 256); } } }
#pragma unroll
        for (int it = 0; it < 2; ++it) { const int i = TID + (2 * ih + it) * NTHREADS; const int key = i >> 3, c8 = i & 7;
            u32x4 kv = (u32x4){0u, 0u, 0u, 0u}, vv = kv;
            if (!samp) { const int pos = qblk * 128 - 128 + key;
                if (pos >= 0) { kv = kva[it]; vv = vva[it];
                    if (qblk == 31 && key >= 128) {
                        float* ok = F.out + O_WKP + (((size_t)(j * 2 + b) * 128 + (key - 128)) * 4 + kvh) * 64 + c8 * 8; float* ov = F.out + O_WVP + (ok - (F.out + O_WKP));
                        *(f32x4*)ok = (f32x4){bf2f(kv.x & 0xffff), bf2f(kv.x >> 16), bf2f(kv.y & 0xffff), bf2f(kv.y >> 16)}; *(f32x4*)(ok + 4) = (f32x4){bf2f(kv.z & 0xffff), bf2f(kv.z >> 16), bf2f(kv.w & 0xffff), bf2f(kv.w >> 16)};
                        *(f32x4*)ov = (f32x4){bf2f(vv.x & 0xffff), bf2f(vv.x >> 16), bf2f(vv.y & 0xffff), bf2f(vv.y >> 16)}; *(f32x4*)(ov + 4) = (f32x4){bf2f(vv.z & 0xffff), bf2f(vv.z >> 16), bf2f(vv.w & 0xffff), bf2f(vv.w >> 16)}; } } }
            else if (key < 136) {
                f32x4 k0, k1, v0, v1;
                if (key < 128) { const size_t o = (((size_t)(j * 32 + b) * 128 + key) * 4 + kvh) * 64 + c8 * 8;
                    k0 = *(const f32x4*)(a.in[I_CK] + o); k1 = *(const f32x4*)(a.in[I_CK] + o + 4); v0 = *(const f32x4*)(a.in[I_CV] + o); v1 = *(const f32x4*)(a.in[I_CV] + o + 4);
                    kv.x = cvt_pk_bf16(k0.x, k0.y); kv.y = cvt_pk_bf16(k0.z, k0.w); kv.z = cvt_pk_bf16(k1.x, k1.y); kv.w = cvt_pk_bf16(k1.z, k1.w);
                    vv.x = cvt_pk_bf16(v0.x, v0.y); vv.y = cvt_pk_bf16(v0.z, v0.w); vv.z = cvt_pk_bf16(v1.x, v1.y); vv.w = cvt_pk_bf16(v1.z, v1.w); }
                else { const bf16_t* rp = QKV + (size_t)(MP + b * 8 + (key - 128)) * QKVD + D + kvh * 64 + c8 * 8; kv = *(const u32x4*)rp; vv = *(const u32x4*)(rp + 256);
                    k0 = (f32x4){bf2f(kv.x & 0xffff), bf2f(kv.x >> 16), bf2f(kv.y & 0xffff), bf2f(kv.y >> 16)}; k1 = (f32x4){bf2f(kv.z & 0xffff), bf2f(kv.z >> 16), bf2f(kv.w & 0xffff), bf2f(kv.w >> 16)};
                    v0 = (f32x4){bf2f(vv.x & 0xffff), bf2f(vv.x >> 16), bf2f(vv.y & 0xffff), bf2f(vv.y >> 16)}; v1 = (f32x4){bf2f(vv.z & 0xffff), bf2f(vv.z >> 16), bf2f(vv.w & 0xffff), bf2f(vv.w >> 16)}; }
                if (key >= 8) { const size_t o = (((size_t)(j * 32 + b) * 128 + (key - 8)) * 4 + kvh) * 64 + c8 * 8;
                    *(f32x4*)(F.out + O_WKS + o) = k0; *(f32x4*)(F.out + O_WKS + o + 4) = k1; *(f32x4*)(F.out + O_WVS + o) = v0; *(f32x4*)(F.out + O_WVS + o + 4) = v1; }
            }
            *(LAS u32x4*)(lds + AT_K + key * AT_KP + c8 * 16) = kv;
            const unsigned vw[4] = {vv.x, vv.y, vv.z, vv.w};
#pragma unroll
            for (int e = 0; e < 8; ++e) *(LAS unsigned short*)(lds + AT_V + (c8 * 8 + e) * AT_VP + key * 2) = (unsigned short)(e & 1 ? vw[e >> 1] >> 16 : vw[e >> 1] & 0xffff);
        }
        }
        for (int i = TID; i < 64 * 24; i += NTHREADS) { const int dd = i / 24, kk = 256 + i % 24; *(LAS unsigned short*)(lds + AT_V + dd * AT_VP + kk * 2) = 0; }
        __syncthreads();
        const int hq = kvh * 8 + g;
        const float sink = a.in[I_SINK][j * 32 + hq];
        const LAS float* tbl = (const LAS float*)(lds + AT_B) + g * 128;
        LAS unsigned char* Pw = lds + AT_P + g * 16 * AT_PP;
        const int nqt = samp ? 1 : 8;
        for (int qt = 0; qt < nqt; ++qt) {
            int qrow; if (!samp) qrow = b * SEQ + qblk * 128 + qt * 16 + fr; else qrow = MP + b * 8 + (fr & 7);
            const bf16_t* qp = QKV + (size_t)qrow * QKVD + hq * 64 + fq * 8;
            const bf16x8 q0 = *(const bf16x8*)qp, q1 = *(const bf16x8*)(qp + 32);
            const int kb = 16 * qt;
            f32x4 sacc[9];
#pragma unroll
            for (int kt = 0; kt < 9; ++kt) { sacc[kt] = (f32x4){0.f, 0.f, 0.f, 0.f};
                const LAS unsigned char* kp = lds + AT_K + (kb + kt * 16 + fr) * AT_KP + fq * 16;
                const bf16x8 k0 = *(const LAS bf16x8*)kp, k1 = *(const LAS bf16x8*)(kp + 64);
                sacc[kt] = __builtin_amdgcn_mfma_f32_16x16x32_bf16(q0, k0, sacc[kt], 0, 0, 0);
                sacc[kt] = __builtin_amdgcn_mfma_f32_16x16x32_bf16(q1, k1, sacc[kt], 0, 0, 0); }
            float mx[4] = {-1e30f, -1e30f, -1e30f, -1e30f};
#pragma unroll
            for (int kt = 0; kt < 9; ++kt)
#pragma unroll
                for (int jj = 0; jj < 4; ++jj) { const int qi = qt * 16 + 4 * fq + jj, kj = kb + kt * 16 + fr, dist = qi + 128 - kj;
                    const bool valid = dist >= 0 && dist < 128 && (samp || qblk > 0 || kj >= 128);
                    const float s = valid ? sacc[kt][jj] * 0.125f + tbl[dist & 127] : -1e30f;
                    sacc[kt][jj] = s; mx[jj] = fmaxf(mx[jj], s); }
            float sm[4];
#pragma unroll
            for (int jj = 0; jj < 4; ++jj) { mx[jj] = fmaxf(row16_max(mx[jj]), sink); sm[jj] = 0.f; }
#pragma unroll
            for (int kt = 0; kt < 9; ++kt)
#pragma unroll
                for (int jj = 0; jj < 4; ++jj) { const float p = fast_exp(sacc[kt][jj] - mx[jj]); sm[jj] += p;
                    *(LAS unsigned short*)(Pw + (4 * fq + jj) * AT_PP + (kt * 16 + fr) * 2) = (unsigned short)(cvt_pk_bf16(p, 0.f) & 0xffff); }
#pragma unroll
            for (int jj = 0; jj < 4; ++jj) { *(LAS unsigned short*)(Pw + (4 * fq + jj) * AT_PP + (144 + fr) * 2) = 0; sm[jj] = row16_sum(sm[jj]) + fast_exp(sink - mx[jj]); }
            asm volatile("s_waitcnt lgkmcnt(0)" ::: "memory");
            f32x4 oacc[4];
#pragma unroll
            for (int dt = 0; dt < 4; ++dt) oacc[dt] = (f32x4){0.f, 0.f, 0.f, 0.f};
#pragma unroll
            for (int ks = 0; ks < 5; ++ks) { const bf16x8 pf = *(const LAS bf16x8*)(Pw + fr * AT_PP + (ks * 32 + fq * 8) * 2);
#pragma unroll
                for (int dt = 0; dt < 4; ++dt) { const bf16x8 vf = *(const LAS bf16x8*)(lds + AT_V + (dt * 16 + fr) * AT_VP + (kb + ks * 32 + fq * 8) * 2);
                    oacc[dt] = __builtin_amdgcn_mfma_f32_16x16x32_bf16(pf, vf, oacc[dt], 0, 0, 0); } }
#pragma unroll
            for (int jj = 0; jj < 4; ++jj) { const float inv = 1.0f / sm[jj]; const int ql = 4 * fq + jj;
                int orow; bool ok = true; if (!samp) orow = b * SEQ + qblk * 128 + qt * 16 + ql; else { orow = MP + b * 8 + (ql & 7); ok = ql < 8; }
                if (ok) {
#pragma unroll
                    for (int dt = 0; dt < 4; ++dt) F.XB[(size_t)orow * D + hq * 64 + dt * 16 + fr] = (bf16_t)(cvt_pk_bf16(oacc[dt][jj] * inv, 0.f) & 0xffff); } }
            asm volatile("s_waitcnt lgkmcnt(0)" ::: "memory");
        }
    }
}

constexpr int SC_TS = 32, SC_VEC = 0, SC_VQ = 5 * SC_TS * 64 * 4, SC_SC = SC_VQ + SC_TS * 16 * 4, SC_BUF = SC_SC + (SC_TS + 1) * 4 * 4 + 64;
static_assert(2 * SC_BUF <= RING_BYTES && SC_BUF % 16 == 0, "scan LDS");
struct ScanChunk { int m0, n, h, q; bool first, last, samp; int b; };
__device__ __forceinline__ ScanChunk scan_chunk(int ci, int w) {
    ScanChunk c;
    if (ci < 128) { const int pc = w & 63; c.b = pc >> 5; c.h = pc & 31; c.q = w >> 6; c.m0 = c.b * SEQ + ci * SC_TS; c.n = SC_TS; c.first = ci == 0; c.last = ci == 127; c.samp = false; }
    else { const int sc = (ci - 128) * 64 + (w & 63); c.q = w >> 6; c.b = sc >> 5; c.h = sc & 31; c.m0 = MP + c.b * 8; c.n = 8; c.first = true; c.last = true; c.samp = true; }
    return c;
}
struct ScanRegs { f32x4 r[2], k[2], w[2], a[2], v; };
template <int CTRL> __device__ __forceinline__ float dpp_t(float x) { return __int_as_float(__builtin_amdgcn_update_dpp(0, __float_as_int(x), CTRL, 0xf, 0xf, false)); }
__device__ __forceinline__ float oct_sum(float x) { x += dpp_t<0xB1>(x); x += dpp_t<0x4E>(x); x += dpp_t<0x141>(x); return x; }
__device__ __forceinline__ void scan_issue(const Frame& F, const ScanChunk& c, ScanRegs& g, const int ptid) {
    const bf16_t* R = (const bf16_t*)(F.ws + WS_RKV); const bf16_t* Kx = R + (size_t)M * D; const bf16_t* V = Kx + (size_t)M * D;
    const float* DEC = (const float*)(F.ws + WS_LUP); const float* AIC = DEC + (size_t)M * D;
    const int s = ptid >> 3, cg = ptid & 7;
    if (s < c.n) { const size_t base = (size_t)(c.m0 + s) * D + c.h * 64 + cg * 8;
#pragma unroll
        for (int e = 0; e < 2; ++e) { g.r[e] = ld_bf4(R + base + 4 * e); g.k[e] = ld_bf4(Kx + base + 4 * e); g.w[e] = *(const f32x4*)(DEC + base + 4 * e); g.a[e] = *(const f32x4*)(AIC + base + 4 * e); }
        g.v = ld_bf4(V + (size_t)(c.m0 + s) * D + c.h * 64 + c.q * 16 + (cg & 3) * 4); }
}
__device__ __forceinline__ void scan_derive(const Frame& F, const ScanChunk& c, const ScanRegs& g, LAS unsigned char* buf, int j, const int ptid) {
    const Args& a = *F.a;
    float* BON = (float*)(F.ws + WS_BONUS);
    const int s = ptid >> 3, cg = ptid & 7;
    if (s < c.n) {
        const size_t pc = (size_t)j * D + c.h * 64 + cg * 8;
        float n2 = 0.f, sbr = 0.f, kr = 0.f, bon = 0.f;
        LAS float* vec = (LAS float*)(buf + SC_VEC) + s * 64 + cg * 8;
#pragma unroll
        for (int e = 0; e < 2; ++e) {
            const f32x4 k_k = *(const f32x4*)(a.in[I_KK] + pc + 4 * e), k_a = *(const f32x4*)(a.in[I_KA] + pc + 4 * e), r_k = *(const f32x4*)(a.in[I_RK] + pc + 4 * e);
            const f32x4 r = g.r[e], k = g.k[e], w = g.w[e], ai = g.a[e];
            const f32x4 kk = k * k_k, km = k * ((ai - 1.0f) * k_a + 1.0f), bb = kk * ai, wr = w * r;
            const f32x4 t0 = kk * kk, t1 = bb * r, t2 = km * r, t3 = t2 * r_k;
            n2 += (t0.x + t0.y) + (t0.z + t0.w); sbr += (t1.x + t1.y) + (t1.z + t1.w); kr += (t2.x + t2.y) + (t2.z + t2.w); bon += (t3.x + t3.y) + (t3.z + t3.w);
            *(LAS f32x4*)(vec + (0 * SC_TS) * 64 + 4 * e) = kk; *(LAS f32x4*)(vec + (1 * SC_TS) * 64 + 4 * e) = wr; *(LAS f32x4*)(vec + (2 * SC_TS) * 64 + 4 * e) = w;
            *(LAS f32x4*)(vec + (3 * SC_TS) * 64 + 4 * e) = bb; *(LAS f32x4*)(vec + (4 * SC_TS) * 64 + 4 * e) = km;
        }
        n2 = oct_sum(n2); sbr = oct_sum(sbr); kr = oct_sum(kr); bon = oct_sum(bon);
        if (cg < 4) *(LAS f32x4*)((LAS float*)(buf + SC_VQ) + s * 16 + cg * 4) = g.v;
        if (cg == 0) { *(LAS f32x4*)((LAS float*)(buf + SC_SC) + s * 4) = (f32x4){1.0f / fmaxf(n2, 1e-24f), sbr, kr, 0.f}; if (c.q == 0) BON[(size_t)(c.m0 + s) * 32 + c.h] = bon; }
    }
}
__device__ __forceinline__ void phase_scan(const Frame& F, int j) {
    int tid_ = threadIdx.x; asm volatile("" : "+v"(tid_)); int bid_ = blockIdx.x; asm volatile("" : "+s"(bid_));
    const int LANE = tid_ & 63, WAVE = __builtin_amdgcn_readfirstlane(tid_ >> 6), BID = bid_;
    const Args& a = *F.a;
    float* Y = (float*)(F.ws + WS_Y);
    const int w = BID, lane = LANE, wave = WAVE, rg = lane >> 4, c4 = lane & 15;
    constexpr int CI0 = 128, NCH = 128 + 16;
    __syncthreads();
    if (wave >= 4) {
        const int ptid = tid_ - 256;
        ScanRegs ga, gb;
        { const ScanChunk c0 = scan_chunk(CI0, w); scan_issue(F, c0, ga, ptid); scan_derive(F, c0, ga, F.lds + (CI0 & 1) * SC_BUF, j, ptid); }
        { const ScanChunk c1 = scan_chunk(CI0 + 1, w); scan_issue(F, c1, ga, ptid); }
        __syncthreads();
        for (int ci = CI0; ci < NCH; ++ci) {
            if (ci + 2 < NCH) { const ScanChunk c2 = scan_chunk(ci + 2, w); scan_issue(F, c2, gb, ptid); }
            asm volatile("" ::: "memory");
            if (ci + 1 < NCH) { const ScanChunk c1 = scan_chunk(ci + 1, w); scan_derive(F, c1, ga, F.lds + ((ci + 1) & 1) * SC_BUF, j, ptid); }
            ga = gb;
            __syncthreads();
        }
    } else {
        const float* SW = a.in[I_SWKV] + (size_t)j * 32 * 32 * 4096;
        f32x4 Sn;
        { const ScanChunk c0 = scan_chunk(CI0, w); Sn = *(const f32x4*)(SW + (((size_t)c0.b * 32 + c0.h) * 64 + c0.q * 16 + wave * 4 + rg) * 64 + 4 * c4); }
        __syncthreads();
        f32x4 S = (f32x4){0.f, 0.f, 0.f, 0.f};
        for (int ci = CI0; ci < NCH; ++ci) {
            LAS unsigned char* buf = F.lds + (ci & 1) * SC_BUF;
            const ScanChunk c = scan_chunk(ci, w);
            const int row = c.q * 16 + wave * 4 + rg;
            const size_t soff = (((size_t)c.b * 32 + c.h) * 64 + row) * 64 + 4 * c4;
            if (c.first) { if (c.samp) S = Sn; else S = (f32x4){0.f, 0.f, 0.f, 0.f}; }
            if (ci + 1 < NCH) { const ScanChunk cn = scan_chunk(ci + 1, w); if (cn.samp) Sn = *(const f32x4*)(SW + (((size_t)cn.b * 32 + cn.h) * 64 + cn.q * 16 + wave * 4 + rg) * 64 + 4 * c4); }
            const LAS float* vec = (const LAS float*)(buf + SC_VEC) + 4 * c4; const LAS float* vq = (const LAS float*)(buf + SC_VQ) + wave * 4 + rg; const LAS float* scl = (const LAS float*)(buf + SC_SC);
            float* yp = Y + (size_t)(c.m0 + c4) * D + c.h * 64 + row;
            float ycap = 0.f;
            f32x4 Akk, Awr, Awd, Abb, Akm, Asc, Bkk, Bwr, Bwd, Bbb, Bkm, Bsc; float Avv, Bvv;
#define SC_LOAD(P, s_) do { P##kk = *(const LAS f32x4*)(vec + (0 * SC_TS + (s_)) * 64); P##wr = *(const LAS f32x4*)(vec + (1 * SC_TS + (s_)) * 64); P##wd = *(const LAS f32x4*)(vec + (2 * SC_TS + (s_)) * 64); \
        P##bb = *(const LAS f32x4*)(vec + (3 * SC_TS + (s_)) * 64); P##km = *(const LAS f32x4*)(vec + (4 * SC_TS + (s_)) * 64); P##sc = *(const LAS f32x4*)(scl + (s_) * 4); P##vv = vq[(s_) * 16]; } while (0)
#define SC_STEP(P, s_) do { float p = (S.x * P##kk.x + S.y * P##kk.y) + (S.z * P##kk.z + S.w * P##kk.w); float qv = (S.x * P##wr.x + S.y * P##wr.y) + (S.z * P##wr.z + S.w * P##wr.w); \
        p = row16_sum(p); qv = row16_sum(qv); const float sa2 = -P##sc.x * p; const float y = qv + sa2 * P##sc.y + P##vv * P##sc.z; \
        S = S * P##wd + P##bb * sa2 + P##km * P##vv; ycap = (((s_) & 15) == c4) ? y : ycap; } while (0)
            SC_LOAD(A, 0);
            for (int s = 0; s < c.n; s += 2) {
                SC_LOAD(B, s + 1);
                SC_STEP(A, s);
                SC_LOAD(A, s + 2);
                SC_STEP(B, s + 1);
                if (((s + 2) & 15) == 0 || s + 2 == c.n) { if (c4 < ((c.n < 16) ? c.n : 16)) yp[(size_t)((s + 2 - 1) & ~15) * D] = ycap; }
            }
#undef SC_LOAD
#undef SC_STEP
            if (c.last) { float* fo = F.out + (c.samp ? O_WKVS : O_WKVP) + soff; *(f32x4*)fo = S; }
            __syncthreads();
        }
    }
}

constexpr int CK_OPP = 144, CK_SLOT = 64 * CK_OPP, CK_FP = 65, CK_F0 = 14 * CK_SLOT, CK_F1 = CK_F0 + 64 * CK_FP * 4, CK_END = CK_F1 + 64 * CK_FP * 4;
static_assert(CK_END <= MISC_OFF, "chunk-scan LDS");
__device__ __forceinline__ void ck_mm(LAS unsigned char* lds, int aslot, int bslot, int rt, int ct0, int l15, int quad, f32x4 (&acc)[2]) {
    const LAS unsigned char* ap = lds + aslot * CK_SLOT + (rt * 16 + l15) * CK_OPP + quad * 16;
    const bf16x8 a0 = *(const LAS bf16x8*)ap, a1 = *(const LAS bf16x8*)(ap + 64);
#pragma unroll
    for (int cc = 0; cc < 2; ++cc) { const LAS unsigned char* bp = lds + bslot * CK_SLOT + ((ct0 + cc) * 16 + l15) * CK_OPP + quad * 16;
        const bf16x8 b0 = *(const LAS bf16x8*)bp, b1 = *(const LAS bf16x8*)(bp + 64);
        acc[cc] = __builtin_amdgcn_mfma_f32_16x16x32_bf16(a0, b0, acc[cc], 0, 0, 0);
        acc[cc] = __builtin_amdgcn_mfma_f32_16x16x32_bf16(a1, b1, acc[cc], 0, 0, 0); }
}
__device__ __forceinline__ void ck_mm_t(LAS unsigned char* lds, int aslot, int bslot, int rt, int ct0, int l15, int quad, f32x4 (&acc)[2]) {
    const LAS unsigned char* ap = lds + aslot * CK_SLOT + (rt * 16 + l15) * CK_OPP + quad * 16;
    const bf16x8 a0 = *(const LAS bf16x8*)ap, a1 = *(const LAS bf16x8*)(ap + 64);
#pragma unroll
    for (int cc = 0; cc < 2; ++cc) { const LAS unsigned char* bp = lds + bslot * CK_SLOT + ((ct0 + cc) * 16 + l15) * CK_OPP + quad * 16;
        const bf16x8 b0 = *(const LAS bf16x8*)bp, b1 = *(const LAS bf16x8*)(bp + 64);
        acc[cc] = __builtin_amdgcn_mfma_f32_16x16x32_bf16(b0, a0, acc[cc], 0, 0, 0);
        acc[cc] = __builtin_amdgcn_mfma_f32_16x16x32_bf16(b1, a1, acc[cc], 0, 0, 0); }
}
__device__ __forceinline__ void ck_st_rm(LAS unsigned char* lds, int slot, int rt, int ct, int l15, int quad, const f32x4& v) {
#pragma unroll
    for (int g = 0; g < 4; ++g) *(LAS unsigned short*)(lds + slot * CK_SLOT + (rt * 16 + quad * 4 + g) * CK_OPP + (ct * 16 + l15) * 2) = (unsigned short)(cvt_pk_bf16(v[g], 0.f) & 0xffffu);
}
__device__ __forceinline__ void ck_st_tr(LAS unsigned char* lds, int slot, int rt, int ct, int l15, int quad, const f32x4& v) {
    u32x2 w; w.x = cvt_pk_bf16(v[0], v[1]); w.y = cvt_pk_bf16(v[2], v[3]);
    *(LAS u32x2*)(lds + slot * CK_SLOT + (ct * 16 + l15) * CK_OPP + (rt * 16 + quad * 4) * 2) = w;
}
__device__ __forceinline__ void ck_st_rm_t(LAS unsigned char* lds, int slot, int rt, int ct, int l15, int quad, const f32x4& v) {
    u32x2 w; w.x = cvt_pk_bf16(v[0], v[1]); w.y = cvt_pk_bf16(v[2], v[3]);
    *(LAS u32x2*)(lds + slot * CK_SLOT + (rt * 16 + l15) * CK_OPP + (ct * 16 + quad * 4) * 2) = w;
}
#define CK_BAR() do { asm volatile("s_waitcnt lgkmcnt(0)" ::: "memory"); __builtin_amdgcn_s_barrier(); asm volatile("" ::: "memory"); } while (0)
__device__ __forceinline__ void phase_ck1(const Frame& F, int j) {
    int tid_ = threadIdx.x; asm volatile("" : "+v"(tid_)); int bid_ = blockIdx.x; asm volatile("" : "+s"(bid_));
    const int TID = tid_, LANE = tid_ & 63, WAVE = __builtin_amdgcn_readfirstlane(tid_ >> 6), BID = bid_;
    const Args& a = *F.a;
    LAS unsigned char* lds = F.lds;
    const bf16_t* R = (const bf16_t*)(F.ws + WS_RKV); const bf16_t* Kx = R + (size_t)M * D; const bf16_t* V = Kx + (size_t)M * D;
    const float* DEC = (const float*)(F.ws + WS_LUP); const float* AIC = DEC + (size_t)M * D;
    float* BON = (float*)(F.ws + WS_BONUS);
    float* CKA = (float*)(F.ws + WS_CKA); float* CKB = (float*)(F.ws + WS_CKB);
    LAS float* F0 = (LAS float*)(lds + CK_F0); LAS float* F1 = (LAS float*)(lds + CK_F1); LAS float* TOT = (LAS float*)(lds + 8 * CK_SLOT);
    const int t = TID >> 3, cg = TID & 7;
    const int seg = TID >> 6, jj = TID & 63;
    const int l15 = LANE & 15, quad = LANE >> 4, rt = WAVE >> 1, ct0 = (WAVE & 1) * 2;
    f32x4 nr[2], nk[2], nw[2], na[2], nv[2], nkk[2], nka[2], nrk[2];
#define CK_FETCH(item_) do { const int pc_ = (item_) >> 6, c_ = (item_) & 63; const size_t base_ = (size_t)((pc_ >> 5) * SEQ + c_ * 64 + t) * D + (pc_ & 31) * 64 + cg * 8; \
        _Pragma("unroll") for (int e = 0; e < 2; ++e) { nr[e] = ld_bf4(R + base_ + 4 * e); nk[e] = ld_bf4(Kx + base_ + 4 * e); nw[e] = *(const f32x4*)(DEC + base_ + 4 * e); \
            na[e] = *(const f32x4*)(AIC + base_ + 4 * e); nv[e] = ld_bf4(V + base_ + 4 * e); \
            const size_t pb_ = (size_t)j * D + (pc_ & 31) * 64 + cg * 8 + 4 * e; nkk[e] = *(const f32x4*)(a.in[I_KK] + pb_); nka[e] = *(const f32x4*)(a.in[I_KA] + pb_); nrk[e] = *(const f32x4*)(a.in[I_RK] + pb_); } } while (0)
    CK_FETCH(BID);
    for (int it = 0; it < 16; ++it) {
        const int item = it * 256 + BID, pc = item >> 6, c = item & 63, b = pc >> 5, h = pc & 31, m0 = b * SEQ + c * 64;
        float kk[8], bb[8], km[8], rr[8], vv[8];
        { const size_t pb = (size_t)j * D + h * 64 + cg * 8;
          float n2 = 0.f, bon = 0.f;
#pragma unroll
          for (int e = 0; e < 2; ++e) {
              const f32x4 r4 = nr[e], k4 = nk[e], w4 = nw[e], a4 = na[e], v4 = nv[e];
              const f32x4 k_k = nkk[e], k_a = nka[e], r_k = nrk[e];
#pragma unroll
              for (int x = 0; x < 4; ++x) { const int i = 4 * e + x; const float kp = k4[x] * k_k[x]; kk[i] = kp; n2 += kp * kp; km[i] = k4[x] * (1.0f + (a4[x] - 1.0f) * k_a[x]); bb[i] = a4[x]; rr[i] = r4[x]; vv[i] = v4[x];
                  bon += r4[x] * km[i] * r_k[x]; F0[t * CK_FP + cg * 8 + i] = __builtin_amdgcn_logf(w4[x]); } }
          n2 = oct_sum(n2); bon = oct_sum(bon);
          const float inv = 1.0f / fmaxf(sqrtf(n2), 1e-12f);
#pragma unroll
          for (int i = 0; i < 8; ++i) { kk[i] *= inv; bb[i] *= kk[i]; }
          if (cg == 0) BON[(size_t)(m0 + t) * 32 + h] = bon; }
        if (it + 1 < 16) CK_FETCH(item + 256);
        CK_BAR();
        float xs[8];
#pragma unroll
        for (int i = 0; i < 8; ++i) { xs[i] = F0[(seg * 8 + i) * CK_FP + jj]; if (i) xs[i] += xs[i - 1]; }
        TOT[seg * 64 + jj] = xs[7];
        CK_BAR();
        { float off = 0.f;
#pragma unroll
          for (int s2 = 0; s2 < 7; ++s2) off += (s2 < seg) ? TOT[s2 * 64 + jj] : 0.f;
#pragma unroll
          for (int i = 0; i < 8; ++i) F0[(seg * 8 + i) * CK_FP + jj] = xs[i] + off; }
        CK_BAR();
        { unsigned pa[4], pbt[4], pk[4], pr[4], pkh[4];
          float av[8], bv[8], kv[8], rv[8], khv[8];
#pragma unroll
          for (int i = 0; i < 8; ++i) { const int col = cg * 8 + i;
              const float lgt = F0[t * CK_FP + col], lgp = t > 0 ? F0[(t - 1) * CK_FP + col] : 0.f, lgL = F0[63 * CK_FP + col];
              const float g = __builtin_amdgcn_exp2f(lgt), gp = __builtin_amdgcn_exp2f(lgp), gi = __builtin_amdgcn_exp2f(-lgt), gh = __builtin_amdgcn_exp2f(lgL - lgt);
              av[i] = -kk[i] * gp; bv[i] = bb[i] * gi; kv[i] = km[i] * gi; rv[i] = rr[i] * g; khv[i] = km[i] * gh;
              F1[t * CK_FP + col] = rv[i];
              *(LAS unsigned short*)(lds + 4 * CK_SLOT + col * CK_OPP + t * 2) = (unsigned short)(cvt_pk_bf16(av[i], 0.f) & 0xffffu);
              *(LAS unsigned short*)(lds + 5 * CK_SLOT + col * CK_OPP + t * 2) = (unsigned short)(cvt_pk_bf16(bb[i] * gh, 0.f) & 0xffffu);
              *(LAS unsigned short*)(lds + 6 * CK_SLOT + col * CK_OPP + t * 2) = (unsigned short)(cvt_pk_bf16(vv[i], 0.f) & 0xffffu); }
#pragma unroll
          for (int i = 0; i < 4; ++i) { pa[i] = cvt_pk_bf16(av[2 * i], av[2 * i + 1]); pbt[i] = cvt_pk_bf16(bv[2 * i], bv[2 * i + 1]); pk[i] = cvt_pk_bf16(kv[2 * i], kv[2 * i + 1]); pr[i] = cvt_pk_bf16(rv[2 * i], rv[2 * i + 1]); pkh[i] = cvt_pk_bf16(khv[2 * i], khv[2 * i + 1]); }
          const int ro = t * CK_OPP + cg * 16;
          *(LAS u32x4*)(lds + 0 * CK_SLOT + ro) = (u32x4){pa[0], pa[1], pa[2], pa[3]}; *(LAS u32x4*)(lds + 1 * CK_SLOT + ro) = (u32x4){pbt[0], pbt[1], pbt[2], pbt[3]};
          *(LAS u32x4*)(lds + 2 * CK_SLOT + ro) = (u32x4){pk[0], pk[1], pk[2], pk[3]}; *(LAS u32x4*)(lds + 3 * CK_SLOT + ro) = (u32x4){pr[0], pr[1], pr[2], pr[3]};
          *(LAS u32x4*)(lds + 7 * CK_SLOT + ro) = (u32x4){pkh[0], pkh[1], pkh[2], pkh[3]}; }
        CK_BAR();
        const f32x4 Z4 = (f32x4){0.f, 0.f, 0.f, 0.f};
        f32x4 TmN[2], TmR[2];
        { f32x4 gabn[2] = {Z4, Z4}, gabt[2] = {Z4, Z4}, gakt[2] = {Z4, Z4}, mbrn[2] = {Z4, Z4}, mkrt[2] = {Z4, Z4};
          ck_mm(lds, 1, 0, rt, ct0, l15, quad, gabn); ck_mm_t(lds, 1, 0, rt, ct0, l15, quad, gabt); ck_mm_t(lds, 2, 0, rt, ct0, l15, quad, gakt); ck_mm(lds, 1, 3, rt, ct0, l15, quad, mbrn); ck_mm_t(lds, 2, 3, rt, ct0, l15, quad, mkrt);
#pragma unroll
          for (int cc = 0; cc < 2; ++cc) { const int ct = ct0 + cc;
#pragma unroll
              for (int g = 0; g < 4; ++g) { const int rown = rt * 16 + quad * 4 + g, coln = ct * 16 + l15, rowt = rt * 16 + l15, colt = ct * 16 + quad * 4 + g;
                  gabn[cc][g] = rown < coln ? gabn[cc][g] : 0.f; mbrn[cc][g] = rown <= coln ? mbrn[cc][g] : 0.f;
                  gabt[cc][g] = rowt < colt ? gabt[cc][g] : 0.f; gakt[cc][g] = rowt < colt ? gakt[cc][g] : 0.f; mkrt[cc][g] = rowt <= colt ? mkrt[cc][g] : 0.f;
                  TmN[cc][g] = gabn[cc][g] + (rown == coln ? 1.0f : 0.f); TmR[cc][g] = gabt[cc][g] + (rowt == colt ? 1.0f : 0.f); }
              ck_st_rm_t(lds, 8, rt, ct, l15, quad, gabt[cc]); ck_st_tr(lds, 9, rt, ct, l15, quad, gabn[cc]); ck_st_rm_t(lds, 10, rt, ct, l15, quad, gakt[cc]);
              ck_st_tr(lds, 11, rt, ct, l15, quad, mbrn[cc]); ck_st_rm_t(lds, 12, rt, ct, l15, quad, mkrt[cc]); ck_st_rm_t(lds, 13, rt, ct, l15, quad, TmR[cc]); } }
        CK_BAR();
        { f32x4 x2n[2] = {Z4, Z4}, x2t[2] = {Z4, Z4};
          ck_mm(lds, 8, 9, rt, ct0, l15, quad, x2n); ck_mm_t(lds, 8, 9, rt, ct0, l15, quad, x2t);
#pragma unroll
          for (int cc = 0; cc < 2; ++cc) { ck_st_rm_t(lds, 0, rt, ct0 + cc, l15, quad, x2t[cc]); ck_st_tr(lds, 1, rt, ct0 + cc, l15, quad, x2n[cc]); } }
        CK_BAR();
#pragma unroll
        for (int k = 0; k < 4; ++k) {
            const int xin = (k & 1) ? 8 : 0, xout = (k & 1) ? 0 : 8, tin = (k & 1) ? 2 : 13, tout = (k & 1) ? 13 : 2;
            f32x4 x2n[2] = {Z4, Z4}, x2t[2] = {Z4, Z4}, tpn[2] = {Z4, Z4}, tpt[2] = {Z4, Z4};
            ck_mm(lds, xin, xin + 1, rt, ct0, l15, quad, x2n); ck_mm_t(lds, xin, xin + 1, rt, ct0, l15, quad, x2t); ck_mm(lds, tin, xin + 1, rt, ct0, l15, quad, tpn); ck_mm_t(lds, tin, xin + 1, rt, ct0, l15, quad, tpt);
#pragma unroll
            for (int cc = 0; cc < 2; ++cc) { TmN[cc] += tpn[cc]; TmR[cc] += tpt[cc];
                ck_st_rm_t(lds, xout, rt, ct0 + cc, l15, quad, x2t[cc]); ck_st_tr(lds, xout + 1, rt, ct0 + cc, l15, quad, x2n[cc]); ck_st_rm_t(lds, tout, rt, ct0 + cc, l15, quad, TmR[cc]); }
            CK_BAR();
        }
        { f32x4 tpn[2] = {Z4, Z4};
          ck_mm(lds, 13, 1, rt, ct0, l15, quad, tpn);
#pragma unroll
          for (int cc = 0; cc < 2; ++cc) { TmN[cc] += tpn[cc]; ck_st_tr(lds, 3, rt, ct0 + cc, l15, quad, TmN[cc]); } }
        CK_BAR();
        { f32x4 w1[2] = {Z4, Z4}, w2[2] = {Z4, Z4};
          ck_mm_t(lds, 4, 3, rt, ct0, l15, quad, w1); ck_mm_t(lds, 10, 3, rt, ct0, l15, quad, w2);
#pragma unroll
          for (int cc = 0; cc < 2; ++cc) { ck_st_rm_t(lds, 8, rt, ct0 + cc, l15, quad, w1[cc]); ck_st_rm_t(lds, 9, rt, ct0 + cc, l15, quad, w2[cc]); } }
        CK_BAR();
        { f32x4 pp[2] = {(f32x4){0.f, 0.f, 0.f, 0.f}, (f32x4){0.f, 0.f, 0.f, 0.f}}, zq[2] = {(f32x4){0.f, 0.f, 0.f, 0.f}, (f32x4){0.f, 0.f, 0.f, 0.f}},
                wh[2] = {(f32x4){0.f, 0.f, 0.f, 0.f}, (f32x4){0.f, 0.f, 0.f, 0.f}}, zy[2] = {(f32x4){0.f, 0.f, 0.f, 0.f}, (f32x4){0.f, 0.f, 0.f, 0.f}};
          ck_mm_t(lds, 8, 5, rt, ct0, l15, quad, pp); ck_mm(lds, 9, 5, rt, ct0, l15, quad, zq); ck_mm_t(lds, 8, 11, rt, ct0, l15, quad, wh); ck_mm(lds, 9, 11, rt, ct0, l15, quad, zy);
          float* gP = CKA + (size_t)item * 8192; float* gW = gP + 4096;
#pragma unroll
          for (int cc = 0; cc < 2; ++cc) { const int ct = ct0 + cc, col = ct * 16 + l15;
              { const int trow = rt * 16 + l15, tcol = ct * 16 + quad * 4;
                f32x4 pv = pp[cc], wv = wh[cc];
#pragma unroll
                for (int g = 0; g < 4; ++g) { pv[g] += (trow == tcol + g) ? __builtin_amdgcn_exp2f(F0[63 * CK_FP + trow]) : 0.f; wv[g] += F1[(tcol + g) * CK_FP + trow]; }
                *(f32x4*)(gP + trow * 64 + tcol) = pv; *(f32x4*)(gW + trow * 64 + tcol) = wv; }
#pragma unroll
              for (int g = 0; g < 4; ++g) { const int row = rt * 16 + quad * 4 + g;
                  zq[cc][g] += bf2f(*(const LAS unsigned short*)(lds + 7 * CK_SLOT + row * CK_OPP + col * 2));
                  zy[cc][g] += bf2f(*(const LAS unsigned short*)(lds + 12 * CK_SLOT + row * CK_OPP + col * 2)); }
              ck_st_tr(lds, 0, rt, ct, l15, quad, zq[cc]); ck_st_tr(lds, 1, rt, ct, l15, quad, zy[cc]); } }
        CK_BAR();
        { f32x4 qq[2] = {(f32x4){0.f, 0.f, 0.f, 0.f}, (f32x4){0.f, 0.f, 0.f, 0.f}}, yl[2] = {(f32x4){0.f, 0.f, 0.f, 0.f}, (f32x4){0.f, 0.f, 0.f, 0.f}};
          ck_mm_t(lds, 6, 0, rt, ct0, l15, quad, qq); ck_mm_t(lds, 6, 1, rt, ct0, l15, quad, yl);
          float* gQ = CKB + (size_t)item * 8192; float* gY = gQ + 4096;
#pragma unroll
          for (int cc = 0; cc < 2; ++cc) { const int o = (rt * 16 + l15) * 64 + (ct0 + cc) * 16 + quad * 4; *(f32x4*)(gQ + o) = qq[cc]; *(f32x4*)(gY + o) = yl[cc]; } }
        CK_BAR();
    }
#undef CK_FETCH
}
__device__ __forceinline__ void phase_ck2(const Frame& F, int j) {
    int tid_ = threadIdx.x; asm volatile("" : "+v"(tid_)); int bid_ = blockIdx.x; asm volatile("" : "+s"(bid_));
    const int LANE = tid_ & 63, WAVE = __builtin_amdgcn_readfirstlane(tid_ >> 6), BID = bid_;
    const float* CKA = (const float*)(F.ws + WS_CKA); const float* CKB = (const float*)(F.ws + WS_CKB);
    float* Y = (float*)(F.ws + WS_Y);
    const int pc = BID & 63, q = BID >> 6, b = pc >> 5, h = pc & 31, mat = WAVE >> 2, ct = WAVE & 3, l15 = LANE & 15, quad = LANE >> 4;
    constexpr int SP = 68;
    LAS float* Sb = (LAS float*)F.lds;
    for (int i = tid_; i < 2 * 16 * SP; i += NTHREADS) Sb[i] = 0.f;
    const float* opB = CKA + (size_t)(pc * 64) * 8192 + mat * 4096 + quad * 64 + ct * 16 + l15;
    const float* opC = CKB + (size_t)(pc * 64) * 8192 + mat * 4096 + (q * 16 + quad * 4) * 64 + ct * 16 + l15;
    float nb[16]; f32x4 nc;
#pragma unroll
    for (int ks = 0; ks < 16; ++ks) nb[ks] = opB[ks * 256];
#pragma unroll
    for (int g = 0; g < 4; ++g) nc[g] = opC[g * 64];
    CK_BAR();
    f32x4 acc = (f32x4){0.f, 0.f, 0.f, 0.f};
    for (int c = 0; c < 64; ++c) {
        float bcur[16];
#pragma unroll
        for (int ks = 0; ks < 16; ++ks) bcur[ks] = nb[ks];
        acc = nc;
        if (c + 1 < 64) {
#pragma unroll
            for (int ks = 0; ks < 16; ++ks) nb[ks] = opB[(size_t)(c + 1) * 8192 + ks * 256];
#pragma unroll
            for (int g = 0; g < 4; ++g) nc[g] = opC[(size_t)(c + 1) * 8192 + g * 64];
        }
        const LAS float* sa = Sb + (c & 1) * 16 * SP + l15 * SP + quad;
        f32x4 acc1 = (f32x4){0.f, 0.f, 0.f, 0.f};
#pragma unroll
        for (int ks = 0; ks < 16; ks += 2) { acc = __builtin_amdgcn_mfma_f32_16x16x4f32(sa[4 * ks], bcur[ks], acc, 0, 0, 0); acc1 = __builtin_amdgcn_mfma_f32_16x16x4f32(sa[4 * ks + 4], bcur[ks + 1], acc1, 0, 0, 0); }
        acc += acc1;
        if (mat == 0) {
            LAS float* sn = Sb + ((c + 1) & 1) * 16 * SP + (quad * 4) * SP + ct * 16 + l15;
#pragma unroll
            for (int g = 0; g < 4; ++g) sn[g * SP] = acc[g];
        } else {
            float* yp = Y + (size_t)(b * SEQ + c * 64 + ct * 16 + l15) * D + h * 64 + q * 16 + quad * 4;
            *(f32x4*)yp = acc;
        }
        CK_BAR();
    }
    if (mat == 0) { float* fo = F.out + O_WKVP + (((size_t)b * 32 + h) * 64 + q * 16 + quad * 4) * 64 + ct * 16 + l15;
#pragma unroll
        for (int g = 0; g < 4; ++g) fo[g * 64] = acc[g]; }
}

__device__ __forceinline__ void phase_rwkvpost(const Frame& F, int j) {
    int tid_ = threadIdx.x; asm volatile("" : "+v"(tid_)); int bid_ = blockIdx.x; asm volatile("" : "+s"(bid_));
    const int TID = tid_, LANE = tid_ & 63, WAVE = __builtin_amdgcn_readfirstlane(tid_ >> 6), BID = bid_; (void)TID; (void)LANE; (void)WAVE; (void)BID;

    const Args& a = *F.a;
    const int gw = BID * NWAVES + WAVE, NGW = gridDim.x * NWAVES;
    const float* Y = (const float*)(F.ws + WS_Y); const bf16_t* V = (const bf16_t*)(F.ws + WS_RKV) + (size_t)2 * M * D; const bf16_t* G = (const bf16_t*)((const float*)(F.ws + WS_LUP) + (size_t)2 * M * D);
    const float* BON = (const float*)(F.ws + WS_BONUS);
    const float* lnw = a.in[I_LNW] + (size_t)j * D; const float* lnb = a.in[I_LNB] + (size_t)j * D;
    for (int m = gw; m < M; m += NGW) {
        f32x4 yv[8]; u32x2 gv[8], vv[8]; float bv[8];
#pragma unroll
        for (int jj = 0; jj < 8; ++jj) { const int col = 4 * (LANE + 64 * jj), head = col >> 6; const size_t off = (size_t)m * D + col;
            yv[jj] = *(const f32x4*)(Y + off); gv[jj] = *(const u32x2*)(G + off); vv[jj] = *(const u32x2*)(V + off); bv[jj] = BON[(size_t)m * 32 + head]; }
#pragma unroll
        for (int jj = 0; jj < 8; ++jj) { const int col = 4 * (LANE + 64 * jj); const size_t off = (size_t)m * D + col;
            const f32x4 y = yv[jj];
            const float mean = row16_sum((y.x + y.y) + (y.z + y.w)) * (1.0f / 64.0f);
            const f32x4 d = y - mean;
            const float var = row16_sum((d.x * d.x + d.y * d.y) + (d.z * d.z + d.w * d.w)) * (1.0f / 64.0f);
            const float rs = 1.0f / sqrtf(var + GN_EPS);
            const f32x4 yn = d * rs * *(const f32x4*)(lnw + col) + *(const f32x4*)(lnb + col);
            const float bon = bv[jj];
            const u32x2 gw2 = gv[jj]; const f32x4 gg = (f32x4){bf2f(gw2.x & 0xffff), bf2f(gw2.x >> 16), bf2f(gw2.y & 0xffff), bf2f(gw2.y >> 16)};
            const u32x2 vw = vv[jj]; const f32x4 v4 = (f32x4){__uint_as_float(vw.x << 16), __uint_as_float(vw.x & 0xffff0000u), __uint_as_float(vw.y << 16), __uint_as_float(vw.y & 0xffff0000u)};
            const f32x4 o = (yn + v4 * bon) * gg;
            u32x2 wv; wv.x = cvt_pk_bf16(o.x, o.y); wv.y = cvt_pk_bf16(o.z, o.w); *(u32x2*)(F.XB + off) = wv; }
    }
}

__global__ void __launch_bounds__(NTHREADS, 2) fwd_kernel(Args args) {
    extern __shared__ __attribute__((aligned(16))) unsigned char lds_raw[];
    Frame F;
    F.lds = (LAS unsigned char*)lds_raw;
    F.a = &args; F.ws = args.ws; F.out = args.out;
    F.X = (float*)(args.ws + WS_X); F.U = (float*)(args.ws + WS_U); F.XB = (bf16_t*)(args.ws + WS_XB);
    volatile LAS unsigned* MISC = (volatile LAS unsigned*)(F.lds + MISC_OFF);
    if (threadIdx.x < 64) MISC[threadIdx.x] = 0u;
    __syncthreads();
    unsigned* ctl = (unsigned*)(args.ws + WS_CTL);
    XcdBarrier bar; bar.bar = ctl + CW_BAR; bar.x = 0; bar.st = nullptr;
    const int lo = args.lo, hi = args.hi;
    const bool use_bar = (hi - lo) > 1;
    if (use_bar) bar = xcd_barrier_post(ctl + CW_BAR, MISC + 8);
    int ph = 0;
#define PHASE(...) do { if (ph >= lo && ph < hi) { { unsigned char* w_ = args.ws; asm volatile("" : "+s"(w_)); F.ws = w_; } __VA_ARGS__; if (ph + 1 < hi) xcd_barrier(bar); } ++ph; } while (0)
    const int G = gridDim.x;
#define c ((int)blockIdx.x)
#define PHASE_R(rep, ...) do { _Pragma("nounroll") for (int r_ = 0; r_ < (rep); ++r_) { PHASE(__VA_ARGS__); } } while (0)
    bf16_t* ACT = (bf16_t*)(F.ws + WS_ACT);

    bf16_t* XR = (bf16_t*)(F.ws + WS_XR);
    for (int l = 0; l < DEPTH; ++l) {
        const int kind = l % 3, j = l / 3, s0 = 3 * l;
        PHASE({ if (kind != 2) phase_convert(F, l, l == 0 ? 0 : 32); if (l == 0) phase_first(F); else phase_samplefold(F, s0, NP_DN); });
        for (int which = 0; which < 2; ++which) {
            if (which == 1) {
                if (kind == 0) {
                    PHASE({ phase_poolprep(F, l, s0 + 1, NP_DN); });
                    PHASE({ g8::Sched<1> S; S.T.init(MP / 256, D / 256, G, c); S.nt = 512 / 64; S.KS = KSE_POOL; S.Ksub = KSUB_POOL; S.A = (const char*)F.XB; S.B = (const char*)(F.ws + WS_WMIX + WM_POOL); S.lda = D; S.ldb = 512;
                            g8::EpiResid E{F.ws, nullptr, 1.0f, (s0 + 2) % 3, 1}; g8::gemm_phase<GEMM_ALIGN, GEMM_SP2, XR_POOL != 0>(F.lds, D, 512, S, E); });
                } else if (kind == 1) {
                    PHASE({ phase_samplefold(F, s0 + 1, NP_DN, true); });
                    PHASE({ g8::Sched<0> S; S.T.init(M / 256, QKVD / 256, G, c); S.nt = D / 64; S.KS = 0; S.Ksub = 0; S.A = (const char*)XR; S.B = (const char*)(F.ws + WS_WMIX + WM_QKV); S.lda = D; S.ldb = D;
                            g8::EpiQKV E{F.ws, args.in[I_ABQKV] + (size_t)j * QKVD, (s0 + 1) % 3}; g8::gemm_phase<GEMM_ALIGN, GEMM_SP2>(F.lds, D, D, S, E);
                            if (l + 1 < DEPTH && (l + 1) % 3 == 2) phase_convert(F, l + 1, QKV_FULL); });
                    PHASE({ phase_attn(F, j); });
                    PHASE({ g8::Sched<0> S; S.T.init(MP / 256, D / 256, G, c); S.nt = D / 64; S.KS = KSE_WO; S.Ksub = KSUB_WO; S.A = (const char*)F.XB; S.B = (const char*)(F.ws + WS_WMIX + WM_AO); S.lda = D; S.ldb = D;
                            g8::EpiResid E{F.ws, args.in[I_ABO] + (size_t)j * D, 1.0f, (s0 + 2) % 3, 1}; g8::gemm_phase<GEMM_ALIGN, GEMM_SP2, XR_WO != 0>(F.lds, D, D, S, E); });
                } else {
                    PHASE({ phase_rwkvmix(F, l, s0 + 1, NP_DN); });
                    PHASE({ g8::Sched<2> S; S.T.init(M / 256, 27, G, c); S.nt = D / 64; S.KS = 0; S.Ksub = 0; S.A = (const char*)(F.ws + WS_MIX6); S.B = (const char*)(F.ws + WS_WMIX2 + WM_RW); S.lda = D; S.ldb = D;
                            g8::EpiRwkv1 E{(float*)(F.ws + WS_RKV), (bf16_t*)(F.ws + WS_HL)}; g8::gemm_phase<GEMM_ALIGN, GEMM_SP2>(F.lds, D, D, S, E); });
                    PHASE({ g8::Sched<3> S; S.T.init((XR_LORA ? MP : M) / 256, 24, G, c); S.nt = 256 / 64;
                            S.KS = 0; S.Ksub = 0; S.A = (const char*)(F.ws + WS_HL); S.B = (const char*)(F.ws + WS_WMIX2 + WM_L2); S.lda = 768; S.ldb = 256;
                            g8::EpiLoraUp E{(float*)(F.ws + WS_LUP), args.in[I_W0] + (size_t)j * D, args.in[I_A0] + (size_t)j * D}; g8::gemm_phase<GEMM_ALIGN, GEMM_SP2, XR_LORA != 0>(F.lds, 768, 256, S, E); });
                    PHASE_R(REP_CK1, { phase_ck1(F, j); });
                    PHASE_R(REP_SCAN, { phase_ck2(F, j); phase_scan(F, j); });
                    PHASE({ phase_rwkvpost(F, j); });
                    PHASE({ g8::Sched<0> S; S.T.init(MP / 256, D / 256, G, c); S.nt = D / 64; S.KS = KSE_WO; S.Ksub = KSUB_WO; S.A = (const char*)F.XB; S.B = (const char*)(F.ws + WS_WMIX2 + WM_RO); S.lda = D; S.ldb = D;
                            g8::EpiResid E{F.ws, nullptr, 1.0f, (s0 + 2) % 3, 1}; g8::gemm_phase<GEMM_ALIGN, GEMM_SP2, XR_WO != 0>(F.lds, D, D, S, E); });
                }
                if (!(kind == 0 ? XR_POOL : XR_WO)) PHASE({ phase_samplefold(F, s0 + 2, kind == 0 ? NP_POOL : NP_WO); });
            }
            const int sin = s0 + (which ? 2 : 0);
            PHASE_R(REP_GU, { g8::Sched<0> S; S.T.init(M / 256, 2 * FF / 256, G, c); S.nt = D / 64; S.KS = 0; S.Ksub = 0; S.A = (const char*)XR; S.B = (const char*)(F.ws + WS_WGU + ((l & 1) * 2 + which) * WGU_BYTES); S.lda = D; S.ldb = D;
                    g8::EpiSwiGLU E{F.ws, sin % 3}; g8::gemm_phase<GEMM_ALIGN, GEMM_SP2>(F.lds, D, D, S, E);
                    if (EARLY_GU > 0 && l + which < DEPTH && (int)blockIdx.x >= GU_FULL) { const bool h0 = l == 0 && which == 0;
                        if (h0) early_convert(F, 0, 0, T_HALF0, T_HALF, GU_FULL);
                        early_convert(F, l + which, 1 - which, 0, h0 ? EARLY_GU0 : EARLY_GU, GU_FULL); } });
            PHASE({ g8::Sched<0> S; S.T.init(MP / 256, D / 256, G, c); S.nt = FF / 64; S.KS = KSE_DN; S.Ksub = KSUB_DN; S.A = (const char*)ACT; S.B = (const char*)(F.ws + WS_WD + ((l & 1) * 2 + which) * WD_BYTES); S.lda = FF; S.ldb = FF;
                    g8::EpiResid E{F.ws, nullptr, 0.5f, (sin + 1) % 3, (which == 0 ? kind == 1 : l + 1 < DEPTH) ? 1 : 0}; g8::gemm_phase<GEMM_ALIGN, GEMM_SP2, XR_DN != 0>(F.lds, FF, FF, S, E);
                    if (EARLY_TILES > EARLY_GU && l + which < DEPTH && (int)blockIdx.x >= DN_FULL) early_convert(F, l + which, 1 - which, (l == 0 && which == 0) ? EARLY_GU0 : EARLY_GU, EARLY_TILES, DN_FULL); });
        }
    }
    PHASE({ phase_final(F, 3 * DEPTH, NP_DN); });
#undef PHASE
#undef PHASE_R
#undef c
}

static int count_phases() { int n = 0; for (int l = 0; l < DEPTH; ++l) { const int kind = l % 3; n += 1 + 2 * (REP_GU + 1) + ((kind == 0 ? XR_POOL : XR_WO) ? 0 : 1) + (kind == 0 ? 2 : kind == 1 ? 4 : 5 + REP_SCAN + REP_CK1); } return n + 1; }
extern "C" void kernel_launch(void* const* d_in, const int* in_sizes, int n_in, void* d_out, int out_size, void* d_ws, size_t ws_size, hipStream_t stream) {
    static int ready = 0;
    if (ready == 0) {
        ready = -1;
        if (n_in != 40 || (size_t)out_size != O_END || ws_size < WS_END) { fprintf(stderr, "kernel_launch: unexpected shapes: n_in %d out %d (want %zu) ws %zu (need %zu)\n", n_in, out_size, (size_t)O_END, ws_size, (size_t)WS_END); return; }
        int dev = 0, cus = 0, per_cu = 0;
        if (hipGetDevice(&dev) != hipSuccess || hipDeviceGetAttribute(&cus, hipDeviceAttributeMultiprocessorCount, dev) != hipSuccess) { fprintf(stderr, "kernel_launch: device query failed\n"); return; }
        if (hipFuncSetAttribute((const void*)fwd_kernel, hipFuncAttributeMaxDynamicSharedMemorySize, LDS_BYTES) != hipSuccess) { fprintf(stderr, "kernel_launch: hipFuncSetAttribute failed\n"); return; }
        if (hipOccupancyMaxActiveBlocksPerMultiprocessor(&per_cu, (const void*)fwd_kernel, NTHREADS, LDS_BYTES) != hipSuccess || per_cu < 1) fprintf(stderr, "kernel_launch: occupancy query says %d blocks per CU\n", per_cu);
        (void)hipGetLastError();
        if (cus < GRID) { fprintf(stderr, "kernel_launch: needs %d CUs, device has %d\n", GRID, cus); return; }
        ready = 1;
    }
    if (ready < 0) return;
    (void)hipMemsetAsync((char*)d_ws + WS_CTL, 0, CTL_ZERO_BYTES, stream);
    Args a{};
    for (int i = 0; i < 40; ++i) a.in[i] = (const float*)d_in[i];
    a.out = (float*)d_out; a.ws = (unsigned char*)d_ws;
    const int NPH = count_phases();
#if N_LAUNCH_MODE == 1
    for (int p = 0; p < NPH; ++p) { a.lo = p; a.hi = p + 1; hipLaunchKernelGGL(fwd_kernel, dim3(GRID), dim3(NTHREADS), LDS_BYTES, stream, a); }
#else
    a.lo = 0; a.hi = NPH; hipLaunchKernelGGL(fwd_kernel, dim3(GRID), dim3(NTHREADS), LDS_BYTES, stream, a);
#endif
    const hipError_t le = hipPeekAtLastError();
    if (le != hipSuccess) fprintf(stderr, "kernel_launch: launch failed: %s\n", hipGetErrorName(le));
}
```

```cpp
#include <hip/hip_runtime.h>
#include <cstdio>
#include <cstdint>

#ifndef N_LAUNCH_MODE
#define N_LAUNCH_MODE 0
#endif

#ifndef REP_CONV
#define REP_CONV 1
#endif
#ifndef REP_GU
#define REP_GU 1
#endif
#ifndef REP_DN
#define REP_DN 1
#endif
#ifndef REP_SCAN
#define REP_SCAN 1
#endif
#ifndef REP_CK1
#define REP_CK1 1
#endif
#ifndef REP_OTHER
#define REP_OTHER 1
#endif
#define LAS __attribute__((address_space(3)))
typedef unsigned short bf16_t;
typedef short bf16x8 __attribute__((ext_vector_type(8)));
typedef float f32x4 __attribute__((ext_vector_type(4)));
typedef float f32x2 __attribute__((ext_vector_type(2)));
typedef unsigned u32x4 __attribute__((ext_vector_type(4)));
typedef unsigned u32x2 __attribute__((ext_vector_type(2)));
typedef unsigned long long u64;
constexpr int KS_DN = 11, KSUB_DN = 512, KS_WO = 4, KSUB_WO = 512, KS_POOL = 2, KSUB_POOL = 256;
#ifndef XR_DN
#define XR_DN 0
#endif
#ifndef XR_WO
#define XR_WO 1
#endif
#ifndef XR_POOL
#define XR_POOL 1
#endif
#ifndef XR_LORA
#define XR_LORA 1
#endif
static_assert(XR_DN == 0, "the extra-row epilogue updates x in place (no partial slab): the down projection keeps its split-K sample sub-units, whose idle workgroups convert weights");
constexpr int KSE_DN = XR_DN ? 0 : KS_DN, KSE_WO = XR_WO ? 0 : KS_WO, KSE_POOL = XR_POOL ? 0 : KS_POOL, NP_DN = XR_DN ? 1 : KS_DN, NP_WO = XR_WO ? 1 : KS_WO, NP_POOL = XR_POOL ? 1 : KS_POOL;
constexpr float SS_SCALE = 1048576.0f, SS_INV = 1.0f / 1048576.0f;
__device__ __forceinline__ float ss_rstd(u64 v) { return 1.0f / sqrtf((float)v * (SS_INV / 2048.0f) + 1e-6f); }

constexpr int D = 2048, FF = 5632, MP = 8192, MS = 256, M = MP + MS, SEQ = 4096, NWAVES = 8, NTHREADS = 512, GRID = 256;
constexpr int NHEAD = 32, HD = 64, QKVD = 2560, DEPTH = 4;
constexpr float RMS_EPS = 1e-6f, GN_EPS = 64e-5f;
constexpr size_t MIXPAD = 8192 + 128, MIXS = (size_t)M * D + MIXPAD;
constexpr size_t O_YP = 0, O_YS = O_YP + (size_t)MP * D, O_POOLP = O_YS + (size_t)MS * D, O_POOLS = O_POOLP + 2 * 2 * 15 * D, O_WKP = O_POOLS + (size_t)2 * 32 * 15 * D,
                 O_WVP = O_WKP + 2 * 128 * 256, O_WKS = O_WVP + 2 * 128 * 256, O_WVS = O_WKS + 32 * 128 * 256, O_SHP = O_WVS + 32 * 128 * 256, O_SHS = O_SHP + 2 * D,
                 O_WKVP = O_SHS + 32 * D, O_WKVS = O_WKVP + (size_t)2 * 32 * 4096, O_END = O_WKVS + (size_t)32 * 32 * 4096;
constexpr size_t MiB = 1u << 20;
constexpr size_t WS_CTL = 0, CTL_ZERO_BYTES = 1 * MiB;
constexpr size_t WS_WGU = 2 * MiB, WGU_BYTES = (size_t)2 * FF * D * 2;
constexpr size_t WS_WD = WS_WGU + 4 * WGU_BYTES, WD_BYTES = (size_t)D * FF * 2;
constexpr size_t WS_WMIX = WS_WD + 4 * WD_BYTES;
constexpr size_t WS_X = WS_WMIX + 40 * MiB, ROWF_BYTES = (size_t)M * D * 4;
constexpr size_t WS_WMIX2 = WS_X;
static_assert(ROWF_BYTES >= 40 * MiB, "second mixer-weight region");
constexpr size_t WS_U = WS_X + ROWF_BYTES;
constexpr size_t WS_XB = WS_U + ROWF_BYTES, ROWB_BYTES = (size_t)M * D * 2;
constexpr size_t WS_BIG = WS_XB + ROWB_BYTES;
constexpr size_t WS_ACT = WS_BIG, WS_QKV = WS_BIG, WS_MIX6 = WS_BIG;
constexpr size_t WS_RKV = WS_MIX6 + 6 * (ROWB_BYTES + MIXPAD * 2), WS_LUP = WS_RKV + 3 * ROWF_BYTES, WS_Y = WS_LUP + 3 * ROWF_BYTES, WS_HL = WS_Y + ROWF_BYTES,
                 WS_BONUS = WS_HL + (size_t)M * 768 * 2, WS_PART = WS_BONUS + 2 * MiB, WS_CKB = WS_PART + 24 * MiB, WS_XR = WS_CKB + 128 * MiB, WS_SS = WS_XR + ROWB_BYTES, WS_END = WS_SS + 1 * MiB;
static_assert((size_t)3 * M * 8 <= 1 * MiB, "SS buffers");
constexpr size_t WS_CKA = WS_MIX6;
static_assert(6 * ROWB_BYTES >= 128 * MiB, "CKA fits over MIX6");
constexpr size_t WM_POOL = 0;
constexpr size_t WM_QKV = 0, WM_AO = (size_t)QKVD * D * 2;
constexpr size_t WM_RW = 0, WM_L2 = (size_t)6912 * D * 2, WM_RO = WM_L2 + (size_t)6144 * 256 * 2;
static_assert(WM_RO + (size_t)D * D * 2 <= 40 * MiB, "mixer weights fit");
constexpr int RING_BYTES = 131072, LDS_BYTES = 163840, MISC_OFF = LDS_BYTES - 256;

constexpr int CW_BAR = 4096;

typedef __bf16 bf16x2_t __attribute__((ext_vector_type(2)));
__device__ __forceinline__ unsigned cvt_pk_bf16(float lo, float hi) { const f32x2 v = {lo, hi}; return __builtin_bit_cast(unsigned, __builtin_convertvector(v, bf16x2_t)); }
__device__ __forceinline__ float bf2f(unsigned short b) { return __uint_as_float(((unsigned)b) << 16); }
__device__ __forceinline__ f32x4 ld_bf4(const bf16_t* p) { const u32x2 w = *(const u32x2*)p; return (f32x4){__uint_as_float(w.x << 16), __uint_as_float(w.x & 0xffff0000u), __uint_as_float(w.y << 16), __uint_as_float(w.y & 0xffff0000u)}; }
__device__ __forceinline__ float wave_sum(float v) {
#pragma unroll
    for (int o = 1; o < 64; o <<= 1) v += __shfl_xor(v, o);
    return v;
}
__device__ __forceinline__ float dpp_ror(float x, int   n);
template <int N> __device__ __forceinline__ float dpp_ror_t(float x) { return __int_as_float(__builtin_amdgcn_update_dpp(0, __float_as_int(x), 0x120 + N, 0xf, 0xf, false)); }
__device__ __forceinline__ float row16_sum(float x) { x += dpp_ror_t<8>(x); x += dpp_ror_t<4>(x); x += dpp_ror_t<2>(x); x += dpp_ror_t<1>(x); return x; }
__device__ __forceinline__ float row16_max(float x) { x = fmaxf(x, dpp_ror_t<8>(x)); x = fmaxf(x, dpp_ror_t<4>(x)); x = fmaxf(x, dpp_ror_t<2>(x)); x = fmaxf(x, dpp_ror_t<1>(x)); return x; }
__device__ __forceinline__ float wave_sum_fast(float x) { x = row16_sum(x); x += __shfl_xor(x, 16); x += __shfl_xor(x, 32); return x; }
__device__ __forceinline__ float fast_exp(float x) { return __builtin_amdgcn_exp2f(x * 1.4426950408889634f); }
__device__ __forceinline__ float fast_sigmoid(float x) { return __builtin_amdgcn_rcpf(1.0f + fast_exp(-x)); }
__device__ __forceinline__ float fast_tanh(float x) { return 1.0f - 2.0f * __builtin_amdgcn_rcpf(1.0f + fast_exp(2.0f * x)); }

#define XB_TMO      128
#define XB_XCNT(j)  (256  + 64 * (j))
#define XB_XSUB(j)  (1280 + 64 * (j))
#define XB_XGEN(j)  (2304 + 64 * (j))
#define XB_TOP      3328
#define XB_TOPGEN   3392
#define XCD_BAR_WORDS 3456
#define XB_SPIN_CAP (1u << 18)
__device__ __forceinline__ unsigned xb_ld(unsigned* p)              { return __hip_atomic_load(p, __ATOMIC_RELAXED, __HIP_MEMORY_SCOPE_AGENT); }
__device__ __forceinline__ unsigned xb_add(unsigned* p, unsigned v) { return __hip_atomic_fetch_add(p, v, __ATOMIC_RELAXED, __HIP_MEMORY_SCOPE_AGENT); }
__device__ __forceinline__ unsigned xb_xcc_id() { return (unsigned)__builtin_amdgcn_s_getreg((3 << 11) | 20) & 0xFu; }
#define XB_SPIN(cond, bar) do { unsigned _sp = 0; while (cond) { __builtin_amdgcn_s_sleep(1); \
    if ((++_sp & 255u) == 0u) { if (xb_ld(&(bar)[XB_TMO])) break; if (_sp > XB_SPIN_CAP) { atomicAdd(&(bar)[XB_TMO], 1u); break; } } } } while (0)
struct XcdBarrier { unsigned* bar; unsigned x; volatile LAS unsigned* st; };
__device__ __forceinline__ XcdBarrier xcd_barrier_post(unsigned* bar, volatile LAS unsigned* st) {
    XcdBarrier b; b.bar = bar; b.x = xb_xcc_id(); b.st = st;
    if (threadIdx.x == 0) (void)xb_add(&bar[XB_XCNT(b.x)], 1u);
    return b;
}
__device__ __forceinline__ void xcd_barrier_complete(unsigned* bar, unsigned x, unsigned& nloc, unsigned& nx) {
    const unsigned G = gridDim.x * gridDim.y * gridDim.z;
    unsigned sum, cnt, mine, sp = 0u;
    for (;;) {
        sum = 0u; cnt = 0u; mine = 0u;
#pragma unroll
        for (unsigned j = 0; j < 16; ++j) { const unsigned c = xb_ld(&bar[XB_XCNT(j)]); sum += c; cnt += (c > 0u) ? 1u : 0u; mine = (j == x) ? c : mine; }
        if (sum == G) break;
        __builtin_amdgcn_s_sleep(1);
        if ((++sp & 255u) == 0u) { if (xb_ld(&bar[XB_TMO])) break; if (sp > XB_SPIN_CAP) { atomicAdd(&bar[XB_TMO], 1u); break; } }
    }
    nloc = mine > 0u ? mine : 1u; nx = cnt > 0u ? cnt : 1u;
}
__device__ __forceinline__ void xcd_barrier(const XcdBarrier& b) {
    asm volatile("s_waitcnt vmcnt(0)" ::: "memory");
    __syncthreads();
    if (threadIdx.x == 0) {
        unsigned* bar = b.bar; asm volatile("" : "+s"(bar));
        __builtin_amdgcn_s_waitcnt(0);
        unsigned nloc = b.st[0], nx = b.st[1];
        if (nloc == 0u) { xcd_barrier_complete(bar, b.x, nloc, nx); b.st[0] = nloc; b.st[1] = nx; }
        const unsigned old = xb_add(&bar[XB_XSUB(b.x)], 1u);
        const unsigned gen = old / nloc;
        if (old + 1u == (gen + 1u) * nloc) {
            __builtin_amdgcn_fence(__ATOMIC_RELEASE, "agent");
            asm volatile("s_waitcnt vmcnt(0)" ::: "memory");
            const unsigned og = xb_add(&bar[XB_TOP], 1u);
            const unsigned tg = og / nx;
            if (og + 1u == (tg + 1u) * nx) xb_add(&bar[XB_TOPGEN], 1u);
            else XB_SPIN(xb_ld(&bar[XB_TOPGEN]) == tg, bar);
            __builtin_amdgcn_fence(__ATOMIC_ACQUIRE, "agent");
            xb_add(&bar[XB_XGEN(b.x)], 1u);
            asm volatile("s_waitcnt vmcnt(0)" ::: "memory");
        } else {
            XB_SPIN(xb_ld(&bar[XB_XGEN(b.x)]) == gen, bar);
            __builtin_amdgcn_fence(__ATOMIC_ACQUIRE, "agent");
            asm volatile("s_waitcnt vmcnt(0)" ::: "memory");
        }
    }
    __syncthreads();
}

namespace g8 {
constexpr int BM = 256, BK = 64, HALF = 128, HTB = HALF * BK * 2, STAGE_BYTES = 8 * HTB, NXCD = 8, WGM = 8;
__host__ __device__ __forceinline__ int lds_byte(int r, int c) { const int st = (r >> 4) * 2 + (c >> 5), rr = r & 15, cc = c & 31, ob = rr * 64 + cc * 2; return st * 1024 + (ob ^ (((ob >> 9) & 1) << 5)); }
__host__ __device__ __forceinline__ void stage_rc(int b, int& R, int& C) { const int st = b / 1024, sb = b % 1024, swz = sb ^ (((sb >> 9) & 1) << 5); R = (st >> 1) * 16 + swz / 64; C = (st & 1) * 32 + (swz % 64) / 2; }
__host__ __device__ __forceinline__ int perm32(int rho) { const int n = rho >> 4, i = rho & 15; return 8 * (i >> 2) + 4 * n + (i & 3); }

struct Unit { const char* A; const char* B; int pm, pn, nt, part; };
struct Tiler {
    int nM, nN, nwg, G, c;
    __device__ void init(int nM_, int nN_, int G_, int c_) { nM = nM_; nN = nN_; nwg = nM * nN; G = G_; c = c_; }
    __device__ bool tile(int i, int& pm, int& pn) const {
        const long L = (long)i * G + c; if (L >= nwg) return false;
        int wgid = (int)L; { const int q = nwg / NXCD, r = nwg % NXCD, xcd = wgid % NXCD, off = wgid / NXCD; wgid = (xcd < r ? xcd * (q + 1) : r * (q + 1) + (xcd - r) * q) + off; }
        const int nig = WGM * nN, gid = wgid / nig, fm = gid * WGM, gsz = (nM - fm) < WGM ? (nM - fm) : WGM;
        pm = fm + ((wgid % nig) % gsz); pn = (wgid % nig) / gsz; return true;
    }
};
template <int MODE> struct Sched {
    Tiler T; const char* A; const char* B; int lda, ldb, nt;
    int KS, Ksub;
    __device__ __forceinline__ bool next(int i, Unit& u) const {
        int pm, pn;
        u.nt = nt; u.part = -1;
        if (KS > 0) {
            const long L = (long)i * T.G + T.c;
            if (L >= T.nwg) { const int sub = (int)(L - T.nwg); if (sub >= T.nN * KS) return false;
                pn = sub % T.nN; const int ks = sub / T.nN; u.pm = T.nM; u.pn = pn; u.nt = Ksub / BK; u.part = ks;
                size_t ao = (size_t)T.nM * BM * lda * 2 + (size_t)ks * Ksub * 2; if (MODE == 1) ao += (size_t)(pn >> 1) * 512 * 2;
                u.A = A + ao; u.B = B + (size_t)pn * BM * ldb * 2 + (size_t)ks * Ksub * 2; return true; }
        }
        if (!T.tile(i, pm, pn)) return false;
        u.pm = pm; u.pn = pn;
        size_t ao = (size_t)pm * BM * lda * 2;
        if (MODE == 1) ao += (size_t)(pn >> 1) * 512 * 2;
        if (MODE == 2) { const int slot = pn < 24 ? (pn >> 3) : (pn - 24 + 3); ao += (size_t)slot * MIXS * 2; }
        if (MODE == 3) ao += (size_t)(pn >> 3) * 256 * 2;
        u.A = A + ao; u.B = B + (size_t)pn * BM * ldb * 2; return true;
    }
};

constexpr int XBASE = 8 * HALF * BK * 2 + 8192, XBUF = 4096;
template <bool ALIGN_EPI, bool SP2, bool XROWS = false, class Epi, class SchedT>
__device__ __forceinline__ void gemm_phase(LAS unsigned char* lds, const int lda, const int ldb, const SchedT& S, const Epi& E) {
    static_assert(SP2 || !XROWS, "extra rows: two-phase schedule only");
    int tid = threadIdx.x; asm volatile("" : "+v"(tid));
    const int wid = __builtin_amdgcn_readfirstlane(tid >> 6), lane = tid & 63, wr = wid >> 2, wc = wid & 3, fr = lane & 15, fq = lane >> 4;
    unsigned voffA, voffB;
    { int R, C; stage_rc(tid * 16, R, C); const int Rb = Epi::PERM ? ((R & ~31) + perm32(R & 31)) : R;
        voffA = (unsigned)(R * lda + C) * 2u; voffB = (unsigned)(Rb * ldb + C) * 2u; }
    const size_t q64voffA = (size_t)64 * lda * 2, q64voffB = (size_t)64 * ldb * 2;
    const size_t kstep = (size_t)(BK * 2);
    const size_t hstepA = (size_t)HALF * lda * 2, hstepB = (size_t)HALF * ldb * 2;
    const unsigned ldsw = (unsigned)wid * 1024u;
    const int aoff = lds_byte(wr * 64 + fr, fq * 8), boff = lds_byte(wc * 32 + fr, fq * 8);
    long xoffu = 0; int ldsx = 0;
    if constexpr (XROWS) { const int sub = wid & 1, kt = (wid >> 1) & 1;
        xoffu = (long)kt * (BK * 2) - (long)(wid >> 1) * 16 * lda * 2; ldsx = XBASE + kt * 2048 + sub * 1024; }
#define PG8_XPTR(u) ((u).A + ((size_t)(MP - (u).pm * BM) + 8 * (u).pm) * lda * 2)
#define PG8_XSTAGE(buf, gbase) do { if constexpr (XROWS) __builtin_amdgcn_global_load_lds((const unsigned*)((const char*)(gbase) + xoffu + voffA), (LAS unsigned*)(lds + ldsx + (buf) * XBUF), 16, 0, 0); } while (0)
#define PG8_LDX(kt, k) do { if constexpr (XROWS) Ax = *(const LAS bf16x8*)(lds + (XBASE + xb * XBUF + (kt) * 2048 + (k) * 1024 - wc * 4096) + boff); } while (0)
#define PG8_XMMA(k) do { if constexpr (XROWS) { __builtin_amdgcn_s_setprio(1); if (wr == 0) { _Pragma("unroll") for (int n = 0; n < 2; ++n) xacc[n] = __builtin_amdgcn_mfma_f32_16x16x32_bf16(B0[n][k], Ax, xacc[n], 0, 0, 0); } \
        else { _Pragma("unroll") for (int n = 0; n < 2; ++n) xacc[n] = __builtin_amdgcn_mfma_f32_16x16x32_bf16(B1[n][k], Ax, xacc[n], 0, 0, 0); } __builtin_amdgcn_s_setprio(0); } } while (0)
#define PG8_SA(b, h) (((b) * 2 + (h)) * HTB)
#define PG8_SB(b, h) ((4 + (b) * 2 + (h)) * HTB)
#define PG8_STAGE(bufoff, gbase, voff) do { \
        __builtin_amdgcn_global_load_lds((const unsigned*)((const char*)(gbase) + (voff)), (LAS unsigned*)(lds + (bufoff) + ldsw), 16, 0, 0); \
        __builtin_amdgcn_global_load_lds((const unsigned*)((const char*)(gbase) + q64##voff + (voff)), (LAS unsigned*)(lds + (bufoff) + ldsw + 8192), 16, 0, 0); } while (0)
#define PG8_LDA(dst, b, h) do { _Pragma("unroll") for (int m = 0; m < 4; ++m) _Pragma("unroll") for (int k = 0; k < 2; ++k) dst[m][k] = *(const LAS bf16x8*)(lds + PG8_SA(b, h) + aoff + m * 2048 + k * 1024); } while (0)
#define PG8_LDB(dst, b, h) do { _Pragma("unroll") for (int n = 0; n < 2; ++n) _Pragma("unroll") for (int k = 0; k < 2; ++k) dst[n][k] = *(const LAS bf16x8*)(lds + PG8_SB(b, h) + boff + n * 2048 + k * 1024); } while (0)
#define PG8_MMA(ai, bj, At, Bt) do { __builtin_amdgcn_s_setprio(1); _Pragma("unroll") for (int m = 0; m < 4; ++m) _Pragma("unroll") for (int n = 0; n < 2; ++n) _Pragma("unroll") for (int k = 0; k < 2; ++k) \
        acc[ai][bj][m][n] = __builtin_amdgcn_mfma_f32_16x16x32_bf16(Bt[n][k], At[m][k], acc[ai][bj][m][n], 0, 0, 0); __builtin_amdgcn_s_setprio(0); } while (0)
#define PG8_WAIT_V(n) asm volatile("s_waitcnt vmcnt(" #n ")" ::: "memory")
#define PG8_WAIT_L(n) asm volatile("s_waitcnt lgkmcnt(" #n ")" ::: "memory")
#define PG8_BAR __builtin_amdgcn_s_barrier()
#define PG8_SCHED __builtin_amdgcn_sched_barrier(0)
    Unit cur, nxt; int ui = 0;
    E.prefetch(S, lds, tid);
    if (!S.next(0, cur)) return;
    f32x4 acc[2][2][4][2];
#pragma unroll
    for (int a = 0; a < 2; ++a)
#pragma unroll
        for (int b = 0; b < 2; ++b)
#pragma unroll
            for (int m = 0; m < 4; ++m)
#pragma unroll
                for (int n = 0; n < 2; ++n) acc[a][b][m][n] = (f32x4){0.f, 0.f, 0.f, 0.f};
    bf16x8 At[4][2], B0[2][2], B1[2][2];
    bf16x8 Ax; f32x4 xacc[2]; int xb = 0;
    if constexpr (XROWS) { xacc[0] = (f32x4){0.f, 0.f, 0.f, 0.f}; xacc[1] = (f32x4){0.f, 0.f, 0.f, 0.f}; }
    const char* cA = cur.A; const char* cB = cur.B;
    const char* cX = PG8_XPTR(cur);
    if constexpr (SP2) {
        PG8_XSTAGE(0, cX);
        PG8_STAGE(PG8_SB(0, 0), cB, voffB); PG8_STAGE(PG8_SB(0, 1), cB + hstepB, voffB); PG8_STAGE(PG8_SA(0, 0), cA, voffA); PG8_STAGE(PG8_SA(0, 1), cA + hstepA, voffA);
        if (wr == 1) PG8_BAR;
        PG8_WAIT_V(2); PG8_BAR;
        PG8_STAGE(PG8_SB(1, 0), cB + kstep, voffB); PG8_STAGE(PG8_SA(1, 0), cA + kstep, voffA); PG8_STAGE(PG8_SB(1, 1), cB + hstepB + kstep, voffB);
        PG8_WAIT_V(6); PG8_BAR;
    } else {
        PG8_STAGE(PG8_SB(0, 0), cB, voffB); PG8_STAGE(PG8_SA(0, 0), cA, voffA); PG8_STAGE(PG8_SB(0, 1), cB + hstepB, voffB); PG8_STAGE(PG8_SA(0, 1), cA + hstepA, voffA);
        if (wr == 1) PG8_BAR;
        PG8_WAIT_V(4); PG8_BAR;
        PG8_STAGE(PG8_SB(1, 0), cB + kstep, voffB); PG8_STAGE(PG8_SA(1, 0), cA + kstep, voffA); PG8_STAGE(PG8_SB(1, 1), cB + hstepB + kstep, voffB);
        PG8_WAIT_V(6); PG8_BAR;
    }
    for (;;) {
        const bool has_next = S.next(ui + 1, nxt);
        const char* nA = has_next ? nxt.A : cA; const char* nB = has_next ? nxt.B : cB;
        const char* nX = has_next ? PG8_XPTR(nxt) : cX;
        const int nt = cur.nt;
#pragma nounroll
        for (int t = 0; t < nt; t += 2) {
            const bool last = (t == nt - 2);
            const char* a1 = cA + (size_t)(t + 1) * kstep;
            const char* a2 = last ? nA : cA + (size_t)(t + 2) * kstep; const char* b2 = last ? nB : cB + (size_t)(t + 2) * kstep;
            const char* a3 = a2 + kstep; const char* b3 = b2 + kstep;
            if constexpr (SP2) {
            const char* x2 = last ? nX : cX + (size_t)(t + 2) * kstep;
            PG8_LDB(B0, 0, 0); PG8_LDB(B1, 0, 1); PG8_LDX(0, 0); PG8_SCHED; PG8_LDA(At, 0, 0); PG8_STAGE(PG8_SA(1, 1), a1 + hstepA, voffA); PG8_XSTAGE(xb ^ 1, x2);
            if constexpr (XROWS) PG8_WAIT_V(9); else PG8_WAIT_V(8);
            PG8_WAIT_L(0); PG8_BAR; PG8_MMA(0, 0, At, B0); PG8_MMA(0, 1, At, B1); PG8_XMMA(0); PG8_BAR; PG8_SCHED;
            PG8_LDA(At, 0, 1); PG8_LDX(0, 1); PG8_STAGE(PG8_SB(0, 0), b2, voffB); PG8_STAGE(PG8_SB(0, 1), b2 + hstepB, voffB); PG8_STAGE(PG8_SA(0, 0), a2, voffA);
            if constexpr (XROWS) PG8_WAIT_V(9); else PG8_WAIT_V(8);
            PG8_WAIT_L(0); PG8_BAR; PG8_MMA(1, 0, At, B0); PG8_MMA(1, 1, At, B1); PG8_XMMA(1); PG8_BAR; PG8_SCHED;
            PG8_LDB(B0, 1, 0); PG8_LDB(B1, 1, 1); PG8_LDX(1, 0); PG8_SCHED; PG8_LDA(At, 1, 0); PG8_STAGE(PG8_SA(0, 1), a2 + hstepA, voffA);
            PG8_WAIT_V(8); PG8_WAIT_L(0); PG8_BAR; PG8_MMA(0, 0, At, B0); PG8_MMA(0, 1, At, B1); PG8_XMMA(0); PG8_BAR; PG8_SCHED;
            PG8_LDA(At, 1, 1); PG8_LDX(1, 1); PG8_STAGE(PG8_SB(1, 0), b3, voffB); PG8_STAGE(PG8_SB(1, 1), b3 + hstepB, voffB); PG8_STAGE(PG8_SA(1, 0), a3, voffA);
            PG8_WAIT_V(8); PG8_WAIT_L(0); PG8_BAR; PG8_MMA(1, 0, At, B0); PG8_MMA(1, 1, At, B1); PG8_XMMA(1); PG8_BAR; PG8_SCHED;
            xb ^= 1;
            } else {
            PG8_LDB(B0, 0, 0); PG8_SCHED; PG8_LDA(At, 0, 0); PG8_STAGE(PG8_SA(1, 1), a1 + hstepA, voffA);
            PG8_WAIT_L(8); PG8_BAR; PG8_WAIT_L(0); PG8_MMA(0, 0, At, B0); PG8_BAR; PG8_SCHED;
            PG8_LDB(B1, 0, 1); PG8_STAGE(PG8_SB(0, 0), b2, voffB);
            PG8_BAR; PG8_WAIT_L(0); PG8_MMA(0, 1, At, B1); PG8_BAR;
            PG8_LDA(At, 0, 1); PG8_STAGE(PG8_SA(0, 0), a2, voffA);
            PG8_BAR; PG8_WAIT_L(0); PG8_MMA(1, 0, At, B0); PG8_BAR; PG8_SCHED;
            PG8_STAGE(PG8_SB(0, 1), b2 + hstepB, voffB);
            PG8_WAIT_V(6); PG8_BAR; PG8_MMA(1, 1, At, B1); PG8_BAR;
            PG8_LDB(B0, 1, 0); PG8_SCHED; PG8_LDA(At, 1, 0); PG8_STAGE(PG8_SA(0, 1), a2 + hstepA, voffA);
            PG8_WAIT_L(8); PG8_BAR; PG8_WAIT_L(0); PG8_MMA(0, 0, At, B0); PG8_BAR; PG8_SCHED;
            PG8_LDB(B1, 1, 1); PG8_STAGE(PG8_SB(1, 0), b3, voffB);
            PG8_BAR; PG8_WAIT_L(0); PG8_MMA(0, 1, At, B1); PG8_BAR;
            PG8_LDA(At, 1, 1); PG8_STAGE(PG8_SA(1, 0), a3, voffA);
            PG8_BAR; PG8_WAIT_L(0); PG8_MMA(1, 0, At, B0); PG8_BAR; PG8_SCHED;
            PG8_STAGE(PG8_SB(1, 1), b3 + hstepB, voffB);
            PG8_WAIT_V(6); PG8_BAR; PG8_MMA(1, 1, At, B1); PG8_BAR;
                    }
        }
        if constexpr (ALIGN_EPI) { if (wr == 0) PG8_BAR; }
        E(acc, cur, wr, wc, fr, fq, ui, lds);
        if constexpr (XROWS) { E.xrows(xacc, cur, wr, wc, fr, fq, ui, lds); xacc[0] = (f32x4){0.f, 0.f, 0.f, 0.f}; xacc[1] = (f32x4){0.f, 0.f, 0.f, 0.f}; }
        if (!has_next) break;
#pragma unroll
        for (int a = 0; a < 2; ++a)
#pragma unroll
            for (int b = 0; b < 2; ++b)
#pragma unroll
                for (int m = 0; m < 4; ++m)
#pragma unroll
                    for (int n = 0; n < 2; ++n) acc[a][b][m][n] = (f32x4){0.f, 0.f, 0.f, 0.f};
        cur = nxt; cA = nA; cB = nB; cX = nX; ++ui;
        if constexpr (ALIGN_EPI) { if (wr == 1) PG8_BAR; }
    }
    PG8_WAIT_V(0);
    if constexpr (!ALIGN_EPI) { if (wr == 0) PG8_BAR; }
    PG8_BAR;
#undef PG8_XPTR
#undef PG8_XSTAGE
#undef PG8_LDX
#undef PG8_XMMA
#undef PG8_SA
#undef PG8_SB
#undef PG8_STAGE
#undef PG8_LDA
#undef PG8_LDB
#undef PG8_MMA
#undef PG8_WAIT_V
#undef PG8_WAIT_L
#undef PG8_BAR
#undef PG8_SCHED
}

struct EpiSwiGLU {
    static constexpr bool PERM = true;
    template <class SchedT> __device__ __forceinline__ void prefetch(const SchedT& S, LAS unsigned char* lds, int tid) const {
        const u64* SS = (const u64*)(ws + WS_SS) + (size_t)ssidx * M; LAS float* RS = (LAS float*)(lds + STAGE_BYTES);
        for (int q = tid; q < 8 * 256; q += NTHREADS) { Unit u; if (S.next(q >> 8, u)) RS[q] = ss_rstd(SS[u.pm * BM + (q & 255)]); }
        asm volatile("s_waitcnt vmcnt(0) lgkmcnt(0)" ::: "memory");
    }
    unsigned char* ws; int ssidx;
    __device__ __forceinline__ void operator()(const f32x4 (&acc)[2][2][4][2], const Unit& u, int wr, int wc, int fr, int fq, int ui, LAS unsigned char* lds) const {
        bf16_t* O = (bf16_t*)(ws + WS_ACT);
        const int row0 = u.pm * BM + wr * 64 + fr, col0 = u.pn * 128 + wc * 32 + 8 * fq;
#pragma unroll
        for (int ai = 0; ai < 2; ++ai)
#pragma unroll
            for (int m = 0; m < 4; ++m) { bf16_t* rowp = O + (size_t)(row0 + ai * HALF + m * 16) * FF + col0;
                const float rs = ((const LAS float*)(lds + STAGE_BYTES))[ui * 256 + wr * 64 + fr + ai * HALF + m * 16];
                float h[8];
#pragma unroll
                for (int n = 0; n < 2; ++n)
#pragma unroll
                    for (int j = 0; j < 4; ++j) { const float g = acc[ai][0][m][n][j] * rs, up = acc[ai][1][m][n][j] * rs; h[n * 4 + j] = g * fast_sigmoid(g) * up; }
                u32x4 w; w.x = cvt_pk_bf16(h[0], h[1]); w.y = cvt_pk_bf16(h[2], h[3]); w.z = cvt_pk_bf16(h[4], h[5]); w.w = cvt_pk_bf16(h[6], h[7]);
                *(u32x4*)rowp = w; }
    }
};
struct EpiResid {
    static constexpr bool PERM = false;
    template <class SchedT> __device__ __forceinline__ void prefetch(const SchedT& S, LAS unsigned char* lds, int tid) const {
        if (bias) { LAS float* BS = (LAS float*)(lds + STAGE_BYTES);
            for (int q = tid; q < 8 * 256; q += NTHREADS) { Unit u; if (S.next(q >> 8, u)) BS[q] = u.part <= 0 ? bias[u.pn * BM + (q & 255)] : 0.f; }
            asm volatile("s_waitcnt vmcnt(0) lgkmcnt(0)" ::: "memory"); }
    }
    __device__ __forceinline__ void xrows(const f32x4 (&xacc)[2], const Unit& u, int wr, int wc, int fr, int fq, int ui, LAS unsigned char* lds) const {
        bf16_t* XR = (bf16_t*)(ws + WS_XR); u64* SS = (u64*)(ws + WS_SS) + (size_t)ssidx * M;
        const int row = MP + 8 * u.pm + (fr & 7);
        float ssq = 0.f;
        if (fr < 8) { bf16_t* p = XR + (size_t)row * D + u.pn * BM + wr * HALF + wc * 32 + 4 * fq;
            u32x2 o[2];
#pragma unroll
            for (int n = 0; n < 2; ++n) o[n] = *(const u32x2*)(p + n * 16);
#pragma unroll
            for (int n = 0; n < 2; ++n) { const f32x4 bv = bias ? *(const LAS f32x4*)((const LAS float*)(lds + STAGE_BYTES) + ui * 256 + wr * HALF + wc * 32 + n * 16 + 4 * fq) : (f32x4){0.f, 0.f, 0.f, 0.f};
                const f32x4 xold = (f32x4){__uint_as_float(o[n].x << 16), __uint_as_float(o[n].x & 0xffff0000u), __uint_as_float(o[n].y << 16), __uint_as_float(o[n].y & 0xffff0000u)};
                const f32x4 xn = xold + xacc[n] * alpha + bv;
                u32x2 w; w.x = cvt_pk_bf16(xn.x, xn.y); w.y = cvt_pk_bf16(xn.z, xn.w); *(u32x2*)(p + n * 16) = w;
                const f32x4 xr = (f32x4){__uint_as_float(w.x << 16), __uint_as_float(w.x & 0xffff0000u), __uint_as_float(w.y << 16), __uint_as_float(w.y & 0xffff0000u)};
                ssq += (xr.x * xr.x + xr.y * xr.y) + (xr.z * xr.z + xr.w * xr.w); } }
        ssq += __shfl_xor(ssq, 16); ssq += __shfl_xor(ssq, 32);
        if (fq == 0 && fr < 8) atomicAdd(SS + row, (u64)(ssq * SS_SCALE));
        asm volatile("" ::: "memory");
    }
    unsigned char* ws; const float* bias; float alpha; int ssidx; int wxr;
    __device__ __forceinline__ void operator()(const f32x4 (&acc)[2][2][4][2], const Unit& u, int wr, int wc, int fr, int fq, int ui, LAS unsigned char* lds) const {
        float* PART = (float*)(ws + WS_PART); bf16_t* XR = (bf16_t*)(ws + WS_XR); u64* SS = (u64*)(ws + WS_SS) + (size_t)ssidx * M;
        const int row0 = u.pm * BM + wr * 64 + fr, col0 = u.pn * BM + wc * 32 + 4 * fq;
        f32x4 bv[2][2];
#pragma unroll
        for (int bj = 0; bj < 2; ++bj)
#pragma unroll
            for (int n = 0; n < 2; ++n) bv[bj][n] = bias ? *(const LAS f32x4*)((const LAS float*)(lds + STAGE_BYTES) + ui * 256 + wc * 32 + 4 * fq + bj * HALF + n * 16) : (f32x4){0.f, 0.f, 0.f, 0.f};
        if (u.part >= 0) {
            float* base = PART + ((size_t)u.part * 256 + wr * 64 + fr) * D + col0;
#pragma unroll
            for (int ai = 0; ai < 2; ++ai)
#pragma unroll
                for (int m = 0; m < 4; ++m) { float* rowp = base + (size_t)(ai * HALF + m * 16) * D;
#pragma unroll
                    for (int bj = 0; bj < 2; ++bj)
#pragma unroll
                        for (int n = 0; n < 2; ++n) *(f32x4*)(rowp + bj * HALF + n * 16) = acc[ai][bj][m][n] * alpha + bv[bj][n]; }
            return;
        }
#pragma unroll
        for (int ai = 0; ai < 2; ++ai) {
            u32x2 xo[4][2][2];
#pragma unroll
            for (int m = 0; m < 4; ++m)
#pragma unroll
                for (int bj = 0; bj < 2; ++bj)
#pragma unroll
                    for (int n = 0; n < 2; ++n) xo[m][bj][n] = *(const u32x2*)(XR + (size_t)(row0 + ai * HALF + m * 16) * D + col0 + bj * HALF + n * 16);
#pragma unroll
            for (int m = 0; m < 4; ++m) { const size_t ro = (size_t)(row0 + ai * HALF + m * 16) * D + col0; float ssq = 0.f;
#pragma unroll
                for (int bj = 0; bj < 2; ++bj)
#pragma unroll
                    for (int n = 0; n < 2; ++n) { const u32x2 o = xo[m][bj][n];
                        const f32x4 xold = (f32x4){__uint_as_float(o.x << 16), __uint_as_float(o.x & 0xffff0000u), __uint_as_float(o.y << 16), __uint_as_float(o.y & 0xffff0000u)};
                        const f32x4 xn = xold + acc[ai][bj][m][n] * alpha + bv[bj][n];
                        u32x2 w; w.x = cvt_pk_bf16(xn.x, xn.y); w.y = cvt_pk_bf16(xn.z, xn.w); *(u32x2*)(XR + ro + bj * HALF + n * 16) = w;
                        const f32x4 xr = (f32x4){__uint_as_float(w.x << 16), __uint_as_float(w.x & 0xffff0000u), __uint_as_float(w.y << 16), __uint_as_float(w.y & 0xffff0000u)};
                        ssq += (xr.x * xr.x + xr.y * xr.y) + (xr.z * xr.z + xr.w * xr.w); }
                ssq += __shfl_xor(ssq, 16); ssq += __shfl_xor(ssq, 32);
                if (fq == 0) atomicAdd(SS + row0 + ai * HALF + m * 16, (u64)(ssq * SS_SCALE)); }
            asm volatile("" ::: "memory"); }
    }
};
struct EpiQKV {
    static constexpr bool PERM = true;
    template <class SchedT> __device__ __forceinline__ void prefetch(const SchedT& S, LAS unsigned char* lds, int tid) const {
        const u64* SS = (const u64*)(ws + WS_SS) + (size_t)ssidx * M; LAS float* RS = (LAS float*)(lds + STAGE_BYTES);
        for (int q = tid; q < 8 * 256; q += NTHREADS) { Unit u; if (S.next(q >> 8, u)) RS[q] = ss_rstd(SS[u.pm * BM + (q & 255)]); }
        asm volatile("s_waitcnt vmcnt(0) lgkmcnt(0)" ::: "memory");
    }
    unsigned char* ws; const float* bias; int ssidx;
    __device__ __forceinline__ void operator()(const f32x4 (&acc)[2][2][4][2], const Unit& u, int wr, int wc, int fr, int fq, int ui, LAS unsigned char* lds) const {
        bf16_t* O = (bf16_t*)(ws + WS_QKV);
        const int row0 = u.pm * BM + wr * 64 + fr, col0 = u.pn * BM + wc * 32 + 8 * fq;
        f32x4 bv[2][2];
#pragma unroll
        for (int bj = 0; bj < 2; ++bj)
#pragma unroll
            for (int n = 0; n < 2; ++n) bv[bj][n] = *(const f32x4*)(bias + col0 + bj * HALF + 4 * n);
#pragma unroll
        for (int ai = 0; ai < 2; ++ai)
#pragma unroll
            for (int m = 0; m < 4; ++m) { bf16_t* rowp = O + (size_t)(row0 + ai * HALF + m * 16) * QKVD + col0;
                const float rs = ((const LAS float*)(lds + STAGE_BYTES))[ui * 256 + wr * 64 + fr + ai * HALF + m * 16];
#pragma unroll
                for (int bj = 0; bj < 2; ++bj) { const f32x4 v0 = acc[ai][bj][m][0] * rs + bv[bj][0], v1 = acc[ai][bj][m][1] * rs + bv[bj][1];
                    u32x4 w; w.x = cvt_pk_bf16(v0[0], v0[1]); w.y = cvt_pk_bf16(v0[2], v0[3]); w.z = cvt_pk_bf16(v1[0], v1[1]); w.w = cvt_pk_bf16(v1[2], v1[3]);
                    *(u32x4*)(rowp + bj * HALF) = w; } }
    }
};
struct EpiRwkv1 {
    static constexpr bool PERM = false;
    template <class SchedT> __device__ __forceinline__ void prefetch(const SchedT&, LAS unsigned char*, int) const {}
    float* RKV; bf16_t* HL;
    __device__ __forceinline__ void operator()(const f32x4 (&acc)[2][2][4][2], const Unit& u, int wr, int wc, int fr, int fq, int ui, LAS unsigned char* lds) const {
        const int row0 = u.pm * BM + wr * 64 + fr, cin = wc * 32 + 4 * fq;
        if (u.pn < 24) {
            bf16_t* base = (bf16_t*)RKV + (size_t)(u.pn >> 3) * M * D + (u.pn & 7) * BM + cin;
#pragma unroll
            for (int ai = 0; ai < 2; ++ai)
#pragma unroll
                for (int m = 0; m < 4; ++m) { bf16_t* rowp = base + (size_t)(row0 + ai * HALF + m * 16) * D;
#pragma unroll
                    for (int bj = 0; bj < 2; ++bj)
#pragma unroll
                        for (int n = 0; n < 2; ++n) { const f32x4 v = acc[ai][bj][m][n]; u32x2 w; w.x = cvt_pk_bf16(v[0], v[1]); w.y = cvt_pk_bf16(v[2], v[3]); *(u32x2*)(rowp + bj * HALF + n * 16) = w; } }
        } else {
            const int which = u.pn - 24;
            bf16_t* base = HL + which * 256 + cin;
#pragma unroll
            for (int ai = 0; ai < 2; ++ai)
#pragma unroll
                for (int m = 0; m < 4; ++m) { bf16_t* rowp = base + (size_t)(row0 + ai * HALF + m * 16) * 768;
#pragma unroll
                    for (int bj = 0; bj < 2; ++bj)
#pragma unroll
                        for (int n = 0; n < 2; ++n) { f32x4 v = acc[ai][bj][m][n];
                            if (which == 0) {
#pragma unroll
                                for (int j = 0; j < 4; ++j) v[j] = fast_tanh(v[j]);
                            } else if (which == 2) {
#pragma unroll
                                for (int j = 0; j < 4; ++j) v[j] = fast_sigmoid(v[j]);
                            }
                            u32x2 w; w.x = cvt_pk_bf16(v[0], v[1]); w.y = cvt_pk_bf16(v[2], v[3]);
                            *(u32x2*)(rowp + bj * HALF + n * 16) = w; }
                    asm volatile("" ::: "memory"); }
        }
    }
};
struct EpiLoraUp {
    static constexpr bool PERM = false;
    template <class SchedT> __device__ __forceinline__ void prefetch(const SchedT&, LAS unsigned char*, int) const {}
    float* LUP; const float* w0; const float* a0;
    __device__ __forceinline__ void xrows(const f32x4 (&xacc)[2], const Unit& u, int wr, int wc, int fr, int fq, int ui, LAS unsigned char* lds) const {
        const int which = u.pn >> 3, row = MP + 8 * u.pm + (fr & 7), col0 = (u.pn & 7) * BM + wr * HALF + wc * 32 + 4 * fq;
        const float* addp = which == 0 ? w0 : a0;
        if (fr < 8) {
#pragma unroll
            for (int n = 0; n < 2; ++n) { f32x4 v = xacc[n]; if (which < 2) v += *(const f32x4*)(addp + col0 + n * 16);
                if (which < 2) {
#pragma unroll
                    for (int j = 0; j < 4; ++j) v[j] = fast_sigmoid(v[j]);
                    if (which == 0) {
#pragma unroll
                        for (int j = 0; j < 4; ++j) v[j] = fast_exp(-0.6065306597126334f * v[j]);
                    }
                    *(f32x4*)(LUP + (size_t)which * M * D + (size_t)row * D + col0 + n * 16) = v;
                } else { u32x2 w; w.x = cvt_pk_bf16(v[0], v[1]); w.y = cvt_pk_bf16(v[2], v[3]);
                    *(u32x2*)((bf16_t*)(LUP + (size_t)2 * M * D) + (size_t)row * D + col0 + n * 16) = w; } } }
        asm volatile("" ::: "memory");
    }
    __device__ __forceinline__ void operator()(const f32x4 (&acc)[2][2][4][2], const Unit& u, int wr, int wc, int fr, int fq, int ui, LAS unsigned char* lds) const {
        const int which = u.pn >> 3, row0 = u.pm * BM + wr * 64 + fr, col0 = (u.pn & 7) * BM + wc * 32 + 4 * fq;
        const float* addp = which == 0 ? w0 : a0;
        f32x4 bv[2][2];
#pragma unroll
        for (int bj = 0; bj < 2; ++bj)
#pragma unroll
            for (int n = 0; n < 2; ++n) bv[bj][n] = which < 2 ? *(const f32x4*)(addp + col0 + bj * HALF + n * 16) : (f32x4){0.f, 0.f, 0.f, 0.f};
        float* base = LUP + (size_t)which * M * D + col0;
#pragma unroll
        for (int ai = 0; ai < 2; ++ai)
#pragma unroll
            for (int m = 0; m < 4; ++m) { float* rowp = base + (size_t)(row0 + ai * HALF + m * 16) * D;
#pragma unroll
                for (int bj = 0; bj < 2; ++bj)
#pragma unroll
                    for (int n = 0; n < 2; ++n) { f32x4 v = acc[ai][bj][m][n] + bv[bj][n];
                        if (which < 2) {
#pragma unroll
                            for (int j = 0; j < 4; ++j) v[j] = fast_sigmoid(v[j]);
                            if (which == 0) {
#pragma unroll
                                for (int j = 0; j < 4; ++j) v[j] = fast_exp(-0.6065306597126334f * v[j]);
                            }
                            *(f32x4*)(rowp + bj * HALF + n * 16) = v;
                        } else {
                            u32x2 w; w.x = cvt_pk_bf16(v[0], v[1]); w.y = cvt_pk_bf16(v[2], v[3]);
                            *(u32x2*)((bf16_t*)(LUP + (size_t)2 * M * D) + (size_t)(row0 + ai * HALF + m * 16) * D + col0 + bj * HALF + n * 16) = w; } }
                asm volatile("" ::: "memory"); }
    }
};
}

struct Args { const float* in[40]; float* out; unsigned char* ws; int lo, hi; };
enum { I_XP = 0, I_XS, I_SPOOL, I_CK, I_CV, I_SSHIFT, I_SWKV, I_NF1, I_NMIX, I_NF2, I_NFIN, I_WG, I_WU, I_WDN, I_PW, I_PSC, I_AQKV, I_ABQKV, I_AWO, I_ABO, I_SINK, I_RELB,
       I_MU, I_RWR, I_RWK, I_RWV, I_RWO, I_W0, I_W1, I_W2, I_A0, I_A1, I_A2, I_G1, I_G2, I_KK, I_KA, I_RK, I_LNW, I_LNB };

struct Frame {
    LAS unsigned char* lds; const Args* a; unsigned char* ws; float* out;
    float* X; float* U; bf16_t* XB;
};

struct ConvT { f32x4 v[8]; const float* nscale; const float* kscale; bf16_t* dst; int dld, k0, n, Ns; };
__device__ __forceinline__ void conv_tile_load(ConvT& c, const float* __restrict__ src, int Ks, int Ns, int k0, int n0, bf16_t* __restrict__ dst, int dld, const float* __restrict__ nscale, int lane, const float* __restrict__ kscale) {
    const int kg = lane >> 3, ng = lane & 7, n = n0 + 4 * ng;
#pragma unroll
    for (int i = 0; i < 8; ++i) { const int k = k0 + 8 * kg + i; c.v[i] = (k < Ks && n < Ns) ? *(const f32x4*)(src + (size_t)k * Ns + n) : (f32x4){0.f, 0.f, 0.f, 0.f}; }
    c.nscale = nscale; c.kscale = kscale; c.dst = dst; c.dld = dld; c.k0 = k0; c.n = n; c.Ns = Ns;
}
__device__ __forceinline__ void conv_tile_finish(ConvT& c, int lane) {
    const int kg = lane >> 3, ng = lane & 7;
    if (c.kscale) {
        const f32x4 g0 = *(const f32x4*)(c.kscale + c.k0 + 8 * kg), g1 = *(const f32x4*)(c.kscale + c.k0 + 8 * kg + 4);
        c.v[0] *= g0.x; c.v[1] *= g0.y; c.v[2] *= g0.z; c.v[3] *= g0.w; c.v[4] *= g1.x; c.v[5] *= g1.y; c.v[6] *= g1.z; c.v[7] *= g1.w; }
    f32x4 sc = (f32x4){1.f, 1.f, 1.f, 1.f};
    if (c.nscale && c.n < c.Ns) sc = *(const f32x4*)(c.nscale + c.n);
#pragma unroll
    for (int s = 0; s < 4; ++s) { const float q = sc[s];
        u32x4 o; o.x = cvt_pk_bf16(c.v[0][s] * q, c.v[1][s] * q); o.y = cvt_pk_bf16(c.v[2][s] * q, c.v[3][s] * q); o.z = cvt_pk_bf16(c.v[4][s] * q, c.v[5][s] * q); o.w = cvt_pk_bf16(c.v[6][s] * q, c.v[7][s] * q);
        *(u32x4*)(c.dst + (size_t)(4 * ng + s) * c.dld + 8 * kg) = o; }
}
__device__ __forceinline__ void conv_tile(const float* __restrict__ src, int Ks, int Ns, int k0, int n0, bf16_t* __restrict__ dst, int dld, const float* __restrict__ nscale, int lane, const float* __restrict__ kscale = nullptr) {
    ConvT c; conv_tile_load(c, src, Ks, Ns, k0, n0, dst, dld, nscale, lane, kscale); conv_tile_finish(c, lane);
}
__device__ __forceinline__ void conv_plain(const float* src, int Ks, int Ns, int KT, int NT, bf16_t* dst, int dld, int it, int lane, const float* nscale = nullptr, const float* kscale = nullptr) {
    const int kb = it / NT, nb = it % NT;
    conv_tile(src, Ks, Ns, kb * 64, nb * 32, dst + (size_t)(nb * 32) * dld + kb * 64, dld, nscale, lane, kscale);
}
__device__ __forceinline__ void conv_gateup(const float* src, int half, bf16_t* dst, int it, int lane, const float* gain) {
    constexpr int NT = FF / 32; const int kb = it / NT, nb = it % NT, n0 = nb * 32;
    conv_tile(src, D, FF, kb * 64, n0, dst + (size_t)((n0 >> 7) * 256 + half * 128 + (n0 & 127)) * D + kb * 64, D, nullptr, lane, gain);
}

#ifndef EARLY_PCT
#define EARLY_PCT (XR_DN ? 100 : 50)
#endif
#ifndef EARLY2_PCT
#define EARLY2_PCT 100
#endif
constexpr int T_HALF = 3 * (D / 64) * (FF / 32), EARLY_GU = (int)((long long)T_HALF * EARLY_PCT / 100), EARLY_TILES = (int)((long long)T_HALF * EARLY2_PCT / 100);
constexpr int T_HALF0 = 2 * (D / 64) * (FF / 32), EARLY_GU0 = EARLY_GU - (T_HALF - T_HALF0) * 3 / 4;
static_assert(EARLY_GU0 > 0, "first-layer split");
static_assert(EARLY_GU <= EARLY_TILES && EARLY_TILES == T_HALF, "early conversion split: everything not done in the gate/up tail is done in the down tail");
constexpr int QKV_FULL = (M / 256) * (QKVD / 256) % GRID;
constexpr int DN_FULL = 8 * KS_DN;
constexpr int GU_UNITS = (M / 256) * (2 * FF / 256), GU_FULL = GU_UNITS % GRID;
static_assert(GU_FULL > 0, "idle workgroups in the last gate/up round");
__device__ __forceinline__ void conv_ffn_tile(const Frame& F, int l, int which, int r, int LANE) {
    const Args& a = *F.a;
    constexpr int T_GU = (D / 64) * (FF / 32);
    const size_t wo = (size_t)(l * 2 + which) * D * FF; const int wb = (l & 1) * 2 + which;
    bf16_t* wgu = (bf16_t*)(F.ws + WS_WGU + wb * WGU_BYTES); bf16_t* wd = (bf16_t*)(F.ws + WS_WD + wb * WD_BYTES);
    const float* gain = a.in[which == 0 ? I_NF1 : I_NF2] + (size_t)l * D;
    if (r < T_GU) { conv_gateup(a.in[I_WG] + wo, 0, wgu, r, LANE, gain); return; } r -= T_GU;
    if (r < T_GU) { conv_gateup(a.in[I_WU] + wo, 1, wgu, r, LANE, gain); return; } r -= T_GU;
    conv_plain(a.in[I_WDN] + wo, FF, D, FF / 64, D / 32, wd, FF, r, LANE);
}
__device__ __forceinline__ void conv_ffn_tile_load(ConvT& c, const Frame& F, int l, int which, int r, int LANE) {
    const Args& a = *F.a;
    constexpr int T_GU = (D / 64) * (FF / 32), NT = FF / 32;
    const size_t wo = (size_t)(l * 2 + which) * D * FF; const int wb = (l & 1) * 2 + which;
    bf16_t* wgu = (bf16_t*)(F.ws + WS_WGU + wb * WGU_BYTES); bf16_t* wd = (bf16_t*)(F.ws + WS_WD + wb * WD_BYTES);
    const float* gain = a.in[which == 0 ? I_NF1 : I_NF2] + (size_t)l * D;
    if (r < 2 * T_GU) { const int half = r >= T_GU ? 1 : 0; r -= half * T_GU; const int kb = r / NT, nb = r % NT, n0 = nb * 32;
        conv_tile_load(c, a.in[half ? I_WU : I_WG] + wo, D, FF, kb * 64, n0, wgu + (size_t)((n0 >> 7) * 256 + half * 128 + (n0 & 127)) * D + kb * 64, D, nullptr, LANE, gain); return; }
    r -= 2 * T_GU; { const int NTd = D / 32, kb = r / NTd, nb = r % NTd;
        conv_tile_load(c, a.in[I_WDN] + wo, FF, D, kb * 64, nb * 32, wd + (size_t)(nb * 32) * FF + kb * 64, FF, nullptr, LANE, nullptr); }
}
__device__ __forceinline__ void early_convert(const Frame& F, int lnext, int which, int first, int last, int wg0) {
    int tid_ = threadIdx.x; asm volatile("" : "+v"(tid_)); int bid_ = blockIdx.x; asm volatile("" : "+s"(bid_));
    const int LANE = tid_ & 63, WAVE = __builtin_amdgcn_readfirstlane(tid_ >> 6), BID = bid_;
    const int gw = (BID - wg0) * NWAVES + WAVE, NGW = (GRID - wg0) * NWAVES;
    for (int r = first + gw; r < last; r += 2 * NGW) {
        ConvT c0, c1; const bool two = r + NGW < last;
        conv_ffn_tile_load(c0, F, lnext, which, r, LANE);
        if (two) conv_ffn_tile_load(c1, F, lnext, which, r + NGW, LANE);
        conv_tile_finish(c0, LANE);
        if (two) conv_tile_finish(c1, LANE);
    }
}
__device__ __forceinline__ void phase_convert(const Frame& F, int l, int wg0) {
    int tid_ = threadIdx.x; asm volatile("" : "+v"(tid_)); int bid_ = blockIdx.x; asm volatile("" : "+s"(bid_));
    const int TID = tid_, LANE = tid_ & 63, WAVE = __builtin_amdgcn_readfirstlane(tid_ >> 6), BID = bid_; (void)TID; (void)LANE; (void)WAVE; (void)BID;

    const Args& a = *F.a; const int kind = l % 3, j = l / 3;
    if (BID < wg0) return;
    const int gw = (BID - wg0) * NWAVES + WAVE, NGW = (GRID - wg0) * NWAVES;
    constexpr int T_GU = (D / 64) * (FF / 32), T_DN = (FF / 64) * (D / 32);
    const int T_FFN = l == 0 ? T_HALF0 : 0;
    int nmix = 0;
    if (kind == 0) nmix = 4 * (512 / 64) * (512 / 32);
    else if (kind == 1) nmix = (D / 64) * (QKVD / 32) + (D / 64) * (D / 32);
    else nmix = 4 * (D / 64) * (D / 32) + 3 * (D / 64) * (256 / 32) + 3 * (256 / 64) * (D / 32);
    const int total = T_FFN + nmix;
    for (int it = gw; it < total; it += NGW) {
        int r = it;
        if (r < T_FFN) {
            conv_ffn_tile(F, l, 0, r, LANE); continue;
        }
        r -= T_FFN;
        unsigned char* wm = F.ws + (kind == 2 ? WS_WMIX2 : WS_WMIX);
        if (kind == 0) {
            const int g = r / 128; r -= g * 128;
            conv_plain(a.in[I_PW] + ((size_t)(j * 4 + g) * 512) * 512, 512, 512, 8, 16, (bf16_t*)(wm + WM_POOL) + (size_t)g * 512 * 512, 512, r, LANE, a.in[I_PSC] + (size_t)j * D + g * 512);
        } else if (kind == 1) {
            constexpr int T_Q = (D / 64) * (QKVD / 32);
            if (r < T_Q) { conv_plain(a.in[I_AQKV] + (size_t)j * D * QKVD, D, QKVD, D / 64, QKVD / 32, (bf16_t*)(wm + WM_QKV), D, r, LANE, nullptr, a.in[I_NMIX] + (size_t)l * D); continue; } r -= T_Q;
            conv_plain(a.in[I_AWO] + (size_t)j * D * D, D, D, D / 64, D / 32, (bf16_t*)(wm + WM_AO), D, r, LANE);
        } else {
            constexpr int T_SQ = (D / 64) * (D / 32), T_L1 = (D / 64) * (256 / 32), T_L2 = (256 / 64) * (D / 32);
            bf16_t* rw = (bf16_t*)(wm + WM_RW); bf16_t* l2 = (bf16_t*)(wm + WM_L2); bf16_t* ro = (bf16_t*)(wm + WM_RO);
            if (r < T_SQ) { conv_plain(a.in[I_RWR] + (size_t)j * D * D, D, D, D / 64, D / 32, rw, D, r, LANE); continue; } r -= T_SQ;
            if (r < T_SQ) { conv_plain(a.in[I_RWK] + (size_t)j * D * D, D, D, D / 64, D / 32, rw + (size_t)2048 * D, D, r, LANE); continue; } r -= T_SQ;
            if (r < T_SQ) { conv_plain(a.in[I_RWV] + (size_t)j * D * D, D, D, D / 64, D / 32, rw + (size_t)4096 * D, D, r, LANE); continue; } r -= T_SQ;
            if (r < T_SQ) { conv_plain(a.in[I_RWO] + (size_t)j * D * D, D, D, D / 64, D / 32, ro, D, r, LANE); continue; } r -= T_SQ;
            if (r < T_L1) { conv_plain(a.in[I_W1] + (size_t)j * D * 96, D, 96, D / 64, 8, rw + (size_t)6144 * D, D, r, LANE); continue; } r -= T_L1;
            if (r < T_L1) { conv_plain(a.in[I_A1] + (size_t)j * D * 96, D, 96, D / 64, 8, rw + (size_t)6400 * D, D, r, LANE); continue; } r -= T_L1;
            if (r < T_L1) { conv_plain(a.in[I_G1] + (size_t)j * D * 256, D, 256, D / 64, 8, rw + (size_t)6656 * D, D, r, LANE); continue; } r -= T_L1;
            if (r < T_L2) { conv_plain(a.in[I_W2] + (size_t)j * 96 * D, 96, D, 4, D / 32, l2, 256, r, LANE); continue; } r -= T_L2;
            if (r < T_L2) { conv_plain(a.in[I_A2] + (size_t)j * 96 * D, 96, D, 4, D / 32, l2 + (size_t)2048 * 256, 256, r, LANE); continue; } r -= T_L2;
            conv_plain(a.in[I_G2] + (size_t)j * 256 * D, 256, D, 4, D / 32, l2 + (size_t)4096 * 256, 256, r, LANE);
        }
    }
}

struct RowV { f32x4 v[8]; };
__device__ __forceinline__ float row_sumsq(const RowV& r) { float s = 0.f;
#pragma unroll
    for (int jj = 0; jj < 8; ++jj) s += (r.v[jj].x * r.v[jj].x + r.v[jj].y * r.v[jj].y) + (r.v[jj].z * r.v[jj].z + r.v[jj].w * r.v[jj].w);
    return wave_sum(s); }
__device__ __forceinline__ void row_store_x(const Frame& F, int m, const RowV& r, float ss, u64* SSb, int LANE, bool writeX) {
    bf16_t* XR = (bf16_t*)(F.ws + WS_XR);
#pragma unroll
    for (int jj = 0; jj < 8; ++jj) { const size_t off = (size_t)m * D + 4 * (LANE + 64 * jj);
        u32x2 w; w.x = cvt_pk_bf16(r.v[jj].x, r.v[jj].y); w.y = cvt_pk_bf16(r.v[jj].z, r.v[jj].w); *(u32x2*)(XR + off) = w; }
    if (LANE == 0) SSb[m] = (u64)(ss * SS_SCALE);
}
template <int NP> __device__ __forceinline__ float sample_fold_row_t(const Frame& F, int m, RowV& r, int LANE) {
    const float* pp = (const float*)(F.ws + WS_PART) + (size_t)(m - MP) * D;
#pragma unroll
    for (int e = 0; e < 8; ++e) r.v[e] = ld_bf4((const bf16_t*)(F.ws + WS_XR) + (size_t)m * D + 4 * (LANE + 64 * e));
#pragma unroll
    for (int jb = 0; jb < 3; ++jb) {
        f32x4 t[NP > 0 ? NP : 1][3];
#pragma unroll
        for (int p = 0; p < NP; ++p)
#pragma unroll
            for (int e = 0; e < 3; ++e) if (3 * jb + e < 8) t[p][e] = *(const f32x4*)(pp + (size_t)p * 256 * D + 4 * (LANE + 64 * (3 * jb + e)));
#pragma unroll
        for (int p = 0; p < NP; ++p)
#pragma unroll
            for (int e = 0; e < 3; ++e) if (3 * jb + e < 8) r.v[3 * jb + e] += t[p][e];
        asm volatile("" ::: "memory");
    }
    return row_sumsq(r);
}
__device__ __forceinline__ float sample_fold_row(const Frame& F, int m, int nparts, RowV& r, int LANE) {
    if (nparts == 1) return sample_fold_row_t<1>(F, m, r, LANE);
    if (nparts == KS_DN) return sample_fold_row_t<KS_DN>(F, m, r, LANE);
    if (nparts == KS_WO) return sample_fold_row_t<KS_WO>(F, m, r, LANE);
    return sample_fold_row_t<KS_POOL>(F, m, r, LANE);
}
__device__ __forceinline__ void zero_ss(u64* SSb, int TID, int BID) { for (int i = BID * NTHREADS + TID; i < M; i += GRID * NTHREADS) SSb[i] = 0ull; }
#define PH_IDS int tid_ = threadIdx.x; asm volatile("" : "+v"(tid_)); int bid_ = blockIdx.x; asm volatile("" : "+s"(bid_)); \
    const int TID = tid_, LANE = tid_ & 63, WAVE = __builtin_amdgcn_readfirstlane(tid_ >> 6), BID = bid_; (void)TID; (void)LANE; (void)WAVE; (void)BID;
__device__ __forceinline__ u64* ss_buf(const Frame& F, int site) { return (u64*)(F.ws + WS_SS) + (size_t)(site % 3) * M; }

__device__ __forceinline__ void phase_first(const Frame& F) {
    PH_IDS
    const Args& a = *F.a;
    const int gw = BID * NWAVES + WAVE, NGW = gridDim.x * NWAVES;
    for (int m = gw; m < M; m += NGW) {
        const float* src = m < MP ? a.in[I_XP] + (size_t)m * D : a.in[I_XS] + (size_t)(m - MP) * D;
        RowV r;
#pragma unroll
        for (int jj = 0; jj < 8; ++jj) r.v[jj] = *(const f32x4*)(src + 4 * (LANE + 64 * jj));
        const float ss = row_sumsq(r);
        row_store_x(F, m, r, ss, ss_buf(F, 0), LANE, true);
    }
    zero_ss(ss_buf(F, 1), TID, BID);
}
__device__ __forceinline__ void phase_samplefold(const Frame& F, int site, int nparts, bool zero2 = false) {
    PH_IDS
    if (BID < 32) { const int m = MP + BID * 8 + WAVE; RowV r; const float ss = sample_fold_row(F, m, nparts, r, LANE); row_store_x(F, m, r, ss, ss_buf(F, site), LANE, true); }
    zero_ss(ss_buf(F, site + 1), TID, BID);
    if (zero2) zero_ss(ss_buf(F, site + 2), TID, BID);
}
__device__ __forceinline__ void phase_final(const Frame& F, int site, int nparts) {
    PH_IDS
    const Args& a = *F.a;
    const int gw = BID * NWAVES + WAVE, NGW = gridDim.x * NWAVES;
    const u64* SSb = ss_buf(F, site);
    f32x4 g[8];
#pragma unroll
    for (int jj = 0; jj < 8; ++jj) g[jj] = *(const f32x4*)(a.in[I_NFIN] + 4 * (LANE + 64 * jj));
    const bf16_t* XRp = (const bf16_t*)(F.ws + WS_XR);
    if (gw < MS) { const int m = MP + gw; RowV r; const float ss = sample_fold_row(F, m, nparts, r, LANE); const float rstd = 1.0f / sqrtf(ss * (1.0f / D) + RMS_EPS);
#pragma unroll
        for (int jj = 0; jj < 8; ++jj) *(f32x4*)(F.out + (size_t)m * D + 4 * (LANE + 64 * jj)) = r.v[jj] * rstd * g[jj]; }
    static_assert(MP % (GRID * NWAVES) == 0, "prompt rows per wave");
    RowV r; float rstd = ss_rstd(SSb[gw]);
#pragma unroll
    for (int jj = 0; jj < 8; ++jj) r.v[jj] = ld_bf4(XRp + (size_t)gw * D + 4 * (LANE + 64 * jj));
    for (int m = gw; m < MP; m += NGW) {
        RowV rn; float rsn = 0.f; const int mn = m + NGW;
        if (mn < MP) { rsn = ss_rstd(SSb[mn]);
#pragma unroll
            for (int jj = 0; jj < 8; ++jj) rn.v[jj] = ld_bf4(XRp + (size_t)mn * D + 4 * (LANE + 64 * jj)); }
#pragma unroll
        for (int jj = 0; jj < 8; ++jj) *(f32x4*)(F.out + (size_t)m * D + 4 * (LANE + 64 * jj)) = r.v[jj] * rstd * g[jj];
        if (mn < MP) {
#pragma unroll
            for (int jj = 0; jj < 8; ++jj) r.v[jj] = rn.v[jj];
            rstd = rsn; }
    }
}

__device__ __forceinline__ void phase_poolprep(const Frame& F, int l, int site, int nparts) {
    PH_IDS
    const Args& a = *F.a; const int j = l / 3;
    const int gw = BID * NWAVES + WAVE, NGW = gridDim.x * NWAVES;
    const u64* SSb = ss_buf(F, site);
    const float* gain = a.in[I_NMIX] + (size_t)l * D;
    const float* prefix_all = a.in[I_SPOOL] + (size_t)j * 32 * 15 * D;
    f32x4 g[8];
#pragma unroll
    for (int jj = 0; jj < 8; ++jj) g[jj] = *(const f32x4*)(gain + 4 * (LANE + 64 * jj));
    if (BID < 32) {
        const int b = BID, t = WAVE, m = MP + b * 8 + t;
        RowV r; const float ss = sample_fold_row(F, m, nparts, r, LANE); row_store_x(F, m, r, ss, ss_buf(F, site), LANE, true);
        const float rstd = 1.0f / sqrtf(ss * (1.0f / D) + RMS_EPS);
        LAS float* U8 = (LAS float*)F.lds;
#pragma unroll
        for (int jj = 0; jj < 8; ++jj) { r.v[jj] = r.v[jj] * rstd * g[jj]; *(LAS f32x4*)(U8 + t * D + 4 * (LANE + 64 * jj)) = r.v[jj]; }
        __syncthreads();
        const float* pf = prefix_all + (size_t)b * 15 * D;
        float* ps = F.out + O_POOLS + ((size_t)(j * 32 + b) * 15) * D;
#pragma unroll
        for (int jj = 0; jj < 8; ++jj) { const int w = 2 << (jj >> 1); const int col = 4 * (LANE + 64 * jj);
            const f32x4 u = r.v[jj]; f32x4 sacc = u;
            for (int d = 1; d < w; ++d) { const int tt = t - d; sacc += tt >= 0 ? *(const LAS f32x4*)(U8 + tt * D + col) : *(const f32x4*)(pf + (size_t)(15 + tt) * D + col); }
            const f32x4 df = sacc * (1.0f / (float)w) - u;
            u32x2 wv; wv.x = cvt_pk_bf16(df.x, df.y); wv.y = cvt_pk_bf16(df.z, df.w); *(u32x2*)(F.XB + (size_t)m * D + col) = wv;
            *(f32x4*)(ps + (size_t)(7 + t) * D + col) = u;
            if (t < 7) *(f32x4*)(ps + (size_t)t * D + col) = *(const f32x4*)(pf + (size_t)(8 + t) * D + col); }
        __syncthreads();
    }
    {
        LAS f32x4* tile = (LAS f32x4*)F.lds;
        LAS float* rsl = (LAS float*)(F.lds + 47 * 2048);
        for (int rb = BID; rb < MP / 32; rb += gridDim.x) {
            const int m0 = rb * 32, b = m0 >> 12, t0 = m0 & 4095;
            if (TID < 47) { const int t = t0 - 15 + TID; rsl[TID] = t >= 0 ? ss_rstd(SSb[b * SEQ + t]) : 0.f; }
            u32x2 raw[12];
#define PP_LOAD(gi_) do { const int H_ = (2 << (gi_)) - 1, R_ = 32 + H_; _Pragma("unroll") for (int k = 0; k < 12; ++k) { const int idx = TID + k * NTHREADS, r = idx >> 7, c4 = idx & 127, t = t0 - H_ + r; \
                raw[k] = (u32x2){0u, 0u}; if (idx < R_ * 128 && t >= 0) raw[k] = *(const u32x2*)((const bf16_t*)(F.ws + WS_XR) + (size_t)(b * SEQ + t) * D + (gi_) * 512 + 4 * c4); } } while (0)
            PP_LOAD(0);
            __syncthreads();
#pragma unroll 1
            for (int gi = 0; gi < 4; ++gi) {
                const int w = 2 << gi, H = w - 1, R = 32 + H;
#pragma unroll
                for (int k = 0; k < 12; ++k) { const int idx = TID + k * NTHREADS, r = idx >> 7;
                    if (idx < R * 128) tile[idx] = (f32x4){__uint_as_float(raw[k].x << 16), __uint_as_float(raw[k].x & 0xffff0000u), __uint_as_float(raw[k].y << 16), __uint_as_float(raw[k].y & 0xffff0000u)} * rsl[15 - H + r]; }
                __syncthreads();
                if (gi < 3) PP_LOAD(gi + 1);
                { const int c4 = TID & 127, rq = TID >> 7, col = gi * 512 + 4 * c4;
                  const f32x4 gv = *(const f32x4*)(gain + col);
                  f32x4 sacc = (f32x4){0.f, 0.f, 0.f, 0.f};
                  for (int d = 0; d < H; ++d) sacc += tile[(rq * 8 + d) * 128 + c4];
#pragma unroll
                  for (int rr = 0; rr < 8; ++rr) { const int r = rq * 8 + rr + H, t = t0 + rq * 8 + rr, m = m0 + rq * 8 + rr;
                      const f32x4 u = tile[r * 128 + c4];
                      sacc += u;
                      const int cnt = t + 1 < w ? t + 1 : w;
                      const f32x4 ug = u * gv, df = sacc * gv * (1.0f / (float)cnt) - ug;
                      u32x2 wv; wv.x = cvt_pk_bf16(df.x, df.y); wv.y = cvt_pk_bf16(df.z, df.w); *(u32x2*)(F.XB + (size_t)m * D + col) = wv;
                      if (t >= SEQ - 15) *(f32x4*)(F.out + O_POOLP + ((size_t)(j * 2 + b) * 15 + (t - (SEQ - 15))) * D + col) = ug;
                      sacc -= tile[(r - H) * 128 + c4]; } }
                __syncthreads();
            }
#undef PP_LOAD
        }
    }
    zero_ss(ss_buf(F, site + 1), TID, BID); zero_ss(ss_buf(F, site + 2), TID, BID);
}

__device__ __forceinline__ void rwkv_mix_store(const Frame& F, int m, int col, const f32x4& u, const f32x4& p, const float* mu) {
    bf16_t* mix6 = (bf16_t*)(F.ws + WS_MIX6);
    const f32x4 dx = p - u;
#pragma unroll
    for (int s = 0; s < 6; ++s) { const int mi = s == 0 ? 0 : s == 1 ? 2 : s == 2 ? 3 : s == 3 ? 1 : s;
        const f32x4 o = u + dx * *(const f32x4*)(mu + (size_t)mi * D + col);
        u32x2 wv; wv.x = cvt_pk_bf16(o.x, o.y); wv.y = cvt_pk_bf16(o.z, o.w); *(u32x2*)(mix6 + (size_t)s * MIXS + (size_t)m * D + col) = wv; }
}
__device__ __forceinline__ void phase_rwkvmix(const Frame& F, int l, int site, int nparts) {
    PH_IDS
    const Args& a = *F.a; const int j = l / 3;
    const int gw = BID * NWAVES + WAVE, NGW = gridDim.x * NWAVES;
    const u64* SSb = ss_buf(F, site);
    const float* gain = a.in[I_NMIX] + (size_t)l * D;
    const float* mu = a.in[I_MU] + (size_t)j * 6 * D;
    f32x4 g[8];
#pragma unroll
    for (int jj = 0; jj < 8; ++jj) g[jj] = *(const f32x4*)(gain + 4 * (LANE + 64 * jj));
    if (BID < 32) {
        const int b = BID, t = WAVE, m = MP + b * 8 + t;
        RowV r; const float ss = sample_fold_row(F, m, nparts, r, LANE); row_store_x(F, m, r, ss, ss_buf(F, site), LANE, true);
        const float rstd = 1.0f / sqrtf(ss * (1.0f / D) + RMS_EPS);
        LAS float* U8 = (LAS float*)F.lds;
#pragma unroll
        for (int jj = 0; jj < 8; ++jj) { r.v[jj] = r.v[jj] * rstd * g[jj]; *(LAS f32x4*)(U8 + t * D + 4 * (LANE + 64 * jj)) = r.v[jj]; }
        __syncthreads();
#pragma unroll
        for (int jj = 0; jj < 8; ++jj) { const int col = 4 * (LANE + 64 * jj);
            const f32x4 p = t > 0 ? *(const LAS f32x4*)(U8 + (t - 1) * D + col) : *(const f32x4*)(a.in[I_SSHIFT] + ((size_t)j * 32 + b) * D + col);
            rwkv_mix_store(F, m, col, r.v[jj], p, mu);
            if (t == 7) *(f32x4*)(F.out + O_SHS + ((size_t)j * 32 + b) * D + col) = r.v[jj]; }
        __syncthreads();
    }
    for (int rb = BID; rb < MP / 32; rb += gridDim.x) {
        const int m0 = rb * 32, b = m0 >> 12, t0 = m0 & 4095, col = 4 * (LANE + 64 * WAVE);
        bf16_t* mix6 = (bf16_t*)(F.ws + WS_MIX6);
        f32x4 mu6[6];
#pragma unroll
        for (int s6 = 0; s6 < 6; ++s6) { const int mi = s6 == 0 ? 0 : s6 == 1 ? 2 : s6 == 2 ? 3 : s6 == 3 ? 1 : s6; mu6[s6] = *(const f32x4*)(mu + (size_t)mi * D + col); }
        const f32x4 gv = *(const f32x4*)(gain + col);
        f32x4 p = (f32x4){0.f, 0.f, 0.f, 0.f};
        if (t0 > 0) p = ld_bf4((const bf16_t*)(F.ws + WS_XR) + (size_t)(m0 - 1) * D + col) * ss_rstd(SSb[m0 - 1]) * gv;
#pragma unroll 1
        for (int r0 = 0; r0 < 32; r0 += 16) {
            u32x2 raw[16]; float rs[16];
#pragma unroll
            for (int q = 0; q < 16; ++q) { raw[q] = *(const u32x2*)((const bf16_t*)(F.ws + WS_XR) + (size_t)(m0 + r0 + q) * D + col); rs[q] = ss_rstd(SSb[m0 + r0 + q]); }
#pragma unroll
            for (int q = 0; q < 16; ++q) { const int rr = r0 + q, m = m0 + rr;
                const f32x4 u = (f32x4){__uint_as_float(raw[q].x << 16), __uint_as_float(raw[q].x & 0xffff0000u), __uint_as_float(raw[q].y << 16), __uint_as_float(raw[q].y & 0xffff0000u)} * rs[q] * gv;
                const f32x4 dx = p - u;
#pragma unroll
                for (int s6 = 0; s6 < 6; ++s6) { const f32x4 o = u + dx * mu6[s6]; u32x2 wv; wv.x = cvt_pk_bf16(o.x, o.y); wv.y = cvt_pk_bf16(o.z, o.w); *(u32x2*)(mix6 + (size_t)s6 * MIXS + (size_t)m * D + col) = wv; }
                if (t0 + rr == SEQ - 1) *(f32x4*)(F.out + O_SHP + ((size_t)j * 2 + b) * D + col) = u;
                p = u; } }
    }
    zero_ss(ss_buf(F, site + 1), TID, BID); zero_ss(ss_buf(F, site + 2), TID, BID);
}

#ifndef GEMM_ALIGN
#define GEMM_ALIGN true
#endif
#ifndef GEMM_SP2
#define GEMM_SP2 true
#endif
constexpr int AT_KP = 144, AT_VP = 560, AT_PP = 336;
constexpr int AT_K = 0, AT_V = AT_K + 256 * AT_KP, AT_P = AT_V + 64 * AT_VP, AT_B = AT_P + 8 * 16 * AT_PP, AT_END = AT_B + 8 * 128 * 4;
static_assert(AT_END <= RING_BYTES, "attention LDS");
__device__ __forceinline__ void phase_attn(const Frame& F, int j) {
    int tid_ = threadIdx.x; asm volatile("" : "+v"(tid_)); int bid_ = blockIdx.x; asm volatile("" : "+s"(bid_));
    const int TID = tid_, LANE = tid_ & 63, WAVE = __builtin_amdgcn_readfirstlane(tid_ >> 6), BID = bid_; (void)TID; (void)LANE; (void)WAVE; (void)BID;

    const Args& a = *F.a;
    const bf16_t* QKV = (const bf16_t*)(F.ws + WS_QKV);
    LAS unsigned char* lds = F.lds;
    const int lane = LANE, g = WAVE, fr = lane & 15, fq = lane >> 4;
    for (int unit = BID; unit < 256 + 128; unit += gridDim.x) {
        const bool samp = unit >= 256;
        int b, kvh, qblk;
        if (!samp) { b = unit >> 7; kvh = (unit >> 5) & 3; qblk = unit & 31; } else { b = (unit - 256) >> 2; kvh = (unit - 256) & 3; qblk = 1; }
        __syncthreads();
        for (int i = TID; i < 8 * 128; i += NTHREADS) { const int gg = i >> 7, dist = i & 127;
            int bk = dist; if (dist >= 16) { bk = 16 + (int)(logf((float)dist * (1.0f / 16.0f)) / 2.0794415416798357f * 16.0f); bk = bk > 31 ? 31 : bk; }
            ((LAS float*)(lds + AT_B))[i] = a.in[I_RELB][bk * 32 + kvh * 8 + gg]; }
        for (int i = TID; i < 256 * 8; i += NTHREADS) { const int key = i >> 3, c8 = i & 7;
            u32x4 kv = (u32x4){0u, 0u, 0u, 0u}, vv = kv;
            if (!samp) { const int pos = qblk * 128 - 128 + key;
                if (pos >= 0) { const bf16_t* rp = QKV + (size_t)(b * SEQ + pos) * QKVD + D + kvh * 64 + c8 * 8; kv = *(const u32x4*)rp; vv = *(const u32x4*)(rp + 256);
                    if (qblk == 31 && key >= 128) {
                        float* ok = F.out + O_WKP + (((size_t)(j * 2 + b) * 128 + (key - 128)) * 4 + kvh) * 64 + c8 * 8; float* ov = F.out + O_WVP + (ok - (F.out + O_WKP));
                        *(f32x4*)ok = (f32x4){bf2f(kv.x & 0xffff), bf2f(kv.x >> 16), bf2f(kv.y & 0xffff), bf2f(kv.y >> 16)}; *(f32x4*)(ok + 4) = (f32x4){bf2f(kv.z & 0xffff), bf2f(kv.z >> 16), bf2f(kv.w & 0xffff), bf2f(kv.w >> 16)};
                        *(f32x4*)ov = (f32x4){bf2f(vv.x & 0xffff), bf2f(vv.x >> 16), bf2f(vv.y & 0xffff), bf2f(vv.y >> 16)}; *(f32x4*)(ov + 4) = (f32x4){bf2f(vv.z & 0xffff), bf2f(vv.z >> 16), bf2f(vv.w & 0xffff), bf2f(vv.w >> 16)}; } } }
            else if (key < 136) {
                f32x4 k0, k1, v0, v1;
                if (key < 128) { const size_t o = (((size_t)(j * 32 + b) * 128 + key) * 4 + kvh) * 64 + c8 * 8;
                    k0 = *(const f32x4*)(a.in[I_CK] + o); k1 = *(const f32x4*)(a.in[I_CK] + o + 4); v0 = *(const f32x4*)(a.in[I_CV] + o); v1 = *(const f32x4*)(a.in[I_CV] + o + 4);
                    kv.x = cvt_pk_bf16(k0.x, k0.y); kv.y = cvt_pk_bf16(k0.z, k0.w); kv.z = cvt_pk_bf16(k1.x, k1.y); kv.w = cvt_pk_bf16(k1.z, k1.w);
                    vv.x = cvt_pk_bf16(v0.x, v0.y); vv.y = cvt_pk_bf16(v0.z, v0.w); vv.z = cvt_pk_bf16(v1.x, v1.y); vv.w = cvt_pk_bf16(v1.z, v1.w); }
                else { const bf16_t* rp = QKV + (size_t)(MP + b * 8 + (key - 128)) * QKVD + D + kvh * 64 + c8 * 8; kv = *(const u32x4*)rp; vv = *(const u32x4*)(rp + 256);
                    k0 = (f32x4){bf2f(kv.x & 0xffff), bf2f(kv.x >> 16), bf2f(kv.y & 0xffff), bf2f(kv.y >> 16)}; k1 = (f32x4){bf2f(kv.z & 0xffff), bf2f(kv.z >> 16), bf2f(kv.w & 0xffff), bf2f(kv.w >> 16)};
                    v0 = (f32x4){bf2f(vv.x & 0xffff), bf2f(vv.x >> 16), bf2f(vv.y & 0xffff), bf2f(vv.y >> 16)}; v1 = (f32x4){bf2f(vv.z & 0xffff), bf2f(vv.z >> 16), bf2f(vv.w & 0xffff), bf2f(vv.w >> 16)}; }
                if (key >= 8) { const size_t o = (((size_t)(j * 32 + b) * 128 + (key - 8)) * 4 + kvh) * 64 + c8 * 8;
                    *(f32x4*)(F.out + O_WKS + o) = k0; *(f32x4*)(F.out + O_WKS + o + 4) = k1; *(f32x4*)(F.out + O_WVS + o) = v0; *(f32x4*)(F.out + O_WVS + o + 4) = v1; }
            }
            *(LAS u32x4*)(lds + AT_K + key * AT_KP + c8 * 16) = kv;
            const unsigned vw[4] = {vv.x, vv.y, vv.z, vv.w};
#pragma unroll
            for (int e = 0; e < 8; ++e) *(LAS unsigned short*)(lds + AT_V + (c8 * 8 + e) * AT_VP + key * 2) = (unsigned short)(e & 1 ? vw[e >> 1] >> 16 : vw[e >> 1] & 0xffff);
        }
        for (int i = TID; i < 64 * 24; i += NTHREADS) { const int dd = i / 24, kk = 256 + i % 24; *(LAS unsigned short*)(lds + AT_V + dd * AT_VP + kk * 2) = 0; }
        __syncthreads();
        const int hq = kvh * 8 + g;
        const float sink = a.in[I_SINK][j * 32 + hq];
        const LAS float* tbl = (const LAS float*)(lds + AT_B) + g * 128;
        LAS unsigned char* Pw = lds + AT_P + g * 16 * AT_PP;
        const int nqt = samp ? 1 : 8;
        for (int qt = 0; qt < nqt; ++qt) {
            int qrow; if (!samp) qrow = b * SEQ + qblk * 128 + qt * 16 + fr; else qrow = MP + b * 8 + (fr & 7);
            const bf16_t* qp = QKV + (size_t)qrow * QKVD + hq * 64 + fq * 8;
            const bf16x8 q0 = *(const bf16x8*)qp, q1 = *(const bf16x8*)(qp + 32);
            const int kb = 16 * qt;
            f32x4 sacc[9];
#pragma unroll
            for (int kt = 0; kt < 9; ++kt) { sacc[kt] = (f32x4){0.f, 0.f, 0.f, 0.f};
                const LAS unsigned char* kp = lds + AT_K + (kb + kt * 16 + fr) * AT_KP + fq * 16;
                const bf16x8 k0 = *(const LAS bf16x8*)kp, k1 = *(const LAS bf16x8*)(kp + 64);
                sacc[kt] = __builtin_amdgcn_mfma_f32_16x16x32_bf16(q0, k0, sacc[kt], 0, 0, 0);
                sacc[kt] = __builtin_amdgcn_mfma_f32_16x16x32_bf16(q1, k1, sacc[kt], 0, 0, 0); }
            float mx[4] = {-1e30f, -1e30f, -1e30f, -1e30f};
#pragma unroll
            for (int kt = 0; kt < 9; ++kt)
#pragma unroll
                for (int jj = 0; jj < 4; ++jj) { const int qi = qt * 16 + 4 * fq + jj, kj = kb + kt * 16 + fr, dist = qi + 128 - kj;
                    const bool valid = dist >= 0 && dist < 128 && (samp || qblk > 0 || kj >= 128);
                    const float s = valid ? sacc[kt][jj] * 0.125f + tbl[dist & 127] : -1e30f;
                    sacc[kt][jj] = s; mx[jj] = fmaxf(mx[jj], s); }
            float sm[4];
#pragma unroll
            for (int jj = 0; jj < 4; ++jj) { mx[jj] = fmaxf(row16_max(mx[jj]), sink); sm[jj] = 0.f; }
#pragma unroll
            for (int kt = 0; kt < 9; ++kt)
#pragma unroll
                for (int jj = 0; jj < 4; ++jj) { const float p = fast_exp(sacc[kt][jj] - mx[jj]); sm[jj] += p;
                    *(LAS unsigned short*)(Pw + (4 * fq + jj) * AT_PP + (kt * 16 + fr) * 2) = (unsigned short)(cvt_pk_bf16(p, 0.f) & 0xffff); }
#pragma unroll
            for (int jj = 0; jj < 4; ++jj) { *(LAS unsigned short*)(Pw + (4 * fq + jj) * AT_PP + (144 + fr) * 2) = 0; sm[jj] = row16_sum(sm[jj]) + fast_exp(sink - mx[jj]); }
            asm volatile("s_waitcnt lgkmcnt(0)" ::: "memory");
            f32x4 oacc[4];
#pragma unroll
            for (int dt = 0; dt < 4; ++dt) oacc[dt] = (f32x4){0.f, 0.f, 0.f, 0.f};
#pragma unroll
            for (int ks = 0; ks < 5; ++ks) { const bf16x8 pf = *(const LAS bf16x8*)(Pw + fr * AT_PP + (ks * 32 + fq * 8) * 2);
#pragma unroll
                for (int dt = 0; dt < 4; ++dt) { const bf16x8 vf = *(const LAS bf16x8*)(lds + AT_V + (dt * 16 + fr) * AT_VP + (kb + ks * 32 + fq * 8) * 2);
                    oacc[dt] = __builtin_amdgcn_mfma_f32_16x16x32_bf16(pf, vf, oacc[dt], 0, 0, 0); } }
#pragma unroll
            for (int jj = 0; jj < 4; ++jj) { const float inv = 1.0f / sm[jj]; const int ql = 4 * fq + jj;
                int orow; bool ok = true; if (!samp) orow = b * SEQ + qblk * 128 + qt * 16 + ql; else { orow = MP + b * 8 + (ql & 7); ok = ql < 8; }
                if (ok) {
#pragma unroll
                    for (int dt = 0; dt < 4; ++dt) F.XB[(size_t)orow * D + hq * 64 + dt * 16 + fr] = (bf16_t)(cvt_pk_bf16(oacc[dt][jj] * inv, 0.f) & 0xffff); } }
            asm volatile("s_waitcnt lgkmcnt(0)" ::: "memory");
        }
    }
}

constexpr int SC_TS = 32, SC_VEC = 0, SC_VQ = 5 * SC_TS * 64 * 4, SC_SC = SC_VQ + SC_TS * 16 * 4, SC_BUF = SC_SC + (SC_TS + 1) * 4 * 4 + 64;
static_assert(2 * SC_BUF <= RING_BYTES && SC_BUF % 16 == 0, "scan LDS");
struct ScanChunk { int m0, n, h, q; bool first, last, samp; int b; };
__device__ __forceinline__ ScanChunk scan_chunk(int ci, int w) {
    ScanChunk c;
    if (ci < 128) { const int pc = w & 63; c.b = pc >> 5; c.h = pc & 31; c.q = w >> 6; c.m0 = c.b * SEQ + ci * SC_TS; c.n = SC_TS; c.first = ci == 0; c.last = ci == 127; c.samp = false; }
    else { const int sc = (ci - 128) * 64 + (w & 63); c.q = w >> 6; c.b = sc >> 5; c.h = sc & 31; c.m0 = MP + c.b * 8; c.n = 8; c.first = true; c.last = true; c.samp = true; }
    return c;
}
struct ScanRegs { f32x4 r[2], k[2], w[2], a[2], v; };
template <int CTRL> __device__ __forceinline__ float dpp_t(float x) { return __int_as_float(__builtin_amdgcn_update_dpp(0, __float_as_int(x), CTRL, 0xf, 0xf, false)); }
__device__ __forceinline__ float oct_sum(float x) { x += dpp_t<0xB1>(x); x += dpp_t<0x4E>(x); x += dpp_t<0x141>(x); return x; }
__device__ __forceinline__ void scan_issue(const Frame& F, const ScanChunk& c, ScanRegs& g, const int ptid) {
    const bf16_t* R = (const bf16_t*)(F.ws + WS_RKV); const bf16_t* Kx = R + (size_t)M * D; const bf16_t* V = Kx + (size_t)M * D;
    const float* DEC = (const float*)(F.ws + WS_LUP); const float* AIC = DEC + (size_t)M * D;
    const int s = ptid >> 3, cg = ptid & 7;
    if (s < c.n) { const size_t base = (size_t)(c.m0 + s) * D + c.h * 64 + cg * 8;
#pragma unroll
        for (int e = 0; e < 2; ++e) { g.r[e] = ld_bf4(R + base + 4 * e); g.k[e] = ld_bf4(Kx + base + 4 * e); g.w[e] = *(const f32x4*)(DEC + base + 4 * e); g.a[e] = *(const f32x4*)(AIC + base + 4 * e); }
        g.v = ld_bf4(V + (size_t)(c.m0 + s) * D + c.h * 64 + c.q * 16 + (cg & 3) * 4); }
}
__device__ __forceinline__ void scan_derive(const Frame& F, const ScanChunk& c, const ScanRegs& g, LAS unsigned char* buf, int j, const int ptid) {
    const Args& a = *F.a;
    float* BON = (float*)(F.ws + WS_BONUS);
    const int s = ptid >> 3, cg = ptid & 7;
    if (s < c.n) {
        const size_t pc = (size_t)j * D + c.h * 64 + cg * 8;
        float n2 = 0.f, sbr = 0.f, kr = 0.f, bon = 0.f;
        LAS float* vec = (LAS float*)(buf + SC_VEC) + s * 64 + cg * 8;
#pragma unroll
        for (int e = 0; e < 2; ++e) {
            const f32x4 k_k = *(const f32x4*)(a.in[I_KK] + pc + 4 * e), k_a = *(const f32x4*)(a.in[I_KA] + pc + 4 * e), r_k = *(const f32x4*)(a.in[I_RK] + pc + 4 * e);
            const f32x4 r = g.r[e], k = g.k[e], w = g.w[e], ai = g.a[e];
            const f32x4 kk = k * k_k, km = k * ((ai - 1.0f) * k_a + 1.0f), bb = kk * ai, wr = w * r;
            const f32x4 t0 = kk * kk, t1 = bb * r, t2 = km * r, t3 = t2 * r_k;
            n2 += (t0.x + t0.y) + (t0.z + t0.w); sbr += (t1.x + t1.y) + (t1.z + t1.w); kr += (t2.x + t2.y) + (t2.z + t2.w); bon += (t3.x + t3.y) + (t3.z + t3.w);
            *(LAS f32x4*)(vec + (0 * SC_TS) * 64 + 4 * e) = kk; *(LAS f32x4*)(vec + (1 * SC_TS) * 64 + 4 * e) = wr; *(LAS f32x4*)(vec + (2 * SC_TS) * 64 + 4 * e) = w;
            *(LAS f32x4*)(vec + (3 * SC_TS) * 64 + 4 * e) = bb; *(LAS f32x4*)(vec + (4 * SC_TS) * 64 + 4 * e) = km;
        }
        n2 = oct_sum(n2); sbr = oct_sum(sbr); kr = oct_sum(kr); bon = oct_sum(bon);
        if (cg < 4) *(LAS f32x4*)((LAS float*)(buf + SC_VQ) + s * 16 + cg * 4) = g.v;
        if (cg == 0) { *(LAS f32x4*)((LAS float*)(buf + SC_SC) + s * 4) = (f32x4){1.0f / fmaxf(n2, 1e-24f), sbr, kr, 0.f}; if (c.q == 0) BON[(size_t)(c.m0 + s) * 32 + c.h] = bon; }
    }
}
__device__ __forceinline__ void phase_scan(const Frame& F, int j) {
    int tid_ = threadIdx.x; asm volatile("" : "+v"(tid_)); int bid_ = blockIdx.x; asm volatile("" : "+s"(bid_));
    const int LANE = tid_ & 63, WAVE = __builtin_amdgcn_readfirstlane(tid_ >> 6), BID = bid_;
    const Args& a = *F.a;
    float* Y = (float*)(F.ws + WS_Y);
    const int w = BID, lane = LANE, wave = WAVE, rg = lane >> 4, c4 = lane & 15;
    constexpr int CI0 = 128, NCH = 128 + 16;
    __syncthreads();
    if (wave >= 4) {
        const int ptid = tid_ - 256;
        ScanRegs ga, gb;
        { const ScanChunk c0 = scan_chunk(CI0, w); scan_issue(F, c0, ga, ptid); scan_derive(F, c0, ga, F.lds + (CI0 & 1) * SC_BUF, j, ptid); }
        { const ScanChunk c1 = scan_chunk(CI0 + 1, w); scan_issue(F, c1, ga, ptid); }
        __syncthreads();
        for (int ci = CI0; ci < NCH; ++ci) {
            if (ci + 2 < NCH) { const ScanChunk c2 = scan_chunk(ci + 2, w); scan_issue(F, c2, gb, ptid); }
            asm volatile("" ::: "memory");
            if (ci + 1 < NCH) { const ScanChunk c1 = scan_chunk(ci + 1, w); scan_derive(F, c1, ga, F.lds + ((ci + 1) & 1) * SC_BUF, j, ptid); }
            ga = gb;
            __syncthreads();
        }
    } else {
        const float* SW = a.in[I_SWKV] + (size_t)j * 32 * 32 * 4096;
        f32x4 Sn;
        { const ScanChunk c0 = scan_chunk(CI0, w); Sn = *(const f32x4*)(SW + (((size_t)c0.b * 32 + c0.h) * 64 + c0.q * 16 + wave * 4 + rg) * 64 + 4 * c4); }
        __syncthreads();
        f32x4 S = (f32x4){0.f, 0.f, 0.f, 0.f};
        for (int ci = CI0; ci < NCH; ++ci) {
            LAS unsigned char* buf = F.lds + (ci & 1) * SC_BUF;
            const ScanChunk c = scan_chunk(ci, w);
            const int row = c.q * 16 + wave * 4 + rg;
            const size_t soff = (((size_t)c.b * 32 + c.h) * 64 + row) * 64 + 4 * c4;
            if (c.first) { if (c.samp) S = Sn; else S = (f32x4){0.f, 0.f, 0.f, 0.f}; }
            if (ci + 1 < NCH) { const ScanChunk cn = scan_chunk(ci + 1, w); if (cn.samp) Sn = *(const f32x4*)(SW + (((size_t)cn.b * 32 + cn.h) * 64 + cn.q * 16 + wave * 4 + rg) * 64 + 4 * c4); }
            const LAS float* vec = (const LAS float*)(buf + SC_VEC) + 4 * c4; const LAS float* vq = (const LAS float*)(buf + SC_VQ) + wave * 4 + rg; const LAS float* scl = (const LAS float*)(buf + SC_SC);
            float* yp = Y + (size_t)(c.m0 + c4) * D + c.h * 64 + row;
            float ycap = 0.f;
            f32x4 Akk, Awr, Awd, Abb, Akm, Asc, Bkk, Bwr, Bwd, Bbb, Bkm, Bsc; float Avv, Bvv;
#define SC_LOAD(P, s_) do { P##kk = *(const LAS f32x4*)(vec + (0 * SC_TS + (s_)) * 64); P##wr = *(const LAS f32x4*)(vec + (1 * SC_TS + (s_)) * 64); P##wd = *(const LAS f32x4*)(vec + (2 * SC_TS + (s_)) * 64); \
        P##bb = *(const LAS f32x4*)(vec + (3 * SC_TS + (s_)) * 64); P##km = *(const LAS f32x4*)(vec + (4 * SC_TS + (s_)) * 64); P##sc = *(const LAS f32x4*)(scl + (s_) * 4); P##vv = vq[(s_) * 16]; } while (0)
#define SC_STEP(P, s_) do { float p = (S.x * P##kk.x + S.y * P##kk.y) + (S.z * P##kk.z + S.w * P##kk.w); float qv = (S.x * P##wr.x + S.y * P##wr.y) + (S.z * P##wr.z + S.w * P##wr.w); \
        p = row16_sum(p); qv = row16_sum(qv); const float sa2 = -P##sc.x * p; const float y = qv + sa2 * P##sc.y + P##vv * P##sc.z; \
        S = S * P##wd + P##bb * sa2 + P##km * P##vv; ycap = (((s_) & 15) == c4) ? y : ycap; } while (0)
            SC_LOAD(A, 0);
            for (int s = 0; s < c.n; s += 2) {
                SC_LOAD(B, s + 1);
                SC_STEP(A, s);
                SC_LOAD(A, s + 2);
                SC_STEP(B, s + 1);
                if (((s + 2) & 15) == 0 || s + 2 == c.n) { if (c4 < ((c.n < 16) ? c.n : 16)) yp[(size_t)((s + 2 - 1) & ~15) * D] = ycap; }
            }
#undef SC_LOAD
#undef SC_STEP
            if (c.last) { float* fo = F.out + (c.samp ? O_WKVS : O_WKVP) + soff; *(f32x4*)fo = S; }
            __syncthreads();
        }
    }
}

constexpr int CK_OPP = 144, CK_SLOT = 64 * CK_OPP, CK_FP = 65, CK_F0 = 14 * CK_SLOT, CK_F1 = CK_F0 + 64 * CK_FP * 4, CK_END = CK_F1 + 64 * CK_FP * 4;
static_assert(CK_END <= MISC_OFF, "chunk-scan LDS");
__device__ __forceinline__ void ck_mm(LAS unsigned char* lds, int aslot, int bslot, int rt, int ct0, int l15, int quad, f32x4 (&acc)[2]) {
    const LAS unsigned char* ap = lds + aslot * CK_SLOT + (rt * 16 + l15) * CK_OPP + quad * 16;
    const bf16x8 a0 = *(const LAS bf16x8*)ap, a1 = *(const LAS bf16x8*)(ap + 64);
#pragma unroll
    for (int cc = 0; cc < 2; ++cc) { const LAS unsigned char* bp = lds + bslot * CK_SLOT + ((ct0 + cc) * 16 + l15) * CK_OPP + quad * 16;
        const bf16x8 b0 = *(const LAS bf16x8*)bp, b1 = *(const LAS bf16x8*)(bp + 64);
        acc[cc] = __builtin_amdgcn_mfma_f32_16x16x32_bf16(a0, b0, acc[cc], 0, 0, 0);
        acc[cc] = __builtin_amdgcn_mfma_f32_16x16x32_bf16(a1, b1, acc[cc], 0, 0, 0); }
}
__device__ __forceinline__ void ck_mm_t(LAS unsigned char* lds, int aslot, int bslot, int rt, int ct0, int l15, int quad, f32x4 (&acc)[2]) {
    const LAS unsigned char* ap = lds + aslot * CK_SLOT + (rt * 16 + l15) * CK_OPP + quad * 16;
    const bf16x8 a0 = *(const LAS bf16x8*)ap, a1 = *(const LAS bf16x8*)(ap + 64);
#pragma unroll
    for (int cc = 0; cc < 2; ++cc) { const LAS unsigned char* bp = lds + bslot * CK_SLOT + ((ct0 + cc) * 16 + l15) * CK_OPP + quad * 16;
        const bf16x8 b0 = *(const LAS bf16x8*)bp, b1 = *(const LAS bf16x8*)(bp + 64);
        acc[cc] = __builtin_amdgcn_mfma_f32_16x16x32_bf16(b0, a0, acc[cc], 0, 0, 0);
        acc[cc] = __builtin_amdgcn_mfma_f32_16x16x32_bf16(b1, a1, acc[cc], 0, 0, 0); }
}
__device__ __forceinline__ void ck_st_rm(LAS unsigned char* lds, int slot, int rt, int ct, int l15, int quad, const f32x4& v) {
#pragma unroll
    for (int g = 0; g < 4; ++g) *(LAS unsigned short*)(lds + slot * CK_SLOT + (rt * 16 + quad * 4 + g) * CK_OPP + (ct * 16 + l15) * 2) = (unsigned short)(cvt_pk_bf16(v[g], 0.f) & 0xffffu);
}
__device__ __forceinline__ void ck_st_tr(LAS unsigned char* lds, int slot, int rt, int ct, int l15, int quad, const f32x4& v) {
    u32x2 w; w.x = cvt_pk_bf16(v[0], v[1]); w.y = cvt_pk_bf16(v[2], v[3]);
    *(LAS u32x2*)(lds + slot * CK_SLOT + (ct * 16 + l15) * CK_OPP + (rt * 16 + quad * 4) * 2) = w;
}
__device__ __forceinline__ void ck_st_rm_t(LAS unsigned char* lds, int slot, int rt, int ct, int l15, int quad, const f32x4& v) {
    u32x2 w; w.x = cvt_pk_bf16(v[0], v[1]); w.y = cvt_pk_bf16(v[2], v[3]);
    *(LAS u32x2*)(lds + slot * CK_SLOT + (rt * 16 + l15) * CK_OPP + (ct * 16 + quad * 4) * 2) = w;
}
#define CK_BAR() do { asm volatile("s_waitcnt lgkmcnt(0)" ::: "memory"); __builtin_amdgcn_s_barrier(); asm volatile("" ::: "memory"); } while (0)
__device__ __forceinline__ void phase_ck1(const Frame& F, int j) {
    int tid_ = threadIdx.x; asm volatile("" : "+v"(tid_)); int bid_ = blockIdx.x; asm volatile("" : "+s"(bid_));
    const int TID = tid_, LANE = tid_ & 63, WAVE = __builtin_amdgcn_readfirstlane(tid_ >> 6), BID = bid_;
    const Args& a = *F.a;
    LAS unsigned char* lds = F.lds;
    const bf16_t* R = (const bf16_t*)(F.ws + WS_RKV); const bf16_t* Kx = R + (size_t)M * D; const bf16_t* V = Kx + (size_t)M * D;
    const float* DEC = (const float*)(F.ws + WS_LUP); const float* AIC = DEC + (size_t)M * D;
    float* BON = (float*)(F.ws + WS_BONUS);
    float* CKA = (float*)(F.ws + WS_CKA); float* CKB = (float*)(F.ws + WS_CKB);
    LAS float* F0 = (LAS float*)(lds + CK_F0); LAS float* F1 = (LAS float*)(lds + CK_F1); LAS float* TOT = (LAS float*)(lds + 8 * CK_SLOT);
    const int t = TID >> 3, cg = TID & 7;
    const int seg = TID >> 6, jj = TID & 63;
    const int l15 = LANE & 15, quad = LANE >> 4, rt = WAVE >> 1, ct0 = (WAVE & 1) * 2;
    f32x4 nr[2], nk[2], nw[2], na[2], nv[2];
#define CK_FETCH(item_) do { const int pc_ = (item_) >> 6, c_ = (item_) & 63; const size_t base_ = (size_t)((pc_ >> 5) * SEQ + c_ * 64 + t) * D + (pc_ & 31) * 64 + cg * 8; \
        _Pragma("unroll") for (int e = 0; e < 2; ++e) { nr[e] = ld_bf4(R + base_ + 4 * e); nk[e] = ld_bf4(Kx + base_ + 4 * e); nw[e] = *(const f32x4*)(DEC + base_ + 4 * e); \
            na[e] = *(const f32x4*)(AIC + base_ + 4 * e); nv[e] = ld_bf4(V + base_ + 4 * e); } } while (0)
    CK_FETCH(BID);
    for (int it = 0; it < 16; ++it) {
        const int item = it * 256 + BID, pc = item >> 6, c = item & 63, b = pc >> 5, h = pc & 31, m0 = b * SEQ + c * 64;
        float kk[8], bb[8], km[8], rr[8], vv[8];
        { const size_t pb = (size_t)j * D + h * 64 + cg * 8;
          float n2 = 0.f, bon = 0.f;
#pragma unroll
          for (int e = 0; e < 2; ++e) {
              const f32x4 r4 = nr[e], k4 = nk[e], w4 = nw[e], a4 = na[e], v4 = nv[e];
              const f32x4 k_k = *(const f32x4*)(a.in[I_KK] + pb + 4 * e), k_a = *(const f32x4*)(a.in[I_KA] + pb + 4 * e), r_k = *(const f32x4*)(a.in[I_RK] + pb + 4 * e);
#pragma unroll
              for (int x = 0; x < 4; ++x) { const int i = 4 * e + x; const float kp = k4[x] * k_k[x]; kk[i] = kp; n2 += kp * kp; km[i] = k4[x] * (1.0f + (a4[x] - 1.0f) * k_a[x]); bb[i] = a4[x]; rr[i] = r4[x]; vv[i] = v4[x];
                  bon += r4[x] * km[i] * r_k[x]; F0[t * CK_FP + cg * 8 + i] = __builtin_amdgcn_logf(w4[x]); } }
          n2 = oct_sum(n2); bon = oct_sum(bon);
          const float inv = 1.0f / fmaxf(sqrtf(n2), 1e-12f);
#pragma unroll
          for (int i = 0; i < 8; ++i) { kk[i] *= inv; bb[i] *= kk[i]; }
          if (cg == 0) BON[(size_t)(m0 + t) * 32 + h] = bon; }
        if (it + 1 < 16) CK_FETCH(item + 256);
        CK_BAR();
        float xs[8];
#pragma unroll
        for (int i = 0; i < 8; ++i) { xs[i] = F0[(seg * 8 + i) * CK_FP + jj]; if (i) xs[i] += xs[i - 1]; }
        TOT[seg * 64 + jj] = xs[7];
        CK_BAR();
        { float off = 0.f;
#pragma unroll
          for (int s2 = 0; s2 < 7; ++s2) off += (s2 < seg) ? TOT[s2 * 64 + jj] : 0.f;
#pragma unroll
          for (int i = 0; i < 8; ++i) F0[(seg * 8 + i) * CK_FP + jj] = xs[i] + off; }
        CK_BAR();
        { unsigned pa[4], pbt[4], pk[4], pr[4], pkh[4];
          float av[8], bv[8], kv[8], rv[8], khv[8];
#pragma unroll
          for (int i = 0; i < 8; ++i) { const int col = cg * 8 + i;
              const float lgt = F0[t * CK_FP + col], lgp = t > 0 ? F0[(t - 1) * CK_FP + col] : 0.f, lgL = F0[63 * CK_FP + col];
              const float g = __builtin_amdgcn_exp2f(lgt), gp = __builtin_amdgcn_exp2f(lgp), gi = __builtin_amdgcn_exp2f(-lgt), gh = __builtin_amdgcn_exp2f(lgL - lgt);
              av[i] = -kk[i] * gp; bv[i] = bb[i] * gi; kv[i] = km[i] * gi; rv[i] = rr[i] * g; khv[i] = km[i] * gh;
              F1[t * CK_FP + col] = rv[i];
              *(LAS unsigned short*)(lds + 4 * CK_SLOT + col * CK_OPP + t * 2) = (unsigned short)(cvt_pk_bf16(av[i], 0.f) & 0xffffu);
              *(LAS unsigned short*)(lds + 5 * CK_SLOT + col * CK_OPP + t * 2) = (unsigned short)(cvt_pk_bf16(bb[i] * gh, 0.f) & 0xffffu);
              *(LAS unsigned short*)(lds + 6 * CK_SLOT + col * CK_OPP + t * 2) = (unsigned short)(cvt_pk_bf16(vv[i], 0.f) & 0xffffu); }
#pragma unroll
          for (int i = 0; i < 4; ++i) { pa[i] = cvt_pk_bf16(av[2 * i], av[2 * i + 1]); pbt[i] = cvt_pk_bf16(bv[2 * i], bv[2 * i + 1]); pk[i] = cvt_pk_bf16(kv[2 * i], kv[2 * i + 1]); pr[i] = cvt_pk_bf16(rv[2 * i], rv[2 * i + 1]); pkh[i] = cvt_pk_bf16(khv[2 * i], khv[2 * i + 1]); }
          const int ro = t * CK_OPP + cg * 16;
          *(LAS u32x4*)(lds + 0 * CK_SLOT + ro) = (u32x4){pa[0], pa[1], pa[2], pa[3]}; *(LAS u32x4*)(lds + 1 * CK_SLOT + ro) = (u32x4){pbt[0], pbt[1], pbt[2], pbt[3]};
          *(LAS u32x4*)(lds + 2 * CK_SLOT + ro) = (u32x4){pk[0], pk[1], pk[2], pk[3]}; *(LAS u32x4*)(lds + 3 * CK_SLOT + ro) = (u32x4){pr[0], pr[1], pr[2], pr[3]};
          *(LAS u32x4*)(lds + 7 * CK_SLOT + ro) = (u32x4){pkh[0], pkh[1], pkh[2], pkh[3]}; }
        CK_BAR();
        const f32x4 Z4 = (f32x4){0.f, 0.f, 0.f, 0.f};
        f32x4 TmN[2], TmR[2];
        { f32x4 gabn[2] = {Z4, Z4}, gabt[2] = {Z4, Z4}, gakt[2] = {Z4, Z4}, mbrn[2] = {Z4, Z4}, mkrt[2] = {Z4, Z4};
          ck_mm(lds, 1, 0, rt, ct0, l15, quad, gabn); ck_mm_t(lds, 1, 0, rt, ct0, l15, quad, gabt); ck_mm_t(lds, 2, 0, rt, ct0, l15, quad, gakt); ck_mm(lds, 1, 3, rt, ct0, l15, quad, mbrn); ck_mm_t(lds, 2, 3, rt, ct0, l15, quad, mkrt);
#pragma unroll
          for (int cc = 0; cc < 2; ++cc) { const int ct = ct0 + cc;
#pragma unroll
              for (int g = 0; g < 4; ++g) { const int rown = rt * 16 + quad * 4 + g, coln = ct * 16 + l15, rowt = rt * 16 + l15, colt = ct * 16 + quad * 4 + g;
                  gabn[cc][g] = rown < coln ? gabn[cc][g] : 0.f; mbrn[cc][g] = rown <= coln ? mbrn[cc][g] : 0.f;
                  gabt[cc][g] = rowt < colt ? gabt[cc][g] : 0.f; gakt[cc][g] = rowt < colt ? gakt[cc][g] : 0.f; mkrt[cc][g] = rowt <= colt ? mkrt[cc][g] : 0.f;
                  TmN[cc][g] = gabn[cc][g] + (rown == coln ? 1.0f : 0.f); TmR[cc][g] = gabt[cc][g] + (rowt == colt ? 1.0f : 0.f); }
              ck_st_rm_t(lds, 8, rt, ct, l15, quad, gabt[cc]); ck_st_tr(lds, 9, rt, ct, l15, quad, gabn[cc]); ck_st_rm_t(lds, 10, rt, ct, l15, quad, gakt[cc]);
              ck_st_tr(lds, 11, rt, ct, l15, quad, mbrn[cc]); ck_st_rm_t(lds, 12, rt, ct, l15, quad, mkrt[cc]); ck_st_rm_t(lds, 13, rt, ct, l15, quad, TmR[cc]); } }
        CK_BAR();
        { f32x4 x2n[2] = {Z4, Z4}, x2t[2] = {Z4, Z4};
          ck_mm(lds, 8, 9, rt, ct0, l15, quad, x2n); ck_mm_t(lds, 8, 9, rt, ct0, l15, quad, x2t);
#pragma unroll
          for (int cc = 0; cc < 2; ++cc) { ck_st_rm_t(lds, 0, rt, ct0 + cc, l15, quad, x2t[cc]); ck_st_tr(lds, 1, rt, ct0 + cc, l15, quad, x2n[cc]); } }
        CK_BAR();
#pragma unroll
        for (int k = 0; k < 4; ++k) {
            const int xin = (k & 1) ? 8 : 0, xout = (k & 1) ? 0 : 8, tin = (k & 1) ? 2 : 13, tout = (k & 1) ? 13 : 2;
            f32x4 x2n[2] = {Z4, Z4}, x2t[2] = {Z4, Z4}, tpn[2] = {Z4, Z4}, tpt[2] = {Z4, Z4};
            ck_mm(lds, xin, xin + 1, rt, ct0, l15, quad, x2n); ck_mm_t(lds, xin, xin + 1, rt, ct0, l15, quad, x2t); ck_mm(lds, tin, xin + 1, rt, ct0, l15, quad, tpn); ck_mm_t(lds, tin, xin + 1, rt, ct0, l15, quad, tpt);
#pragma unroll
            for (int cc = 0; cc < 2; ++cc) { TmN[cc] += tpn[cc]; TmR[cc] += tpt[cc];
                ck_st_rm_t(lds, xout, rt, ct0 + cc, l15, quad, x2t[cc]); ck_st_tr(lds, xout + 1, rt, ct0 + cc, l15, quad, x2n[cc]); ck_st_rm_t(lds, tout, rt, ct0 + cc, l15, quad, TmR[cc]); }
            CK_BAR();
        }
        { f32x4 tpn[2] = {Z4, Z4};
          ck_mm(lds, 13, 1, rt, ct0, l15, quad, tpn);
#pragma unroll
          for (int cc = 0; cc < 2; ++cc) { TmN[cc] += tpn[cc]; ck_st_tr(lds, 3, rt, ct0 + cc, l15, quad, TmN[cc]); } }
        CK_BAR();
        { f32x4 w1[2] = {Z4, Z4}, w2[2] = {Z4, Z4};
          ck_mm_t(lds, 4, 3, rt, ct0, l15, quad, w1); ck_mm_t(lds, 10, 3, rt, ct0, l15, quad, w2);
#pragma unroll
          for (int cc = 0; cc < 2; ++cc) { ck_st_rm_t(lds, 8, rt, ct0 + cc, l15, quad, w1[cc]); ck_st_rm_t(lds, 9, rt, ct0 + cc, l15, quad, w2[cc]); } }
        CK_BAR();
        { f32x4 pp[2] = {(f32x4){0.f, 0.f, 0.f, 0.f}, (f32x4){0.f, 0.f, 0.f, 0.f}}, zq[2] = {(f32x4){0.f, 0.f, 0.f, 0.f}, (f32x4){0.f, 0.f, 0.f, 0.f}},
                wh[2] = {(f32x4){0.f, 0.f, 0.f, 0.f}, (f32x4){0.f, 0.f, 0.f, 0.f}}, zy[2] = {(f32x4){0.f, 0.f, 0.f, 0.f}, (f32x4){0.f, 0.f, 0.f, 0.f}};
          ck_mm_t(lds, 8, 5, rt, ct0, l15, quad, pp); ck_mm(lds, 9, 5, rt, ct0, l15, quad, zq); ck_mm_t(lds, 8, 11, rt, ct0, l15, quad, wh); ck_mm(lds, 9, 11, rt, ct0, l15, quad, zy);
          float* gP = CKA + (size_t)item * 8192; float* gW = gP + 4096;
#pragma unroll
          for (int cc = 0; cc < 2; ++cc) { const int ct = ct0 + cc, col = ct * 16 + l15;
              { const int trow = rt * 16 + l15, tcol = ct * 16 + quad * 4;
                f32x4 pv = pp[cc], wv = wh[cc];
#pragma unroll
                for (int g = 0; g < 4; ++g) { pv[g] += (trow == tcol + g) ? __builtin_amdgcn_exp2f(F0[63 * CK_FP + trow]) : 0.f; wv[g] += F1[(tcol + g) * CK_FP + trow]; }
                *(f32x4*)(gP + trow * 64 + tcol) = pv; *(f32x4*)(gW + trow * 64 + tcol) = wv; }
#pragma unroll
              for (int g = 0; g < 4; ++g) { const int row = rt * 16 + quad * 4 + g;
                  zq[cc][g] += bf2f(*(const LAS unsigned short*)(lds + 7 * CK_SLOT + row * CK_OPP + col * 2));
                  zy[cc][g] += bf2f(*(const LAS unsigned short*)(lds + 12 * CK_SLOT + row * CK_OPP + col * 2)); }
              ck_st_tr(lds, 0, rt, ct, l15, quad, zq[cc]); ck_st_tr(lds, 1, rt, ct, l15, quad, zy[cc]); } }
        CK_BAR();
        { f32x4 qq[2] = {(f32x4){0.f, 0.f, 0.f, 0.f}, (f32x4){0.f, 0.f, 0.f, 0.f}}, yl[2] = {(f32x4){0.f, 0.f, 0.f, 0.f}, (f32x4){0.f, 0.f, 0.f, 0.f}};
          ck_mm_t(lds, 6, 0, rt, ct0, l15, quad, qq); ck_mm_t(lds, 6, 1, rt, ct0, l15, quad, yl);
          float* gQ = CKB + (size_t)item * 8192; float* gY = gQ + 4096;
#pragma unroll
          for (int cc = 0; cc < 2; ++cc) { const int o = (rt * 16 + l15) * 64 + (ct0 + cc) * 16 + quad * 4; *(f32x4*)(gQ + o) = qq[cc]; *(f32x4*)(gY + o) = yl[cc]; } }
        CK_BAR();
    }
#undef CK_FETCH
}
__device__ __forceinline__ void phase_ck2(const Frame& F, int j) {
    int tid_ = threadIdx.x; asm volatile("" : "+v"(tid_)); int bid_ = blockIdx.x; asm volatile("" : "+s"(bid_));
    const int LANE = tid_ & 63, WAVE = __builtin_amdgcn_readfirstlane(tid_ >> 6), BID = bid_;
    const float* CKA = (const float*)(F.ws + WS_CKA); const float* CKB = (const float*)(F.ws + WS_CKB);
    float* Y = (float*)(F.ws + WS_Y);
    const int pc = BID & 63, q = BID >> 6, b = pc >> 5, h = pc & 31, mat = WAVE >> 2, ct = WAVE & 3, l15 = LANE & 15, quad = LANE >> 4;
    constexpr int SP = 68;
    LAS float* Sb = (LAS float*)F.lds;
    for (int i = tid_; i < 2 * 16 * SP; i += NTHREADS) Sb[i] = 0.f;
    const float* opB = CKA + (size_t)(pc * 64) * 8192 + mat * 4096 + quad * 64 + ct * 16 + l15;
    const float* opC = CKB + (size_t)(pc * 64) * 8192 + mat * 4096 + (q * 16 + quad * 4) * 64 + ct * 16 + l15;
    float nb[16]; f32x4 nc;
#pragma unroll
    for (int ks = 0; ks < 16; ++ks) nb[ks] = opB[ks * 256];
#pragma unroll
    for (int g = 0; g < 4; ++g) nc[g] = opC[g * 64];
    CK_BAR();
    f32x4 acc = (f32x4){0.f, 0.f, 0.f, 0.f};
    for (int c = 0; c < 64; ++c) {
        float bcur[16];
#pragma unroll
        for (int ks = 0; ks < 16; ++ks) bcur[ks] = nb[ks];
        acc = nc;
        if (c + 1 < 64) {
#pragma unroll
            for (int ks = 0; ks < 16; ++ks) nb[ks] = opB[(size_t)(c + 1) * 8192 + ks * 256];
#pragma unroll
            for (int g = 0; g < 4; ++g) nc[g] = opC[(size_t)(c + 1) * 8192 + g * 64];
        }
        const LAS float* sa = Sb + (c & 1) * 16 * SP + l15 * SP + quad;
#pragma unroll
        for (int ks = 0; ks < 16; ++ks) acc = __builtin_amdgcn_mfma_f32_16x16x4f32(sa[4 * ks], bcur[ks], acc, 0, 0, 0);
        if (mat == 0) {
            LAS float* sn = Sb + ((c + 1) & 1) * 16 * SP + (quad * 4) * SP + ct * 16 + l15;
#pragma unroll
            for (int g = 0; g < 4; ++g) sn[g * SP] = acc[g];
        } else {
            float* yp = Y + (size_t)(b * SEQ + c * 64 + ct * 16 + l15) * D + h * 64 + q * 16 + quad * 4;
            *(f32x4*)yp = acc;
        }
        CK_BAR();
    }
    if (mat == 0) { float* fo = F.out + O_WKVP + (((size_t)b * 32 + h) * 64 + q * 16 + quad * 4) * 64 + ct * 16 + l15;
#pragma unroll
        for (int g = 0; g < 4; ++g) fo[g * 64] = acc[g]; }
}

__device__ __forceinline__ void phase_rwkvpost(const Frame& F, int j) {
    int tid_ = threadIdx.x; asm volatile("" : "+v"(tid_)); int bid_ = blockIdx.x; asm volatile("" : "+s"(bid_));
    const int TID = tid_, LANE = tid_ & 63, WAVE = __builtin_amdgcn_readfirstlane(tid_ >> 6), BID = bid_; (void)TID; (void)LANE; (void)WAVE; (void)BID;

    const Args& a = *F.a;
    const int gw = BID * NWAVES + WAVE, NGW = gridDim.x * NWAVES;
    const float* Y = (const float*)(F.ws + WS_Y); const bf16_t* V = (const bf16_t*)(F.ws + WS_RKV) + (size_t)2 * M * D; const bf16_t* G = (const bf16_t*)((const float*)(F.ws + WS_LUP) + (size_t)2 * M * D);
    const float* BON = (const float*)(F.ws + WS_BONUS);
    const float* lnw = a.in[I_LNW] + (size_t)j * D; const float* lnb = a.in[I_LNB] + (size_t)j * D;
    for (int m = gw; m < M; m += NGW) {
        f32x4 yv[8]; u32x2 gv[8], vv[8]; float bv[8];
#pragma unroll
        for (int jj = 0; jj < 8; ++jj) { const int col = 4 * (LANE + 64 * jj), head = col >> 6; const size_t off = (size_t)m * D + col;
            yv[jj] = *(const f32x4*)(Y + off); gv[jj] = *(const u32x2*)(G + off); vv[jj] = *(const u32x2*)(V + off); bv[jj] = BON[(size_t)m * 32 + head]; }
#pragma unroll
        for (int jj = 0; jj < 8; ++jj) { const int col = 4 * (LANE + 64 * jj); const size_t off = (size_t)m * D + col;
            const f32x4 y = yv[jj];
            const float mean = row16_sum((y.x + y.y) + (y.z + y.w)) * (1.0f / 64.0f);
            const f32x4 d = y - mean;
            const float var = row16_sum((d.x * d.x + d.y * d.y) + (d.z * d.z + d.w * d.w)) * (1.0f / 64.0f);
            const float rs = 1.0f / sqrtf(var + GN_EPS);
            const f32x4 yn = d * rs * *(const f32x4*)(lnw + col) + *(const f32x4*)(lnb + col);
            const float bon = bv[jj];
            const u32x2 gw2 = gv[jj]; const f32x4 gg = (f32x4){bf2f(gw2.x & 0xffff), bf2f(gw2.x >> 16), bf2f(gw2.y & 0xffff), bf2f(gw2.y >> 16)};
            const u32x2 vw = vv[jj]; const f32x4 v4 = (f32x4){__uint_as_float(vw.x << 16), __uint_as_float(vw.x & 0xffff0000u), __uint_as_float(vw.y << 16), __uint_as_float(vw.y & 0xffff0000u)};
            const f32x4 o = (yn + v4 * bon) * gg;
            u32x2 wv; wv.x = cvt_pk_bf16(o.x, o.y); wv.y = cvt_pk_bf16(o.z, o.w); *(u32x2*)(F.XB + off) = wv; }
    }
}

__global__ void __launch_bounds__(NTHREADS, 2) fwd_kernel(Args args) {
    extern __shared__ __attribute__((aligned(16))) unsigned char lds_raw[];
    Frame F;
    F.lds = (LAS unsigned char*)lds_raw;
    F.a = &args; F.ws = args.ws; F.out = args.out;
    F.X = (float*)(args.ws + WS_X); F.U = (float*)(args.ws + WS_U); F.XB = (bf16_t*)(args.ws + WS_XB);
    volatile LAS unsigned* MISC = (volatile LAS unsigned*)(F.lds + MISC_OFF);
    if (threadIdx.x < 64) MISC[threadIdx.x] = 0u;
    __syncthreads();
    unsigned* ctl = (unsigned*)(args.ws + WS_CTL);
    XcdBarrier bar; bar.bar = ctl + CW_BAR; bar.x = 0; bar.st = nullptr;
    const int lo = args.lo, hi = args.hi;
    const bool use_bar = (hi - lo) > 1;
    if (use_bar) bar = xcd_barrier_post(ctl + CW_BAR, MISC + 8);
    int ph = 0;
#define PHASE(...) do { if (ph >= lo && ph < hi) { { unsigned char* w_ = args.ws; asm volatile("" : "+s"(w_)); F.ws = w_; } __VA_ARGS__; if (ph + 1 < hi) xcd_barrier(bar); } ++ph; } while (0)
    const int G = gridDim.x;
#define c ((int)blockIdx.x)
#define PHASE_R(rep, ...) do { _Pragma("nounroll") for (int r_ = 0; r_ < (rep); ++r_) { PHASE(__VA_ARGS__); } } while (0)
    bf16_t* ACT = (bf16_t*)(F.ws + WS_ACT);

    bf16_t* XR = (bf16_t*)(F.ws + WS_XR);
    for (int l = 0; l < DEPTH; ++l) {
        const int kind = l % 3, j = l / 3, s0 = 3 * l;
        PHASE({ if (kind != 2) phase_convert(F, l, l == 0 ? 0 : 32); if (l == 0) phase_first(F); else phase_samplefold(F, s0, NP_DN); });
        for (int which = 0; which < 2; ++which) {
            if (which == 1) {
                if (kind == 0) {
                    PHASE({ phase_poolprep(F, l, s0 + 1, NP_DN); });
                    PHASE({ g8::Sched<1> S; S.T.init(MP / 256, D / 256, G, c); S.nt = 512 / 64; S.KS = KSE_POOL; S.Ksub = KSUB_POOL; S.A = (const char*)F.XB; S.B = (const char*)(F.ws + WS_WMIX + WM_POOL); S.lda = D; S.ldb = 512;
                            g8::EpiResid E{F.ws, nullptr, 1.0f, (s0 + 2) % 3, 1}; g8::gemm_phase<GEMM_ALIGN, GEMM_SP2, XR_POOL != 0>(F.lds, D, 512, S, E); });
                } else if (kind == 1) {
                    PHASE({ phase_samplefold(F, s0 + 1, NP_DN, true); });
                    PHASE({ g8::Sched<0> S; S.T.init(M / 256, QKVD / 256, G, c); S.nt = D / 64; S.KS = 0; S.Ksub = 0; S.A = (const char*)XR; S.B = (const char*)(F.ws + WS_WMIX + WM_QKV); S.lda = D; S.ldb = D;
                            g8::EpiQKV E{F.ws, args.in[I_ABQKV] + (size_t)j * QKVD, (s0 + 1) % 3}; g8::gemm_phase<GEMM_ALIGN, GEMM_SP2>(F.lds, D, D, S, E);
                            if (l + 1 < DEPTH && (l + 1) % 3 == 2) phase_convert(F, l + 1, QKV_FULL); });
                    PHASE({ phase_attn(F, j); });
                    PHASE({ g8::Sched<0> S; S.T.init(MP / 256, D / 256, G, c); S.nt = D / 64; S.KS = KSE_WO; S.Ksub = KSUB_WO; S.A = (const char*)F.XB; S.B = (const char*)(F.ws + WS_WMIX + WM_AO); S.lda = D; S.ldb = D;
                            g8::EpiResid E{F.ws, args.in[I_ABO] + (size_t)j * D, 1.0f, (s0 + 2) % 3, 1}; g8::gemm_phase<GEMM_ALIGN, GEMM_SP2, XR_WO != 0>(F.lds, D, D, S, E); });
                } else {
                    PHASE({ phase_rwkvmix(F, l, s0 + 1, NP_DN); });
                    PHASE({ g8::Sched<2> S; S.T.init(M / 256, 27, G, c); S.nt = D / 64; S.KS = 0; S.Ksub = 0; S.A = (const char*)(F.ws + WS_MIX6); S.B = (const char*)(F.ws + WS_WMIX2 + WM_RW); S.lda = D; S.ldb = D;
                            g8::EpiRwkv1 E{(float*)(F.ws + WS_RKV), (bf16_t*)(F.ws + WS_HL)}; g8::gemm_phase<GEMM_ALIGN, GEMM_SP2>(F.lds, D, D, S, E); });
                    PHASE({ g8::Sched<3> S; S.T.init((XR_LORA ? MP : M) / 256, 24, G, c); S.nt = 256 / 64;
                            S.KS = 0; S.Ksub = 0; S.A = (const char*)(F.ws + WS_HL); S.B = (const char*)(F.ws + WS_WMIX2 + WM_L2); S.lda = 768; S.ldb = 256;
                            g8::EpiLoraUp E{(float*)(F.ws + WS_LUP), args.in[I_W0] + (size_t)j * D, args.in[I_A0] + (size_t)j * D}; g8::gemm_phase<GEMM_ALIGN, GEMM_SP2, XR_LORA != 0>(F.lds, 768, 256, S, E); });
                    PHASE_R(REP_CK1, { phase_ck1(F, j); });
                    PHASE_R(REP_SCAN, { phase_ck2(F, j); phase_scan(F, j); });
                    PHASE({ phase_rwkvpost(F, j); });
                    PHASE({ g8::Sched<0> S; S.T.init(MP / 256, D / 256, G, c); S.nt = D / 64; S.KS = KSE_WO; S.Ksub = KSUB_WO; S.A = (const char*)F.XB; S.B = (const char*)(F.ws + WS_WMIX2 + WM_RO); S.lda = D; S.ldb = D;
                            g8::EpiResid E{F.ws, nullptr, 1.0f, (s0 + 2) % 3, 1}; g8::gemm_phase<GEMM_ALIGN, GEMM_SP2, XR_WO != 0>(F.lds, D, D, S, E); });
                }
                if (!(kind == 0 ? XR_POOL : XR_WO)) PHASE({ phase_samplefold(F, s0 + 2, kind == 0 ? NP_POOL : NP_WO); });
            }
            const int sin = s0 + (which ? 2 : 0);
            PHASE_R(REP_GU, { g8::Sched<0> S; S.T.init(M / 256, 2 * FF / 256, G, c); S.nt = D / 64; S.KS = 0; S.Ksub = 0; S.A = (const char*)XR; S.B = (const char*)(F.ws + WS_WGU + ((l & 1) * 2 + which) * WGU_BYTES); S.lda = D; S.ldb = D;
                    g8::EpiSwiGLU E{F.ws, sin % 3}; g8::gemm_phase<GEMM_ALIGN, GEMM_SP2>(F.lds, D, D, S, E);
                    if (EARLY_GU > 0 && l + which < DEPTH && (int)blockIdx.x >= GU_FULL) { const bool h0 = l == 0 && which == 0;
                        if (h0) early_convert(F, 0, 0, T_HALF0, T_HALF, GU_FULL);
                        early_convert(F, l + which, 1 - which, 0, h0 ? EARLY_GU0 : EARLY_GU, GU_FULL); } });
            PHASE({ g8::Sched<0> S; S.T.init(MP / 256, D / 256, G, c); S.nt = FF / 64; S.KS = KSE_DN; S.Ksub = KSUB_DN; S.A = (const char*)ACT; S.B = (const char*)(F.ws + WS_WD + ((l & 1) * 2 + which) * WD_BYTES); S.lda = FF; S.ldb = FF;
                    g8::EpiResid E{F.ws, nullptr, 0.5f, (sin + 1) % 3, (which == 0 ? kind == 1 : l + 1 < DEPTH) ? 1 : 0}; g8::gemm_phase<GEMM_ALIGN, GEMM_SP2, XR_DN != 0>(F.lds, FF, FF, S, E);
                    if (EARLY_TILES > EARLY_GU && l + which < DEPTH && (int)blockIdx.x >= DN_FULL) early_convert(F, l + which, 1 - which, (l == 0 && which == 0) ? EARLY_GU0 : EARLY_GU, EARLY_TILES, DN_FULL); });
        }
    }
    PHASE({ phase_final(F, 3 * DEPTH, NP_DN); });
#undef PHASE
#undef PHASE_R
#undef c
}

static int count_phases() { int n = 0; for (int l = 0; l < DEPTH; ++l) { const int kind = l % 3; n += 1 + 2 * (REP_GU + 1) + ((kind == 0 ? XR_POOL : XR_WO) ? 0 : 1) + (kind == 0 ? 2 : kind == 1 ? 4 : 5 + REP_SCAN + REP_CK1); } return n + 1; }
extern "C" void kernel_launch(void* const* d_in, const int* in_sizes, int n_in, void* d_out, int out_size, void* d_ws, size_t ws_size, hipStream_t stream) {
    static int ready = 0;
    if (ready == 0) {
        ready = -1;
        if (n_in != 40 || (size_t)out_size != O_END || ws_size < WS_END) { fprintf(stderr, "kernel_launch: unexpected shapes: n_in %d out %d (want %zu) ws %zu (need %zu)\n", n_in, out_size, (size_t)O_END, ws_size, (size_t)WS_END); return; }
        int dev = 0, cus = 0, per_cu = 0;
        if (hipGetDevice(&dev) != hipSuccess || hipDeviceGetAttribute(&cus, hipDeviceAttributeMultiprocessorCount, dev) != hipSuccess) { fprintf(stderr, "kernel_launch: device query failed\n"); return; }
        if (hipFuncSetAttribute((const void*)fwd_kernel, hipFuncAttributeMaxDynamicSharedMemorySize, LDS_BYTES) != hipSuccess) { fprintf(stderr, "kernel_launch: hipFuncSetAttribute failed\n"); return; }
        if (hipOccupancyMaxActiveBlocksPerMultiprocessor(&per_cu, (const void*)fwd_kernel, NTHREADS, LDS_BYTES) != hipSuccess || per_cu < 1) fprintf(stderr, "kernel_launch: occupancy query says %d blocks per CU\n", per_cu);
        (void)hipGetLastError();
        if (cus < GRID) { fprintf(stderr, "kernel_launch: needs %d CUs, device has %d\n", GRID, cus); return; }
        ready = 1;
    }
    if (ready < 0) return;
    (void)hipMemsetAsync((char*)d_ws + WS_CTL, 0, CTL_ZERO_BYTES, stream);
    Args a{};
    for (int i = 0; i < 40; ++i) a.in[i] = (const float*)d_in[i];
    a.out = (float*)d_out; a.ws = (unsigned char*)d_ws;
    const int NPH = count_phases();
#if N_LAUNCH_MODE == 1
    for (int p = 0; p < NPH; ++p) { a.lo = p; a.hi = p + 1; hipLaunchKernelGGL(fwd_kernel, dim3(GRID), dim3(NTHREADS), LDS_BYTES, stream, a); }
#else
    a.lo = 0; a.hi = NPH; hipLaunchKernelGGL(fwd_kernel, dim3(GRID), dim3(NTHREADS), LDS_BYTES, stream, a);
#endif
    const hipError_t le = hipPeekAtLastError();
    if (le != hipSuccess) fprintf(stderr, "kernel_launch: launch failed: %s\n", hipGetErrorName(le));
}
```

```cpp
#include <hip/hip_runtime.h>
#include <cstdio>
#include <cstdint>

#ifndef N_LAUNCH_MODE
#define N_LAUNCH_MODE 0
#endif

#ifndef REP_CONV
#define REP_CONV 1
#endif
#ifndef REP_GU
#define REP_GU 1
#endif
#ifndef REP_DN
#define REP_DN 1
#endif
#ifndef REP_SCAN
#define REP_SCAN 1
#endif
#ifndef REP_CK1
#define REP_CK1 1
#endif
#ifndef REP_OTHER
#define REP_OTHER 1
#endif
#define LAS __attribute__((address_space(3)))
typedef unsigned short bf16_t;
typedef short bf16x8 __attribute__((ext_vector_type(8)));
typedef float f32x4 __attribute__((ext_vector_type(4)));
typedef float f32x2 __attribute__((ext_vector_type(2)));
typedef unsigned u32x4 __attribute__((ext_vector_type(4)));
typedef unsigned u32x2 __attribute__((ext_vector_type(2)));
typedef unsigned long long u64;
constexpr int KS_DN = 11, KSUB_DN = 512, KS_WO = 4, KSUB_WO = 512, KS_POOL = 2, KSUB_POOL = 256;
#ifndef XR_DN
#define XR_DN 0
#endif
#ifndef XR_WO
#define XR_WO 1
#endif
#ifndef XR_POOL
#define XR_POOL 1
#endif
#ifndef XR_LORA
#define XR_LORA 1
#endif
static_assert(XR_DN == 0, "the extra-row epilogue updates x in place (no partial slab): the down projection keeps its split-K sample sub-units, whose idle workgroups convert weights");
constexpr int KSE_DN = XR_DN ? 0 : KS_DN, KSE_WO = XR_WO ? 0 : KS_WO, KSE_POOL = XR_POOL ? 0 : KS_POOL, NP_DN = XR_DN ? 1 : KS_DN, NP_WO = XR_WO ? 1 : KS_WO, NP_POOL = XR_POOL ? 1 : KS_POOL;
constexpr float SS_SCALE = 1048576.0f, SS_INV = 1.0f / 1048576.0f;
__device__ __forceinline__ float ss_rstd(u64 v) { return 1.0f / sqrtf((float)v * (SS_INV / 2048.0f) + 1e-6f); }

constexpr int D = 2048, FF = 5632, MP = 8192, MS = 256, M = MP + MS, SEQ = 4096, NWAVES = 8, NTHREADS = 512, GRID = 256;
constexpr int NHEAD = 32, HD = 64, QKVD = 2560, DEPTH = 4;
constexpr float RMS_EPS = 1e-6f, GN_EPS = 64e-5f;
constexpr size_t O_YP = 0, O_YS = O_YP + (size_t)MP * D, O_POOLP = O_YS + (size_t)MS * D, O_POOLS = O_POOLP + 2 * 2 * 15 * D, O_WKP = O_POOLS + (size_t)2 * 32 * 15 * D,
                 O_WVP = O_WKP + 2 * 128 * 256, O_WKS = O_WVP + 2 * 128 * 256, O_WVS = O_WKS + 32 * 128 * 256, O_SHP = O_WVS + 32 * 128 * 256, O_SHS = O_SHP + 2 * D,
                 O_WKVP = O_SHS + 32 * D, O_WKVS = O_WKVP + (size_t)2 * 32 * 4096, O_END = O_WKVS + (size_t)32 * 32 * 4096;
constexpr size_t MiB = 1u << 20;
constexpr size_t WS_CTL = 0, CTL_ZERO_BYTES = 1 * MiB;
constexpr size_t WS_WGU = 2 * MiB, WGU_BYTES = (size_t)2 * FF * D * 2;
constexpr size_t WS_WD = WS_WGU + 4 * WGU_BYTES, WD_BYTES = (size_t)D * FF * 2;
constexpr size_t WS_WMIX = WS_WD + 4 * WD_BYTES;
constexpr size_t WS_X = WS_WMIX + 40 * MiB, ROWF_BYTES = (size_t)M * D * 4;
constexpr size_t WS_WMIX2 = WS_X;
static_assert(ROWF_BYTES >= 40 * MiB, "second mixer-weight region");
constexpr size_t WS_U = WS_X + ROWF_BYTES;
constexpr size_t WS_XB = WS_U + ROWF_BYTES, ROWB_BYTES = (size_t)M * D * 2;
constexpr size_t WS_BIG = WS_XB + ROWB_BYTES;
constexpr size_t WS_ACT = WS_BIG, WS_QKV = WS_BIG, WS_MIX6 = WS_BIG;
constexpr size_t WS_RKV = WS_MIX6 + 6 * ROWB_BYTES, WS_LUP = WS_RKV + 3 * ROWF_BYTES, WS_Y = WS_LUP + 3 * ROWF_BYTES, WS_HL = WS_Y + ROWF_BYTES,
                 WS_BONUS = WS_HL + (size_t)M * 768 * 2, WS_PART = WS_BONUS + 2 * MiB, WS_CKB = WS_PART + 24 * MiB, WS_XR = WS_CKB + 128 * MiB, WS_SS = WS_XR + ROWB_BYTES, WS_END = WS_SS + 1 * MiB;
static_assert((size_t)3 * M * 8 <= 1 * MiB, "SS buffers");
constexpr size_t WS_CKA = WS_MIX6;
static_assert(6 * ROWB_BYTES >= 128 * MiB, "CKA fits over MIX6");
constexpr size_t WM_POOL = 0;
constexpr size_t WM_QKV = 0, WM_AO = (size_t)QKVD * D * 2;
constexpr size_t WM_RW = 0, WM_L2 = (size_t)6912 * D * 2, WM_RO = WM_L2 + (size_t)6144 * 256 * 2;
static_assert(WM_RO + (size_t)D * D * 2 <= 40 * MiB, "mixer weights fit");
constexpr int RING_BYTES = 131072, LDS_BYTES = 163840, MISC_OFF = LDS_BYTES - 256;

constexpr int CW_BAR = 4096;

typedef __bf16 bf16x2_t __attribute__((ext_vector_type(2)));
__device__ __forceinline__ unsigned cvt_pk_bf16(float lo, float hi) { const f32x2 v = {lo, hi}; return __builtin_bit_cast(unsigned, __builtin_convertvector(v, bf16x2_t)); }
__device__ __forceinline__ float bf2f(unsigned short b) { return __uint_as_float(((unsigned)b) << 16); }
__device__ __forceinline__ f32x4 ld_bf4(const bf16_t* p) { const u32x2 w = *(const u32x2*)p; return (f32x4){__uint_as_float(w.x << 16), __uint_as_float(w.x & 0xffff0000u), __uint_as_float(w.y << 16), __uint_as_float(w.y & 0xffff0000u)}; }
__device__ __forceinline__ float wave_sum(float v) {
#pragma unroll
    for (int o = 1; o < 64; o <<= 1) v += __shfl_xor(v, o);
    return v;
}
__device__ __forceinline__ float dpp_ror(float x, int   n);
template <int N> __device__ __forceinline__ float dpp_ror_t(float x) { return __int_as_float(__builtin_amdgcn_update_dpp(0, __float_as_int(x), 0x120 + N, 0xf, 0xf, false)); }
__device__ __forceinline__ float row16_sum(float x) { x += dpp_ror_t<8>(x); x += dpp_ror_t<4>(x); x += dpp_ror_t<2>(x); x += dpp_ror_t<1>(x); return x; }
__device__ __forceinline__ float row16_max(float x) { x = fmaxf(x, dpp_ror_t<8>(x)); x = fmaxf(x, dpp_ror_t<4>(x)); x = fmaxf(x, dpp_ror_t<2>(x)); x = fmaxf(x, dpp_ror_t<1>(x)); return x; }
__device__ __forceinline__ float wave_sum_fast(float x) { x = row16_sum(x); x += __shfl_xor(x, 16); x += __shfl_xor(x, 32); return x; }
__device__ __forceinline__ float fast_exp(float x) { return __builtin_amdgcn_exp2f(x * 1.4426950408889634f); }
__device__ __forceinline__ float fast_sigmoid(float x) { return __builtin_amdgcn_rcpf(1.0f + fast_exp(-x)); }
__device__ __forceinline__ float fast_tanh(float x) { return 1.0f - 2.0f * __builtin_amdgcn_rcpf(1.0f + fast_exp(2.0f * x)); }

#define XB_TMO      128
#define XB_XCNT(j)  (256  + 64 * (j))
#define XB_XSUB(j)  (1280 + 64 * (j))
#define XB_XGEN(j)  (2304 + 64 * (j))
#define XB_TOP      3328
#define XB_TOPGEN   3392
#define XCD_BAR_WORDS 3456
#define XB_SPIN_CAP (1u << 18)
__device__ __forceinline__ unsigned xb_ld(unsigned* p)              { return __hip_atomic_load(p, __ATOMIC_RELAXED, __HIP_MEMORY_SCOPE_AGENT); }
__device__ __forceinline__ unsigned xb_add(unsigned* p, unsigned v) { return __hip_atomic_fetch_add(p, v, __ATOMIC_RELAXED, __HIP_MEMORY_SCOPE_AGENT); }
__device__ __forceinline__ unsigned xb_xcc_id() { return (unsigned)__builtin_amdgcn_s_getreg((3 << 11) | 20) & 0xFu; }
#define XB_SPIN(cond, bar) do { unsigned _sp = 0; while (cond) { __builtin_amdgcn_s_sleep(1); \
    if ((++_sp & 255u) == 0u) { if (xb_ld(&(bar)[XB_TMO])) break; if (_sp > XB_SPIN_CAP) { atomicAdd(&(bar)[XB_TMO], 1u); break; } } } } while (0)
struct XcdBarrier { unsigned* bar; unsigned x; volatile LAS unsigned* st; };
__device__ __forceinline__ XcdBarrier xcd_barrier_post(unsigned* bar, volatile LAS unsigned* st) {
    XcdBarrier b; b.bar = bar; b.x = xb_xcc_id(); b.st = st;
    if (threadIdx.x == 0) (void)xb_add(&bar[XB_XCNT(b.x)], 1u);
    return b;
}
__device__ __forceinline__ void xcd_barrier_complete(unsigned* bar, unsigned x, unsigned& nloc, unsigned& nx) {
    const unsigned G = gridDim.x * gridDim.y * gridDim.z;
    unsigned sum, cnt, mine, sp = 0u;
    for (;;) {
        sum = 0u; cnt = 0u; mine = 0u;
#pragma unroll
        for (unsigned j = 0; j < 16; ++j) { const unsigned c = xb_ld(&bar[XB_XCNT(j)]); sum += c; cnt += (c > 0u) ? 1u : 0u; mine = (j == x) ? c : mine; }
        if (sum == G) break;
        __builtin_amdgcn_s_sleep(1);
        if ((++sp & 255u) == 0u) { if (xb_ld(&bar[XB_TMO])) break; if (sp > XB_SPIN_CAP) { atomicAdd(&bar[XB_TMO], 1u); break; } }
    }
    nloc = mine > 0u ? mine : 1u; nx = cnt > 0u ? cnt : 1u;
}
__device__ __forceinline__ void xcd_barrier(const XcdBarrier& b) {
    asm volatile("s_waitcnt vmcnt(0)" ::: "memory");
    __syncthreads();
    if (threadIdx.x == 0) {
        unsigned* bar = b.bar; asm volatile("" : "+s"(bar));
        __builtin_amdgcn_s_waitcnt(0);
        unsigned nloc = b.st[0], nx = b.st[1];
        if (nloc == 0u) { xcd_barrier_complete(bar, b.x, nloc, nx); b.st[0] = nloc; b.st[1] = nx; }
        const unsigned old = xb_add(&bar[XB_XSUB(b.x)], 1u);
        const unsigned gen = old / nloc;
        if (old + 1u == (gen + 1u) * nloc) {
            __builtin_amdgcn_fence(__ATOMIC_RELEASE, "agent");
            asm volatile("s_waitcnt vmcnt(0)" ::: "memory");
            const unsigned og = xb_add(&bar[XB_TOP], 1u);
            const unsigned tg = og / nx;
            if (og + 1u == (tg + 1u) * nx) xb_add(&bar[XB_TOPGEN], 1u);
            else XB_SPIN(xb_ld(&bar[XB_TOPGEN]) == tg, bar);
            __builtin_amdgcn_fence(__ATOMIC_ACQUIRE, "agent");
            xb_add(&bar[XB_XGEN(b.x)], 1u);
            asm volatile("s_waitcnt vmcnt(0)" ::: "memory");
        } else {
            XB_SPIN(xb_ld(&bar[XB_XGEN(b.x)]) == gen, bar);
            __builtin_amdgcn_fence(__ATOMIC_ACQUIRE, "agent");
            asm volatile("s_waitcnt vmcnt(0)" ::: "memory");
        }
    }
    __syncthreads();
}

namespace g8 {
constexpr int BM = 256, BK = 64, HALF = 128, HTB = HALF * BK * 2, STAGE_BYTES = 8 * HTB, NXCD = 8, WGM = 8;
__host__ __device__ __forceinline__ int lds_byte(int r, int c) { const int st = (r >> 4) * 2 + (c >> 5), rr = r & 15, cc = c & 31, ob = rr * 64 + cc * 2; return st * 1024 + (ob ^ (((ob >> 9) & 1) << 5)); }
__host__ __device__ __forceinline__ void stage_rc(int b, int& R, int& C) { const int st = b / 1024, sb = b % 1024, swz = sb ^ (((sb >> 9) & 1) << 5); R = (st >> 1) * 16 + swz / 64; C = (st & 1) * 32 + (swz % 64) / 2; }
__host__ __device__ __forceinline__ int perm32(int rho) { const int n = rho >> 4, i = rho & 15; return 8 * (i >> 2) + 4 * n + (i & 3); }

struct Unit { const char* A; const char* B; int pm, pn, nt, part; };
struct Tiler {
    int nM, nN, nwg, G, c;
    __device__ void init(int nM_, int nN_, int G_, int c_) { nM = nM_; nN = nN_; nwg = nM * nN; G = G_; c = c_; }
    __device__ bool tile(int i, int& pm, int& pn) const {
        const long L = (long)i * G + c; if (L >= nwg) return false;
        int wgid = (int)L; { const int q = nwg / NXCD, r = nwg % NXCD, xcd = wgid % NXCD, off = wgid / NXCD; wgid = (xcd < r ? xcd * (q + 1) : r * (q + 1) + (xcd - r) * q) + off; }
        const int nig = WGM * nN, gid = wgid / nig, fm = gid * WGM, gsz = (nM - fm) < WGM ? (nM - fm) : WGM;
        pm = fm + ((wgid % nig) % gsz); pn = (wgid % nig) / gsz; return true;
    }
};
template <int MODE> struct Sched {
    Tiler T; const char* A; const char* B; int lda, ldb, nt;
    int KS, Ksub;
    __device__ __forceinline__ bool next(int i, Unit& u) const {
        int pm, pn;
        u.nt = nt; u.part = -1;
        if (KS > 0) {
            const long L = (long)i * T.G + T.c;
            if (L >= T.nwg) { const int sub = (int)(L - T.nwg); if (sub >= T.nN * KS) return false;
                pn = sub % T.nN; const int ks = sub / T.nN; u.pm = T.nM; u.pn = pn; u.nt = Ksub / BK; u.part = ks;
                size_t ao = (size_t)T.nM * BM * lda * 2 + (size_t)ks * Ksub * 2; if (MODE == 1) ao += (size_t)(pn >> 1) * 512 * 2;
                u.A = A + ao; u.B = B + (size_t)pn * BM * ldb * 2 + (size_t)ks * Ksub * 2; return true; }
        }
        if (!T.tile(i, pm, pn)) return false;
        u.pm = pm; u.pn = pn;
        size_t ao = (size_t)pm * BM * lda * 2;
        if (MODE == 1) ao += (size_t)(pn >> 1) * 512 * 2;
        if (MODE == 2) { const int slot = pn < 24 ? (pn >> 3) : (pn - 24 + 3); ao += (size_t)slot * M * D * 2; }
        if (MODE == 3) ao += (size_t)(pn >> 3) * 256 * 2;
        u.A = A + ao; u.B = B + (size_t)pn * BM * ldb * 2; return true;
    }
};

constexpr int XBASE = 8 * HALF * BK * 2 + 8192, XBUF = 4096;
template <bool ALIGN_EPI, bool SP2, bool XROWS = false, class Epi, class SchedT>
__device__ __forceinline__ void gemm_phase(LAS unsigned char* lds, const int lda, const int ldb, const SchedT& S, const Epi& E) {
    static_assert(SP2 || !XROWS, "extra rows: two-phase schedule only");
    int tid = threadIdx.x; asm volatile("" : "+v"(tid));
    const int wid = __builtin_amdgcn_readfirstlane(tid >> 6), lane = tid & 63, wr = wid >> 2, wc = wid & 3, fr = lane & 15, fq = lane >> 4;
    unsigned voffA, voffB;
    { int R, C; stage_rc(tid * 16, R, C); const int Rb = Epi::PERM ? ((R & ~31) + perm32(R & 31)) : R;
        voffA = (unsigned)(R * lda + C) * 2u; voffB = (unsigned)(Rb * ldb + C) * 2u; }
    const size_t q64voffA = (size_t)64 * lda * 2, q64voffB = (size_t)64 * ldb * 2;
    const size_t kstep = (size_t)(BK * 2);
    const size_t hstepA = (size_t)HALF * lda * 2, hstepB = (size_t)HALF * ldb * 2;
    const unsigned ldsw = (unsigned)wid * 1024u;
    const int aoff = lds_byte(wr * 64 + fr, fq * 8), boff = lds_byte(wc * 32 + fr, fq * 8);
    long xoffu = 0; int ldsx = 0;
    if constexpr (XROWS) { const int sub = wid & 1, kt = (wid >> 1) & 1;
        xoffu = (long)kt * (BK * 2) - (long)(wid >> 1) * 16 * lda * 2; ldsx = XBASE + kt * 2048 + sub * 1024; }
#define PG8_XPTR(u) ((u).A + ((size_t)(MP - (u).pm * BM) + 8 * (u).pm) * lda * 2)
#define PG8_XSTAGE(buf, gbase) do { if constexpr (XROWS) __builtin_amdgcn_global_load_lds((const unsigned*)((const char*)(gbase) + xoffu + voffA), (LAS unsigned*)(lds + ldsx + (buf) * XBUF), 16, 0, 0); } while (0)
#define PG8_LDX(kt, k) do { if constexpr (XROWS) Ax = *(const LAS bf16x8*)(lds + (XBASE + xb * XBUF + (kt) * 2048 + (k) * 1024 - wc * 4096) + boff); } while (0)
#define PG8_XMMA(k) do { if constexpr (XROWS) { __builtin_amdgcn_s_setprio(1); if (wr == 0) { _Pragma("unroll") for (int n = 0; n < 2; ++n) xacc[n] = __builtin_amdgcn_mfma_f32_16x16x32_bf16(B0[n][k], Ax, xacc[n], 0, 0, 0); } \
        else { _Pragma("unroll") for (int n = 0; n < 2; ++n) xacc[n] = __builtin_amdgcn_mfma_f32_16x16x32_bf16(B1[n][k], Ax, xacc[n], 0, 0, 0); } __builtin_amdgcn_s_setprio(0); } } while (0)
#define PG8_SA(b, h) (((b) * 2 + (h)) * HTB)
#define PG8_SB(b, h) ((4 + (b) * 2 + (h)) * HTB)
#define PG8_STAGE(bufoff, gbase, voff) do { \
        __builtin_amdgcn_global_load_lds((const unsigned*)((const char*)(gbase) + (voff)), (LAS unsigned*)(lds + (bufoff) + ldsw), 16, 0, 0); \
        __builtin_amdgcn_global_load_lds((const unsigned*)((const char*)(gbase) + q64##voff + (voff)), (LAS unsigned*)(lds + (bufoff) + ldsw + 8192), 16, 0, 0); } while (0)
#define PG8_LDA(dst, b, h) do { _Pragma("unroll") for (int m = 0; m < 4; ++m) _Pragma("unroll") for (int k = 0; k < 2; ++k) dst[m][k] = *(const LAS bf16x8*)(lds + PG8_SA(b, h) + aoff + m * 2048 + k * 1024); } while (0)
#define PG8_LDB(dst, b, h) do { _Pragma("unroll") for (int n = 0; n < 2; ++n) _Pragma("unroll") for (int k = 0; k < 2; ++k) dst[n][k] = *(const LAS bf16x8*)(lds + PG8_SB(b, h) + boff + n * 2048 + k * 1024); } while (0)
#define PG8_MMA(ai, bj, At, Bt) do { __builtin_amdgcn_s_setprio(1); _Pragma("unroll") for (int m = 0; m < 4; ++m) _Pragma("unroll") for (int n = 0; n < 2; ++n) _Pragma("unroll") for (int k = 0; k < 2; ++k) \
        acc[ai][bj][m][n] = __builtin_amdgcn_mfma_f32_16x16x32_bf16(Bt[n][k], At[m][k], acc[ai][bj][m][n], 0, 0, 0); __builtin_amdgcn_s_setprio(0); } while (0)
#define PG8_WAIT_V(n) asm volatile("s_waitcnt vmcnt(" #n ")" ::: "memory")
#define PG8_WAIT_L(n) asm volatile("s_waitcnt lgkmcnt(" #n ")" ::: "memory")
#define PG8_BAR __builtin_amdgcn_s_barrier()
#define PG8_SCHED __builtin_amdgcn_sched_barrier(0)
    Unit cur, nxt; int ui = 0;
    E.prefetch(S, lds, tid);
    if (!S.next(0, cur)) return;
    f32x4 acc[2][2][4][2];
#pragma unroll
    for (int a = 0; a < 2; ++a)
#pragma unroll
        for (int b = 0; b < 2; ++b)
#pragma unroll
            for (int m = 0; m < 4; ++m)
#pragma unroll
                for (int n = 0; n < 2; ++n) acc[a][b][m][n] = (f32x4){0.f, 0.f, 0.f, 0.f};
    bf16x8 At[4][2], B0[2][2], B1[2][2];
    bf16x8 Ax; f32x4 xacc[2]; int xb = 0;
    if constexpr (XROWS) { xacc[0] = (f32x4){0.f, 0.f, 0.f, 0.f}; xacc[1] = (f32x4){0.f, 0.f, 0.f, 0.f}; }
    const char* cA = cur.A; const char* cB = cur.B;
    const char* cX = PG8_XPTR(cur);
    if constexpr (SP2) {
        PG8_XSTAGE(0, cX);
        PG8_STAGE(PG8_SB(0, 0), cB, voffB); PG8_STAGE(PG8_SB(0, 1), cB + hstepB, voffB); PG8_STAGE(PG8_SA(0, 0), cA, voffA); PG8_STAGE(PG8_SA(0, 1), cA + hstepA, voffA);
        if (wr == 1) PG8_BAR;
        PG8_WAIT_V(2); PG8_BAR;
        PG8_STAGE(PG8_SB(1, 0), cB + kstep, voffB); PG8_STAGE(PG8_SA(1, 0), cA + kstep, voffA); PG8_STAGE(PG8_SB(1, 1), cB + hstepB + kstep, voffB);
        PG8_WAIT_V(6); PG8_BAR;
    } else {
        PG8_STAGE(PG8_SB(0, 0), cB, voffB); PG8_STAGE(PG8_SA(0, 0), cA, voffA); PG8_STAGE(PG8_SB(0, 1), cB + hstepB, voffB); PG8_STAGE(PG8_SA(0, 1), cA + hstepA, voffA);
        if (wr == 1) PG8_BAR;
        PG8_WAIT_V(4); PG8_BAR;
        PG8_STAGE(PG8_SB(1, 0), cB + kstep, voffB); PG8_STAGE(PG8_SA(1, 0), cA + kstep, voffA); PG8_STAGE(PG8_SB(1, 1), cB + hstepB + kstep, voffB);
        PG8_WAIT_V(6); PG8_BAR;
    }
    for (;;) {
        const bool has_next = S.next(ui + 1, nxt);
        const char* nA = has_next ? nxt.A : cA; const char* nB = has_next ? nxt.B : cB;
        const char* nX = has_next ? PG8_XPTR(nxt) : cX;
        const int nt = cur.nt;
#pragma nounroll
        for (int t = 0; t < nt; t += 2) {
            const bool last = (t == nt - 2);
            const char* a1 = cA + (size_t)(t + 1) * kstep;
            const char* a2 = last ? nA : cA + (size_t)(t + 2) * kstep; const char* b2 = last ? nB : cB + (size_t)(t + 2) * kstep;
            const char* a3 = a2 + kstep; const char* b3 = b2 + kstep;
            if constexpr (SP2) {
            const char* x2 = last ? nX : cX + (size_t)(t + 2) * kstep;
            PG8_LDB(B0, 0, 0); PG8_LDB(B1, 0, 1); PG8_LDX(0, 0); PG8_SCHED; PG8_LDA(At, 0, 0); PG8_STAGE(PG8_SA(1, 1), a1 + hstepA, voffA); PG8_XSTAGE(xb ^ 1, x2);
            if constexpr (XROWS) PG8_WAIT_V(9); else PG8_WAIT_V(8);
            PG8_WAIT_L(0); PG8_BAR; PG8_MMA(0, 0, At, B0); PG8_MMA(0, 1, At, B1); PG8_XMMA(0); PG8_BAR; PG8_SCHED;
            PG8_LDA(At, 0, 1); PG8_LDX(0, 1); PG8_STAGE(PG8_SB(0, 0), b2, voffB); PG8_STAGE(PG8_SB(0, 1), b2 + hstepB, voffB); PG8_STAGE(PG8_SA(0, 0), a2, voffA);
            if constexpr (XROWS) PG8_WAIT_V(9); else PG8_WAIT_V(8);
            PG8_WAIT_L(0); PG8_BAR; PG8_MMA(1, 0, At, B0); PG8_MMA(1, 1, At, B1); PG8_XMMA(1); PG8_BAR; PG8_SCHED;
            PG8_LDB(B0, 1, 0); PG8_LDB(B1, 1, 1); PG8_LDX(1, 0); PG8_SCHED; PG8_LDA(At, 1, 0); PG8_STAGE(PG8_SA(0, 1), a2 + hstepA, voffA);
            PG8_WAIT_V(8); PG8_WAIT_L(0); PG8_BAR; PG8_MMA(0, 0, At, B0); PG8_MMA(0, 1, At, B1); PG8_XMMA(0); PG8_BAR; PG8_SCHED;
            PG8_LDA(At, 1, 1); PG8_LDX(1, 1); PG8_STAGE(PG8_SB(1, 0), b3, voffB); PG8_STAGE(PG8_SB(1, 1), b3 + hstepB, voffB); PG8_STAGE(PG8_SA(1, 0), a3, voffA);
            PG8_WAIT_V(8); PG8_WAIT_L(0); PG8_BAR; PG8_MMA(1, 0, At, B0); PG8_MMA(1, 1, At, B1); PG8_XMMA(1); PG8_BAR; PG8_SCHED;
            xb ^= 1;
            } else {
            PG8_LDB(B0, 0, 0); PG8_SCHED; PG8_LDA(At, 0, 0); PG8_STAGE(PG8_SA(1, 1), a1 + hstepA, voffA);
            PG8_WAIT_L(8); PG8_BAR; PG8_WAIT_L(0); PG8_MMA(0, 0, At, B0); PG8_BAR; PG8_SCHED;
            PG8_LDB(B1, 0, 1); PG8_STAGE(PG8_SB(0, 0), b2, voffB);
            PG8_BAR; PG8_WAIT_L(0); PG8_MMA(0, 1, At, B1); PG8_BAR;
            PG8_LDA(At, 0, 1); PG8_STAGE(PG8_SA(0, 0), a2, voffA);
            PG8_BAR; PG8_WAIT_L(0); PG8_MMA(1, 0, At, B0); PG8_BAR; PG8_SCHED;
            PG8_STAGE(PG8_SB(0, 1), b2 + hstepB, voffB);
            PG8_WAIT_V(6); PG8_BAR; PG8_MMA(1, 1, At, B1); PG8_BAR;
            PG8_LDB(B0, 1, 0); PG8_SCHED; PG8_LDA(At, 1, 0); PG8_STAGE(PG8_SA(0, 1), a2 + hstepA, voffA);
            PG8_WAIT_L(8); PG8_BAR; PG8_WAIT_L(0); PG8_MMA(0, 0, At, B0); PG8_BAR; PG8_SCHED;
            PG8_LDB(B1, 1, 1); PG8_STAGE(PG8_SB(1, 0), b3, voffB);
            PG8_BAR; PG8_WAIT_L(0); PG8_MMA(0, 1, At, B1); PG8_BAR;
            PG8_LDA(At, 1, 1); PG8_STAGE(PG8_SA(1, 0), a3, voffA);
            PG8_BAR; PG8_WAIT_L(0); PG8_MMA(1, 0, At, B0); PG8_BAR; PG8_SCHED;
            PG8_STAGE(PG8_SB(1, 1), b3 + hstepB, voffB);
            PG8_WAIT_V(6); PG8_BAR; PG8_MMA(1, 1, At, B1); PG8_BAR;
                    }
        }
        if constexpr (ALIGN_EPI) { if (wr == 0) PG8_BAR; }
        E(acc, cur, wr, wc, fr, fq, ui, lds);
        if constexpr (XROWS) { E.xrows(xacc, cur, wr, wc, fr, fq, ui, lds); xacc[0] = (f32x4){0.f, 0.f, 0.f, 0.f}; xacc[1] = (f32x4){0.f, 0.f, 0.f, 0.f}; }
        if (!has_next) break;
#pragma unroll
        for (int a = 0; a < 2; ++a)
#pragma unroll
            for (int b = 0; b < 2; ++b)
#pragma unroll
                for (int m = 0; m < 4; ++m)
#pragma unroll
                    for (int n = 0; n < 2; ++n) acc[a][b][m][n] = (f32x4){0.f, 0.f, 0.f, 0.f};
        cur = nxt; cA = nA; cB = nB; cX = nX; ++ui;
        if constexpr (ALIGN_EPI) { if (wr == 1) PG8_BAR; }
    }
    PG8_WAIT_V(0);
    if constexpr (!ALIGN_EPI) { if (wr == 0) PG8_BAR; }
    PG8_BAR;
#undef PG8_XPTR
#undef PG8_XSTAGE
#undef PG8_LDX
#undef PG8_XMMA
#undef PG8_SA
#undef PG8_SB
#undef PG8_STAGE
#undef PG8_LDA
#undef PG8_LDB
#undef PG8_MMA
#undef PG8_WAIT_V
#undef PG8_WAIT_L
#undef PG8_BAR
#undef PG8_SCHED
}

struct EpiSwiGLU {
    static constexpr bool PERM = true;
    template <class SchedT> __device__ __forceinline__ void prefetch(const SchedT& S, LAS unsigned char* lds, int tid) const {
        const u64* SS = (const u64*)(ws + WS_SS) + (size_t)ssidx * M; LAS float* RS = (LAS float*)(lds + STAGE_BYTES);
        for (int q = tid; q < 8 * 256; q += NTHREADS) { Unit u; if (S.next(q >> 8, u)) RS[q] = ss_rstd(SS[u.pm * BM + (q & 255)]); }
        asm volatile("s_waitcnt vmcnt(0) lgkmcnt(0)" ::: "memory");
    }
    unsigned char* ws; int ssidx;
    __device__ __forceinline__ void operator()(const f32x4 (&acc)[2][2][4][2], const Unit& u, int wr, int wc, int fr, int fq, int ui, LAS unsigned char* lds) const {
        bf16_t* O = (bf16_t*)(ws + WS_ACT);
        const int row0 = u.pm * BM + wr * 64 + fr, col0 = u.pn * 128 + wc * 32 + 8 * fq;
#pragma unroll
        for (int ai = 0; ai < 2; ++ai)
#pragma unroll
            for (int m = 0; m < 4; ++m) { bf16_t* rowp = O + (size_t)(row0 + ai * HALF + m * 16) * FF + col0;
                const float rs = ((const LAS float*)(lds + STAGE_BYTES))[ui * 256 + wr * 64 + fr + ai * HALF + m * 16];
                float h[8];
#pragma unroll
                for (int n = 0; n < 2; ++n)
#pragma unroll
                    for (int j = 0; j < 4; ++j) { const float g = acc[ai][0][m][n][j] * rs, up = acc[ai][1][m][n][j] * rs; h[n * 4 + j] = g * fast_sigmoid(g) * up; }
                u32x4 w; w.x = cvt_pk_bf16(h[0], h[1]); w.y = cvt_pk_bf16(h[2], h[3]); w.z = cvt_pk_bf16(h[4], h[5]); w.w = cvt_pk_bf16(h[6], h[7]);
                *(u32x4*)rowp = w; }
    }
};
struct EpiResid {
    static constexpr bool PERM = false;
    template <class SchedT> __device__ __forceinline__ void prefetch(const SchedT& S, LAS unsigned char* lds, int tid) const {
        if (bias) { LAS float* BS = (LAS float*)(lds + STAGE_BYTES);
            for (int q = tid; q < 8 * 256; q += NTHREADS) { Unit u; if (S.next(q >> 8, u)) BS[q] = u.part <= 0 ? bias[u.pn * BM + (q & 255)] : 0.f; }
            asm volatile("s_waitcnt vmcnt(0) lgkmcnt(0)" ::: "memory"); }
    }
    __device__ __forceinline__ void xrows(const f32x4 (&xacc)[2], const Unit& u, int wr, int wc, int fr, int fq, int ui, LAS unsigned char* lds) const {
        bf16_t* XR = (bf16_t*)(ws + WS_XR); u64* SS = (u64*)(ws + WS_SS) + (size_t)ssidx * M;
        const int row = MP + 8 * u.pm + (fr & 7);
        float ssq = 0.f;
        if (fr < 8) { bf16_t* p = XR + (size_t)row * D + u.pn * BM + wr * HALF + wc * 32 + 4 * fq;
            u32x2 o[2];
#pragma unroll
            for (int n = 0; n < 2; ++n) o[n] = *(const u32x2*)(p + n * 16);
#pragma unroll
            for (int n = 0; n < 2; ++n) { const f32x4 bv = bias ? *(const LAS f32x4*)((const LAS float*)(lds + STAGE_BYTES) + ui * 256 + wr * HALF + wc * 32 + n * 16 + 4 * fq) : (f32x4){0.f, 0.f, 0.f, 0.f};
                const f32x4 xold = (f32x4){__uint_as_float(o[n].x << 16), __uint_as_float(o[n].x & 0xffff0000u), __uint_as_float(o[n].y << 16), __uint_as_float(o[n].y & 0xffff0000u)};
                const f32x4 xn = xold + xacc[n] * alpha + bv;
                u32x2 w; w.x = cvt_pk_bf16(xn.x, xn.y); w.y = cvt_pk_bf16(xn.z, xn.w); *(u32x2*)(p + n * 16) = w;
                const f32x4 xr = (f32x4){__uint_as_float(w.x << 16), __uint_as_float(w.x & 0xffff0000u), __uint_as_float(w.y << 16), __uint_as_float(w.y & 0xffff0000u)};
                ssq += (xr.x * xr.x + xr.y * xr.y) + (xr.z * xr.z + xr.w * xr.w); } }
        ssq += __shfl_xor(ssq, 16); ssq += __shfl_xor(ssq, 32);
        if (fq == 0 && fr < 8) atomicAdd(SS + row, (u64)(ssq * SS_SCALE));
        asm volatile("" ::: "memory");
    }
    unsigned char* ws; const float* bias; float alpha; int ssidx; int wxr;
    __device__ __forceinline__ void operator()(const f32x4 (&acc)[2][2][4][2], const Unit& u, int wr, int wc, int fr, int fq, int ui, LAS unsigned char* lds) const {
        float* PART = (float*)(ws + WS_PART); bf16_t* XR = (bf16_t*)(ws + WS_XR); u64* SS = (u64*)(ws + WS_SS) + (size_t)ssidx * M;
        const int row0 = u.pm * BM + wr * 64 + fr, col0 = u.pn * BM + wc * 32 + 4 * fq;
        f32x4 bv[2][2];
#pragma unroll
        for (int bj = 0; bj < 2; ++bj)
#pragma unroll
            for (int n = 0; n < 2; ++n) bv[bj][n] = bias ? *(const LAS f32x4*)((const LAS float*)(lds + STAGE_BYTES) + ui * 256 + wc * 32 + 4 * fq + bj * HALF + n * 16) : (f32x4){0.f, 0.f, 0.f, 0.f};
        if (u.part >= 0) {
            float* base = PART + ((size_t)u.part * 256 + wr * 64 + fr) * D + col0;
#pragma unroll
            for (int ai = 0; ai < 2; ++ai)
#pragma unroll
                for (int m = 0; m < 4; ++m) { float* rowp = base + (size_t)(ai * HALF + m * 16) * D;
#pragma unroll
                    for (int bj = 0; bj < 2; ++bj)
#pragma unroll
                        for (int n = 0; n < 2; ++n) *(f32x4*)(rowp + bj * HALF + n * 16) = acc[ai][bj][m][n] * alpha + bv[bj][n]; }
            return;
        }
#pragma unroll
        for (int ai = 0; ai < 2; ++ai) {
            u32x2 xo[4][2][2];
#pragma unroll
            for (int m = 0; m < 4; ++m)
#pragma unroll
                for (int bj = 0; bj < 2; ++bj)
#pragma unroll
                    for (int n = 0; n < 2; ++n) xo[m][bj][n] = *(const u32x2*)(XR + (size_t)(row0 + ai * HALF + m * 16) * D + col0 + bj * HALF + n * 16);
#pragma unroll
            for (int m = 0; m < 4; ++m) { const size_t ro = (size_t)(row0 + ai * HALF + m * 16) * D + col0; float ssq = 0.f;
#pragma unroll
                for (int bj = 0; bj < 2; ++bj)
#pragma unroll
                    for (int n = 0; n < 2; ++n) { const u32x2 o = xo[m][bj][n];
                        const f32x4 xold = (f32x4){__uint_as_float(o.x << 16), __uint_as_float(o.x & 0xffff0000u), __uint_as_float(o.y << 16), __uint_as_float(o.y & 0xffff0000u)};
                        const f32x4 xn = xold + acc[ai][bj][m][n] * alpha + bv[bj][n];
                        u32x2 w; w.x = cvt_pk_bf16(xn.x, xn.y); w.y = cvt_pk_bf16(xn.z, xn.w); *(u32x2*)(XR + ro + bj * HALF + n * 16) = w;
                        const f32x4 xr = (f32x4){__uint_as_float(w.x << 16), __uint_as_float(w.x & 0xffff0000u), __uint_as_float(w.y << 16), __uint_as_float(w.y & 0xffff0000u)};
                        ssq += (xr.x * xr.x + xr.y * xr.y) + (xr.z * xr.z + xr.w * xr.w); }
                ssq += __shfl_xor(ssq, 16); ssq += __shfl_xor(ssq, 32);
                if (fq == 0) atomicAdd(SS + row0 + ai * HALF + m * 16, (u64)(ssq * SS_SCALE)); }
            asm volatile("" ::: "memory"); }
    }
};
struct EpiQKV {
    static constexpr bool PERM = true;
    template <class SchedT> __device__ __forceinline__ void prefetch(const SchedT& S, LAS unsigned char* lds, int tid) const {
        const u64* SS = (const u64*)(ws + WS_SS) + (size_t)ssidx * M; LAS float* RS = (LAS float*)(lds + STAGE_BYTES);
        for (int q = tid; q < 8 * 256; q += NTHREADS) { Unit u; if (S.next(q >> 8, u)) RS[q] = ss_rstd(SS[u.pm * BM + (q & 255)]); }
        asm volatile("s_waitcnt vmcnt(0) lgkmcnt(0)" ::: "memory");
    }
    unsigned char* ws; const float* bias; int ssidx;
    __device__ __forceinline__ void operator()(const f32x4 (&acc)[2][2][4][2], const Unit& u, int wr, int wc, int fr, int fq, int ui, LAS unsigned char* lds) const {
        bf16_t* O = (bf16_t*)(ws + WS_QKV);
        const int row0 = u.pm * BM + wr * 64 + fr, col0 = u.pn * BM + wc * 32 + 8 * fq;
        f32x4 bv[2][2];
#pragma unroll
        for (int bj = 0; bj < 2; ++bj)
#pragma unroll
            for (int n = 0; n < 2; ++n) bv[bj][n] = *(const f32x4*)(bias + col0 + bj * HALF + 4 * n);
#pragma unroll
        for (int ai = 0; ai < 2; ++ai)
#pragma unroll
            for (int m = 0; m < 4; ++m) { bf16_t* rowp = O + (size_t)(row0 + ai * HALF + m * 16) * QKVD + col0;
                const float rs = ((const LAS float*)(lds + STAGE_BYTES))[ui * 256 + wr * 64 + fr + ai * HALF + m * 16];
#pragma unroll
                for (int bj = 0; bj < 2; ++bj) { const f32x4 v0 = acc[ai][bj][m][0] * rs + bv[bj][0], v1 = acc[ai][bj][m][1] * rs + bv[bj][1];
                    u32x4 w; w.x = cvt_pk_bf16(v0[0], v0[1]); w.y = cvt_pk_bf16(v0[2], v0[3]); w.z = cvt_pk_bf16(v1[0], v1[1]); w.w = cvt_pk_bf16(v1[2], v1[3]);
                    *(u32x4*)(rowp + bj * HALF) = w; } }
    }
};
struct EpiRwkv1 {
    static constexpr bool PERM = false;
    template <class SchedT> __device__ __forceinline__ void prefetch(const SchedT&, LAS unsigned char*, int) const {}
    float* RKV; bf16_t* HL;
    __device__ __forceinline__ void operator()(const f32x4 (&acc)[2][2][4][2], const Unit& u, int wr, int wc, int fr, int fq, int ui, LAS unsigned char* lds) const {
        const int row0 = u.pm * BM + wr * 64 + fr, cin = wc * 32 + 4 * fq;
        if (u.pn < 24) {
            bf16_t* base = (bf16_t*)RKV + (size_t)(u.pn >> 3) * M * D + (u.pn & 7) * BM + cin;
#pragma unroll
            for (int ai = 0; ai < 2; ++ai)
#pragma unroll
                for (int m = 0; m < 4; ++m) { bf16_t* rowp = base + (size_t)(row0 + ai * HALF + m * 16) * D;
#pragma unroll
                    for (int bj = 0; bj < 2; ++bj)
#pragma unroll
                        for (int n = 0; n < 2; ++n) { const f32x4 v = acc[ai][bj][m][n]; u32x2 w; w.x = cvt_pk_bf16(v[0], v[1]); w.y = cvt_pk_bf16(v[2], v[3]); *(u32x2*)(rowp + bj * HALF + n * 16) = w; } }
        } else {
            const int which = u.pn - 24;
            bf16_t* base = HL + which * 256 + cin;
#pragma unroll
            for (int ai = 0; ai < 2; ++ai)
#pragma unroll
                for (int m = 0; m < 4; ++m) { bf16_t* rowp = base + (size_t)(row0 + ai * HALF + m * 16) * 768;
#pragma unroll
                    for (int bj = 0; bj < 2; ++bj)
#pragma unroll
                        for (int n = 0; n < 2; ++n) { f32x4 v = acc[ai][bj][m][n];
                            if (which == 0) {
#pragma unroll
                                for (int j = 0; j < 4; ++j) v[j] = fast_tanh(v[j]);
                            } else if (which == 2) {
#pragma unroll
                                for (int j = 0; j < 4; ++j) v[j] = fast_sigmoid(v[j]);
                            }
                            u32x2 w; w.x = cvt_pk_bf16(v[0], v[1]); w.y = cvt_pk_bf16(v[2], v[3]);
                            *(u32x2*)(rowp + bj * HALF + n * 16) = w; }
                    asm volatile("" ::: "memory"); }
        }
    }
};
struct EpiLoraUp {
    static constexpr bool PERM = false;
    template <class SchedT> __device__ __forceinline__ void prefetch(const SchedT&, LAS unsigned char*, int) const {}
    float* LUP; const float* w0; const float* a0;
    __device__ __forceinline__ void xrows(const f32x4 (&xacc)[2], const Unit& u, int wr, int wc, int fr, int fq, int ui, LAS unsigned char* lds) const {
        const int which = u.pn >> 3, row = MP + 8 * u.pm + (fr & 7), col0 = (u.pn & 7) * BM + wr * HALF + wc * 32 + 4 * fq;
        const float* addp = which == 0 ? w0 : a0;
        if (fr < 8) {
#pragma unroll
            for (int n = 0; n < 2; ++n) { f32x4 v = xacc[n]; if (which < 2) v += *(const f32x4*)(addp + col0 + n * 16);
                if (which < 2) {
#pragma unroll
                    for (int j = 0; j < 4; ++j) v[j] = fast_sigmoid(v[j]);
                    if (which == 0) {
#pragma unroll
                        for (int j = 0; j < 4; ++j) v[j] = fast_exp(-0.6065306597126334f * v[j]);
                    }
                    *(f32x4*)(LUP + (size_t)which * M * D + (size_t)row * D + col0 + n * 16) = v;
                } else { u32x2 w; w.x = cvt_pk_bf16(v[0], v[1]); w.y = cvt_pk_bf16(v[2], v[3]);
                    *(u32x2*)((bf16_t*)(LUP + (size_t)2 * M * D) + (size_t)row * D + col0 + n * 16) = w; } } }
        asm volatile("" ::: "memory");
    }
    __device__ __forceinline__ void operator()(const f32x4 (&acc)[2][2][4][2], const Unit& u, int wr, int wc, int fr, int fq, int ui, LAS unsigned char* lds) const {
        const int which = u.pn >> 3, row0 = u.pm * BM + wr * 64 + fr, col0 = (u.pn & 7) * BM + wc * 32 + 4 * fq;
        const float* addp = which == 0 ? w0 : a0;
        f32x4 bv[2][2];
#pragma unroll
        for (int bj = 0; bj < 2; ++bj)
#pragma unroll
            for (int n = 0; n < 2; ++n) bv[bj][n] = which < 2 ? *(const f32x4*)(addp + col0 + bj * HALF + n * 16) : (f32x4){0.f, 0.f, 0.f, 0.f};
        float* base = LUP + (size_t)which * M * D + col0;
#pragma unroll
        for (int ai = 0; ai < 2; ++ai)
#pragma unroll
            for (int m = 0; m < 4; ++m) { float* rowp = base + (size_t)(row0 + ai * HALF + m * 16) * D;
#pragma unroll
                for (int bj = 0; bj < 2; ++bj)
#pragma unroll
                    for (int n = 0; n < 2; ++n) { f32x4 v = acc[ai][bj][m][n] + bv[bj][n];
                        if (which < 2) {
#pragma unroll
                            for (int j = 0; j < 4; ++j) v[j] = fast_sigmoid(v[j]);
                            if (which == 0) {
#pragma unroll
                                for (int j = 0; j < 4; ++j) v[j] = fast_exp(-0.6065306597126334f * v[j]);
                            }
                            *(f32x4*)(rowp + bj * HALF + n * 16) = v;
                        } else {
                            u32x2 w; w.x = cvt_pk_bf16(v[0], v[1]); w.y = cvt_pk_bf16(v[2], v[3]);
                            *(u32x2*)((bf16_t*)(LUP + (size_t)2 * M * D) + (size_t)(row0 + ai * HALF + m * 16) * D + col0 + bj * HALF + n * 16) = w; } }
                asm volatile("" ::: "memory"); }
    }
};
}

struct Args { const float* in[40]; float* out; unsigned char* ws; int lo, hi; };
enum { I_XP = 0, I_XS, I_SPOOL, I_CK, I_CV, I_SSHIFT, I_SWKV, I_NF1, I_NMIX, I_NF2, I_NFIN, I_WG, I_WU, I_WDN, I_PW, I_PSC, I_AQKV, I_ABQKV, I_AWO, I_ABO, I_SINK, I_RELB,
       I_MU, I_RWR, I_RWK, I_RWV, I_RWO, I_W0, I_W1, I_W2, I_A0, I_A1, I_A2, I_G1, I_G2, I_KK, I_KA, I_RK, I_LNW, I_LNB };

struct Frame {
    LAS unsigned char* lds; const Args* a; unsigned char* ws; float* out;
    float* X; float* U; bf16_t* XB;
};

struct ConvT { f32x4 v[8]; const float* nscale; const float* kscale; bf16_t* dst; int dld, k0, n, Ns; };
__device__ __forceinline__ void conv_tile_load(ConvT& c, const float* __restrict__ src, int Ks, int Ns, int k0, int n0, bf16_t* __restrict__ dst, int dld, const float* __restrict__ nscale, int lane, const float* __restrict__ kscale) {
    const int kg = lane >> 3, ng = lane & 7, n = n0 + 4 * ng;
#pragma unroll
    for (int i = 0; i < 8; ++i) { const int k = k0 + 8 * kg + i; c.v[i] = (k < Ks && n < Ns) ? __builtin_nontemporal_load((const f32x4*)(src + (size_t)k * Ns + n)) : (f32x4){0.f, 0.f, 0.f, 0.f}; }
    c.nscale = nscale; c.kscale = kscale; c.dst = dst; c.dld = dld; c.k0 = k0; c.n = n; c.Ns = Ns;
}
__device__ __forceinline__ void conv_tile_finish(ConvT& c, int lane) {
    const int kg = lane >> 3, ng = lane & 7;
    if (c.kscale) {
        const f32x4 g0 = *(const f32x4*)(c.kscale + c.k0 + 8 * kg), g1 = *(const f32x4*)(c.kscale + c.k0 + 8 * kg + 4);
        c.v[0] *= g0.x; c.v[1] *= g0.y; c.v[2] *= g0.z; c.v[3] *= g0.w; c.v[4] *= g1.x; c.v[5] *= g1.y; c.v[6] *= g1.z; c.v[7] *= g1.w; }
    f32x4 sc = (f32x4){1.f, 1.f, 1.f, 1.f};
    if (c.nscale && c.n < c.Ns) sc = *(const f32x4*)(c.nscale + c.n);
#pragma unroll
    for (int s = 0; s < 4; ++s) { const float q = sc[s];
        u32x4 o; o.x = cvt_pk_bf16(c.v[0][s] * q, c.v[1][s] * q); o.y = cvt_pk_bf16(c.v[2][s] * q, c.v[3][s] * q); o.z = cvt_pk_bf16(c.v[4][s] * q, c.v[5][s] * q); o.w = cvt_pk_bf16(c.v[6][s] * q, c.v[7][s] * q);
        __builtin_nontemporal_store(o, (u32x4*)(c.dst + (size_t)(4 * ng + s) * c.dld + 8 * kg)); }
}
__device__ __forceinline__ void conv_tile(const float* __restrict__ src, int Ks, int Ns, int k0, int n0, bf16_t* __restrict__ dst, int dld, const float* __restrict__ nscale, int lane, const float* __restrict__ kscale = nullptr) {
    ConvT c; conv_tile_load(c, src, Ks, Ns, k0, n0, dst, dld, nscale, lane, kscale); conv_tile_finish(c, lane);
}
__device__ __forceinline__ void conv_plain(const float* src, int Ks, int Ns, int KT, int NT, bf16_t* dst, int dld, int it, int lane, const float* nscale = nullptr, const float* kscale = nullptr) {
    const int kb = it / NT, nb = it % NT;
    conv_tile(src, Ks, Ns, kb * 64, nb * 32, dst + (size_t)(nb * 32) * dld + kb * 64, dld, nscale, lane, kscale);
}
__device__ __forceinline__ void conv_gateup(const float* src, int half, bf16_t* dst, int it, int lane, const float* gain) {
    constexpr int NT = FF / 32; const int kb = it / NT, nb = it % NT, n0 = nb * 32;
    conv_tile(src, D, FF, kb * 64, n0, dst + (size_t)((n0 >> 7) * 256 + half * 128 + (n0 & 127)) * D + kb * 64, D, nullptr, lane, gain);
}

#ifndef EARLY_PCT
#define EARLY_PCT (XR_DN ? 100 : 50)
#endif
#ifndef EARLY2_PCT
#define EARLY2_PCT 100
#endif
constexpr int T_HALF = 3 * (D / 64) * (FF / 32), EARLY_GU = (int)((long long)T_HALF * EARLY_PCT / 100), EARLY_TILES = (int)((long long)T_HALF * EARLY2_PCT / 100);
constexpr int T_HALF0 = 2 * (D / 64) * (FF / 32), EARLY_GU0 = EARLY_GU - (T_HALF - T_HALF0) * 3 / 4;
static_assert(EARLY_GU0 > 0, "first-layer split");
static_assert(EARLY_GU <= EARLY_TILES && EARLY_TILES == T_HALF, "early conversion split: everything not done in the gate/up tail is done in the down tail");
constexpr int QKV_FULL = (M / 256) * (QKVD / 256) % GRID;
constexpr int DN_FULL = 8 * KS_DN;
constexpr int GU_UNITS = (M / 256) * (2 * FF / 256), GU_FULL = GU_UNITS % GRID;
static_assert(GU_FULL > 0, "idle workgroups in the last gate/up round");
__device__ __forceinline__ void conv_ffn_tile(const Frame& F, int l, int which, int r, int LANE) {
    const Args& a = *F.a;
    constexpr int T_GU = (D / 64) * (FF / 32);
    const size_t wo = (size_t)(l * 2 + which) * D * FF; const int wb = (l & 1) * 2 + which;
    bf16_t* wgu = (bf16_t*)(F.ws + WS_WGU + wb * WGU_BYTES); bf16_t* wd = (bf16_t*)(F.ws + WS_WD + wb * WD_BYTES);
    const float* gain = a.in[which == 0 ? I_NF1 : I_NF2] + (size_t)l * D;
    if (r < T_GU) { conv_gateup(a.in[I_WG] + wo, 0, wgu, r, LANE, gain); return; } r -= T_GU;
    if (r < T_GU) { conv_gateup(a.in[I_WU] + wo, 1, wgu, r, LANE, gain); return; } r -= T_GU;
    conv_plain(a.in[I_WDN] + wo, FF, D, FF / 64, D / 32, wd, FF, r, LANE);
}
__device__ __forceinline__ void conv_ffn_tile_load(ConvT& c, const Frame& F, int l, int which, int r, int LANE) {
    const Args& a = *F.a;
    constexpr int T_GU = (D / 64) * (FF / 32), NT = FF / 32;
    const size_t wo = (size_t)(l * 2 + which) * D * FF; const int wb = (l & 1) * 2 + which;
    bf16_t* wgu = (bf16_t*)(F.ws + WS_WGU + wb * WGU_BYTES); bf16_t* wd = (bf16_t*)(F.ws + WS_WD + wb * WD_BYTES);
    const float* gain = a.in[which == 0 ? I_NF1 : I_NF2] + (size_t)l * D;
    if (r < 2 * T_GU) { const int half = r >= T_GU ? 1 : 0; r -= half * T_GU; const int kb = r / NT, nb = r % NT, n0 = nb * 32;
        conv_tile_load(c, a.in[half ? I_WU : I_WG] + wo, D, FF, kb * 64, n0, wgu + (size_t)((n0 >> 7) * 256 + half * 128 + (n0 & 127)) * D + kb * 64, D, nullptr, LANE, gain); return; }
    r -= 2 * T_GU; { const int NTd = D / 32, kb = r / NTd, nb = r % NTd;
        conv_tile_load(c, a.in[I_WDN] + wo, FF, D, kb * 64, nb * 32, wd + (size_t)(nb * 32) * FF + kb * 64, FF, nullptr, LANE, nullptr); }
}
__device__ __forceinline__ void early_convert(const Frame& F, int lnext, int which, int first, int last, int wg0) {
    int tid_ = threadIdx.x; asm volatile("" : "+v"(tid_)); int bid_ = blockIdx.x; asm volatile("" : "+s"(bid_));
    const int LANE = tid_ & 63, WAVE = __builtin_amdgcn_readfirstlane(tid_ >> 6), BID = bid_;
    const int gw = (BID - wg0) * NWAVES + WAVE, NGW = (GRID - wg0) * NWAVES;
    for (int r = first + gw; r < last; r += 2 * NGW) {
        ConvT c0, c1; const bool two = r + NGW < last;
        conv_ffn_tile_load(c0, F, lnext, which, r, LANE);
        if (two) conv_ffn_tile_load(c1, F, lnext, which, r + NGW, LANE);
        conv_tile_finish(c0, LANE);
        if (two) conv_tile_finish(c1, LANE);
    }
}
__device__ __forceinline__ void phase_convert(const Frame& F, int l, int wg0) {
    int tid_ = threadIdx.x; asm volatile("" : "+v"(tid_)); int bid_ = blockIdx.x; asm volatile("" : "+s"(bid_));
    const int TID = tid_, LANE = tid_ & 63, WAVE = __builtin_amdgcn_readfirstlane(tid_ >> 6), BID = bid_; (void)TID; (void)LANE; (void)WAVE; (void)BID;

    const Args& a = *F.a; const int kind = l % 3, j = l / 3;
    if (BID < wg0) return;
    const int gw = (BID - wg0) * NWAVES + WAVE, NGW = (GRID - wg0) * NWAVES;
    constexpr int T_GU = (D / 64) * (FF / 32), T_DN = (FF / 64) * (D / 32);
    const int T_FFN = l == 0 ? T_HALF0 : 0;
    int nmix = 0;
    if (kind == 0) nmix = 4 * (512 / 64) * (512 / 32);
    else if (kind == 1) nmix = (D / 64) * (QKVD / 32) + (D / 64) * (D / 32);
    else nmix = 4 * (D / 64) * (D / 32) + 3 * (D / 64) * (256 / 32) + 3 * (256 / 64) * (D / 32);
    const int total = T_FFN + nmix;
    for (int it = gw; it < total; it += NGW) {
        int r = it;
        if (r < T_FFN) {
            conv_ffn_tile(F, l, 0, r, LANE); continue;
        }
        r -= T_FFN;
        unsigned char* wm = F.ws + (kind == 2 ? WS_WMIX2 : WS_WMIX);
        if (kind == 0) {
            const int g = r / 128; r -= g * 128;
            conv_plain(a.in[I_PW] + ((size_t)(j * 4 + g) * 512) * 512, 512, 512, 8, 16, (bf16_t*)(wm + WM_POOL) + (size_t)g * 512 * 512, 512, r, LANE, a.in[I_PSC] + (size_t)j * D + g * 512);
        } else if (kind == 1) {
            constexpr int T_Q = (D / 64) * (QKVD / 32);
            if (r < T_Q) { conv_plain(a.in[I_AQKV] + (size_t)j * D * QKVD, D, QKVD, D / 64, QKVD / 32, (bf16_t*)(wm + WM_QKV), D, r, LANE, nullptr, a.in[I_NMIX] + (size_t)l * D); continue; } r -= T_Q;
            conv_plain(a.in[I_AWO] + (size_t)j * D * D, D, D, D / 64, D / 32, (bf16_t*)(wm + WM_AO), D, r, LANE);
        } else {
            constexpr int T_SQ = (D / 64) * (D / 32), T_L1 = (D / 64) * (256 / 32), T_L2 = (256 / 64) * (D / 32);
            bf16_t* rw = (bf16_t*)(wm + WM_RW); bf16_t* l2 = (bf16_t*)(wm + WM_L2); bf16_t* ro = (bf16_t*)(wm + WM_RO);
            if (r < T_SQ) { conv_plain(a.in[I_RWR] + (size_t)j * D * D, D, D, D / 64, D / 32, rw, D, r, LANE); continue; } r -= T_SQ;
            if (r < T_SQ) { conv_plain(a.in[I_RWK] + (size_t)j * D * D, D, D, D / 64, D / 32, rw + (size_t)2048 * D, D, r, LANE); continue; } r -= T_SQ;
            if (r < T_SQ) { conv_plain(a.in[I_RWV] + (size_t)j * D * D, D, D, D / 64, D / 32, rw + (size_t)4096 * D, D, r, LANE); continue; } r -= T_SQ;
            if (r < T_SQ) { conv_plain(a.in[I_RWO] + (size_t)j * D * D, D, D, D / 64, D / 32, ro, D, r, LANE); continue; } r -= T_SQ;
            if (r < T_L1) { conv_plain(a.in[I_W1] + (size_t)j * D * 96, D, 96, D / 64, 8, rw + (size_t)6144 * D, D, r, LANE); continue; } r -= T_L1;
            if (r < T_L1) { conv_plain(a.in[I_A1] + (size_t)j * D * 96, D, 96, D / 64, 8, rw + (size_t)6400 * D, D, r, LANE); continue; } r -= T_L1;
            if (r < T_L1) { conv_plain(a.in[I_G1] + (size_t)j * D * 256, D, 256, D / 64, 8, rw + (size_t)6656 * D, D, r, LANE); continue; } r -= T_L1;
            if (r < T_L2) { conv_plain(a.in[I_W2] + (size_t)j * 96 * D, 96, D, 4, D / 32, l2, 256, r, LANE); continue; } r -= T_L2;
            if (r < T_L2) { conv_plain(a.in[I_A2] + (size_t)j * 96 * D, 96, D, 4, D / 32, l2 + (size_t)2048 * 256, 256, r, LANE); continue; } r -= T_L2;
            conv_plain(a.in[I_G2] + (size_t)j * 256 * D, 256, D, 4, D / 32, l2 + (size_t)4096 * 256, 256, r, LANE);
        }
    }
}

struct RowV { f32x4 v[8]; };
__device__ __forceinline__ float row_sumsq(const RowV& r) { float s = 0.f;
#pragma unroll
    for (int jj = 0; jj < 8; ++jj) s += (r.v[jj].x * r.v[jj].x + r.v[jj].y * r.v[jj].y) + (r.v[jj].z * r.v[jj].z + r.v[jj].w * r.v[jj].w);
    return wave_sum(s); }
__device__ __forceinline__ void row_store_x(const Frame& F, int m, const RowV& r, float ss, u64* SSb, int LANE, bool writeX) {
    bf16_t* XR = (bf16_t*)(F.ws + WS_XR);
#pragma unroll
    for (int jj = 0; jj < 8; ++jj) { const size_t off = (size_t)m * D + 4 * (LANE + 64 * jj);
        u32x2 w; w.x = cvt_pk_bf16(r.v[jj].x, r.v[jj].y); w.y = cvt_pk_bf16(r.v[jj].z, r.v[jj].w); *(u32x2*)(XR + off) = w; }
    if (LANE == 0) SSb[m] = (u64)(ss * SS_SCALE);
}
template <int NP> __device__ __forceinline__ float sample_fold_row_t(const Frame& F, int m, RowV& r, int LANE) {
    const float* pp = (const float*)(F.ws + WS_PART) + (size_t)(m - MP) * D;
#pragma unroll
    for (int e = 0; e < 8; ++e) r.v[e] = ld_bf4((const bf16_t*)(F.ws + WS_XR) + (size_t)m * D + 4 * (LANE + 64 * e));
#pragma unroll
    for (int jb = 0; jb < 3; ++jb) {
        f32x4 t[NP > 0 ? NP : 1][3];
#pragma unroll
        for (int p = 0; p < NP; ++p)
#pragma unroll
            for (int e = 0; e < 3; ++e) if (3 * jb + e < 8) t[p][e] = *(const f32x4*)(pp + (size_t)p * 256 * D + 4 * (LANE + 64 * (3 * jb + e)));
#pragma unroll
        for (int p = 0; p < NP; ++p)
#pragma unroll
            for (int e = 0; e < 3; ++e) if (3 * jb + e < 8) r.v[3 * jb + e] += t[p][e];
        asm volatile("" ::: "memory");
    }
    return row_sumsq(r);
}
__device__ __forceinline__ float sample_fold_row(const Frame& F, int m, int nparts, RowV& r, int LANE) {
    if (nparts == 1) return sample_fold_row_t<1>(F, m, r, LANE);
    if (nparts == KS_DN) return sample_fold_row_t<KS_DN>(F, m, r, LANE);
    if (nparts == KS_WO) return sample_fold_row_t<KS_WO>(F, m, r, LANE);
    return sample_fold_row_t<KS_POOL>(F, m, r, LANE);
}
__device__ __forceinline__ void zero_ss(u64* SSb, int TID, int BID) { for (int i = BID * NTHREADS + TID; i < M; i += GRID * NTHREADS) SSb[i] = 0ull; }
#define PH_IDS int tid_ = threadIdx.x; asm volatile("" : "+v"(tid_)); int bid_ = blockIdx.x; asm volatile("" : "+s"(bid_)); \
    const int TID = tid_, LANE = tid_ & 63, WAVE = __builtin_amdgcn_readfirstlane(tid_ >> 6), BID = bid_; (void)TID; (void)LANE; (void)WAVE; (void)BID;
__device__ __forceinline__ u64* ss_buf(const Frame& F, int site) { return (u64*)(F.ws + WS_SS) + (size_t)(site % 3) * M; }

__device__ __forceinline__ void phase_first(const Frame& F) {
    PH_IDS
    const Args& a = *F.a;
    const int gw = BID * NWAVES + WAVE, NGW = gridDim.x * NWAVES;
    for (int m = gw; m < M; m += NGW) {
        const float* src = m < MP ? a.in[I_XP] + (size_t)m * D : a.in[I_XS] + (size_t)(m - MP) * D;
        RowV r;
#pragma unroll
        for (int jj = 0; jj < 8; ++jj) r.v[jj] = *(const f32x4*)(src + 4 * (LANE + 64 * jj));
        const float ss = row_sumsq(r);
        row_store_x(F, m, r, ss, ss_buf(F, 0), LANE, true);
    }
    zero_ss(ss_buf(F, 1), TID, BID);
}
__device__ __forceinline__ void phase_samplefold(const Frame& F, int site, int nparts, bool zero2 = false) {
    PH_IDS
    if (BID < 32) { const int m = MP + BID * 8 + WAVE; RowV r; const float ss = sample_fold_row(F, m, nparts, r, LANE); row_store_x(F, m, r, ss, ss_buf(F, site), LANE, true); }
    zero_ss(ss_buf(F, site + 1), TID, BID);
    if (zero2) zero_ss(ss_buf(F, site + 2), TID, BID);
}
__device__ __forceinline__ void phase_final(const Frame& F, int site, int nparts) {
    PH_IDS
    const Args& a = *F.a;
    const int gw = BID * NWAVES + WAVE, NGW = gridDim.x * NWAVES;
    const u64* SSb = ss_buf(F, site);
    f32x4 g[8];
#pragma unroll
    for (int jj = 0; jj < 8; ++jj) g[jj] = *(const f32x4*)(a.in[I_NFIN] + 4 * (LANE + 64 * jj));
    const bf16_t* XRp = (const bf16_t*)(F.ws + WS_XR);
    if (gw < MS) { const int m = MP + gw; RowV r; const float ss = sample_fold_row(F, m, nparts, r, LANE); const float rstd = 1.0f / sqrtf(ss * (1.0f / D) + RMS_EPS);
#pragma unroll
        for (int jj = 0; jj < 8; ++jj) *(f32x4*)(F.out + (size_t)m * D + 4 * (LANE + 64 * jj)) = r.v[jj] * rstd * g[jj]; }
    static_assert(MP % (GRID * NWAVES) == 0, "prompt rows per wave");
    RowV r; float rstd = ss_rstd(SSb[gw]);
#pragma unroll
    for (int jj = 0; jj < 8; ++jj) r.v[jj] = ld_bf4(XRp + (size_t)gw * D + 4 * (LANE + 64 * jj));
    for (int m = gw; m < MP; m += NGW) {
        RowV rn; float rsn = 0.f; const int mn = m + NGW;
        if (mn < MP) { rsn = ss_rstd(SSb[mn]);
#pragma unroll
            for (int jj = 0; jj < 8; ++jj) rn.v[jj] = ld_bf4(XRp + (size_t)mn * D + 4 * (LANE + 64 * jj)); }
#pragma unroll
        for (int jj = 0; jj < 8; ++jj) *(f32x4*)(F.out + (size_t)m * D + 4 * (LANE + 64 * jj)) = r.v[jj] * rstd * g[jj];
        if (mn < MP) {
#pragma unroll
            for (int jj = 0; jj < 8; ++jj) r.v[jj] = rn.v[jj];
            rstd = rsn; }
    }
}

__device__ __forceinline__ void phase_poolprep(const Frame& F, int l, int site, int nparts) {
    PH_IDS
    const Args& a = *F.a; const int j = l / 3;
    const int gw = BID * NWAVES + WAVE, NGW = gridDim.x * NWAVES;
    const u64* SSb = ss_buf(F, site);
    const float* gain = a.in[I_NMIX] + (size_t)l * D;
    const float* prefix_all = a.in[I_SPOOL] + (size_t)j * 32 * 15 * D;
    f32x4 g[8];
#pragma unroll
    for (int jj = 0; jj < 8; ++jj) g[jj] = *(const f32x4*)(gain + 4 * (LANE + 64 * jj));
    if (BID < 32) {
        const int b = BID, t = WAVE, m = MP + b * 8 + t;
        RowV r; const float ss = sample_fold_row(F, m, nparts, r, LANE); row_store_x(F, m, r, ss, ss_buf(F, site), LANE, true);
        const float rstd = 1.0f / sqrtf(ss * (1.0f / D) + RMS_EPS);
        LAS float* U8 = (LAS float*)F.lds;
#pragma unroll
        for (int jj = 0; jj < 8; ++jj) { r.v[jj] = r.v[jj] * rstd * g[jj]; *(LAS f32x4*)(U8 + t * D + 4 * (LANE + 64 * jj)) = r.v[jj]; }
        __syncthreads();
        const float* pf = prefix_all + (size_t)b * 15 * D;
        float* ps = F.out + O_POOLS + ((size_t)(j * 32 + b) * 15) * D;
#pragma unroll
        for (int jj = 0; jj < 8; ++jj) { const int w = 2 << (jj >> 1); const int col = 4 * (LANE + 64 * jj);
            const f32x4 u = r.v[jj]; f32x4 sacc = u;
            for (int d = 1; d < w; ++d) { const int tt = t - d; sacc += tt >= 0 ? *(const LAS f32x4*)(U8 + tt * D + col) : *(const f32x4*)(pf + (size_t)(15 + tt) * D + col); }
            const f32x4 df = sacc * (1.0f / (float)w) - u;
            u32x2 wv; wv.x = cvt_pk_bf16(df.x, df.y); wv.y = cvt_pk_bf16(df.z, df.w); *(u32x2*)(F.XB + (size_t)m * D + col) = wv;
            *(f32x4*)(ps + (size_t)(7 + t) * D + col) = u;
            if (t < 7) *(f32x4*)(ps + (size_t)t * D + col) = *(const f32x4*)(pf + (size_t)(8 + t) * D + col); }
        __syncthreads();
    }
    {
        LAS f32x4* tile = (LAS f32x4*)F.lds;
        LAS float* rsl = (LAS float*)(F.lds + 47 * 2048);
        for (int rb = BID; rb < MP / 32; rb += gridDim.x) {
            const int m0 = rb * 32, b = m0 >> 12, t0 = m0 & 4095;
            if (TID < 47) { const int t = t0 - 15 + TID; rsl[TID] = t >= 0 ? ss_rstd(SSb[b * SEQ + t]) : 0.f; }
            u32x2 raw[12];
#define PP_LOAD(gi_) do { const int H_ = (2 << (gi_)) - 1, R_ = 32 + H_; _Pragma("unroll") for (int k = 0; k < 12; ++k) { const int idx = TID + k * NTHREADS, r = idx >> 7, c4 = idx & 127, t = t0 - H_ + r; \
                raw[k] = (u32x2){0u, 0u}; if (idx < R_ * 128 && t >= 0) raw[k] = *(const u32x2*)((const bf16_t*)(F.ws + WS_XR) + (size_t)(b * SEQ + t) * D + (gi_) * 512 + 4 * c4); } } while (0)
            PP_LOAD(0);
            __syncthreads();
#pragma unroll 1
            for (int gi = 0; gi < 4; ++gi) {
                const int w = 2 << gi, H = w - 1, R = 32 + H;
#pragma unroll
                for (int k = 0; k < 12; ++k) { const int idx = TID + k * NTHREADS, r = idx >> 7;
                    if (idx < R * 128) tile[idx] = (f32x4){__uint_as_float(raw[k].x << 16), __uint_as_float(raw[k].x & 0xffff0000u), __uint_as_float(raw[k].y << 16), __uint_as_float(raw[k].y & 0xffff0000u)} * rsl[15 - H + r]; }
                __syncthreads();
                if (gi < 3) PP_LOAD(gi + 1);
                { const int c4 = TID & 127, rq = TID >> 7, col = gi * 512 + 4 * c4;
                  const f32x4 gv = *(const f32x4*)(gain + col);
                  f32x4 sacc = (f32x4){0.f, 0.f, 0.f, 0.f};
                  for (int d = 0; d < H; ++d) sacc += tile[(rq * 8 + d) * 128 + c4];
#pragma unroll
                  for (int rr = 0; rr < 8; ++rr) { const int r = rq * 8 + rr + H, t = t0 + rq * 8 + rr, m = m0 + rq * 8 + rr;
                      const f32x4 u = tile[r * 128 + c4];
                      sacc += u;
                      const int cnt = t + 1 < w ? t + 1 : w;
                      const f32x4 ug = u * gv, df = sacc * gv * (1.0f / (float)cnt) - ug;
                      u32x2 wv; wv.x = cvt_pk_bf16(df.x, df.y); wv.y = cvt_pk_bf16(df.z, df.w); *(u32x2*)(F.XB + (size_t)m * D + col) = wv;
                      if (t >= SEQ - 15) *(f32x4*)(F.out + O_POOLP + ((size_t)(j * 2 + b) * 15 + (t - (SEQ - 15))) * D + col) = ug;
                      sacc -= tile[(r - H) * 128 + c4]; } }
                __syncthreads();
            }
#undef PP_LOAD
        }
    }
    zero_ss(ss_buf(F, site + 1), TID, BID); zero_ss(ss_buf(F, site + 2), TID, BID);
}

__device__ __forceinline__ void rwkv_mix_store(const Frame& F, int m, int col, const f32x4& u, const f32x4& p, const float* mu) {
    bf16_t* mix6 = (bf16_t*)(F.ws + WS_MIX6);
    const f32x4 dx = p - u;
#pragma unroll
    for (int s = 0; s < 6; ++s) { const int mi = s == 0 ? 0 : s == 1 ? 2 : s == 2 ? 3 : s == 3 ? 1 : s;
        const f32x4 o = u + dx * *(const f32x4*)(mu + (size_t)mi * D + col);
        u32x2 wv; wv.x = cvt_pk_bf16(o.x, o.y); wv.y = cvt_pk_bf16(o.z, o.w); *(u32x2*)(mix6 + ((size_t)s * M + m) * D + col) = wv; }
}
__device__ __forceinline__ void phase_rwkvmix(const Frame& F, int l, int site, int nparts) {
    PH_IDS
    const Args& a = *F.a; const int j = l / 3;
    const int gw = BID * NWAVES + WAVE, NGW = gridDim.x * NWAVES;
    const u64* SSb = ss_buf(F, site);
    const float* gain = a.in[I_NMIX] + (size_t)l * D;
    const float* mu = a.in[I_MU] + (size_t)j * 6 * D;
    f32x4 g[8];
#pragma unroll
    for (int jj = 0; jj < 8; ++jj) g[jj] = *(const f32x4*)(gain + 4 * (LANE + 64 * jj));
    if (BID < 32) {
        const int b = BID, t = WAVE, m = MP + b * 8 + t;
        RowV r; const float ss = sample_fold_row(F, m, nparts, r, LANE); row_store_x(F, m, r, ss, ss_buf(F, site), LANE, true);
        const float rstd = 1.0f / sqrtf(ss * (1.0f / D) + RMS_EPS);
        LAS float* U8 = (LAS float*)F.lds;
#pragma unroll
        for (int jj = 0; jj < 8; ++jj) { r.v[jj] = r.v[jj] * rstd * g[jj]; *(LAS f32x4*)(U8 + t * D + 4 * (LANE + 64 * jj)) = r.v[jj]; }
        __syncthreads();
#pragma unroll
        for (int jj = 0; jj < 8; ++jj) { const int col = 4 * (LANE + 64 * jj);
            const f32x4 p = t > 0 ? *(const LAS f32x4*)(U8 + (t - 1) * D + col) : *(const f32x4*)(a.in[I_SSHIFT] + ((size_t)j * 32 + b) * D + col);
            rwkv_mix_store(F, m, col, r.v[jj], p, mu);
            if (t == 7) *(f32x4*)(F.out + O_SHS + ((size_t)j * 32 + b) * D + col) = r.v[jj]; }
        __syncthreads();
    }
    for (int rb = BID; rb < MP / 32; rb += gridDim.x) {
        const int m0 = rb * 32, b = m0 >> 12, t0 = m0 & 4095, col = 4 * (LANE + 64 * WAVE);
        bf16_t* mix6 = (bf16_t*)(F.ws + WS_MIX6);
        f32x4 mu6[6];
#pragma unroll
        for (int s6 = 0; s6 < 6; ++s6) { const int mi = s6 == 0 ? 0 : s6 == 1 ? 2 : s6 == 2 ? 3 : s6 == 3 ? 1 : s6; mu6[s6] = *(const f32x4*)(mu + (size_t)mi * D + col); }
        const f32x4 gv = *(const f32x4*)(gain + col);
        f32x4 p = (f32x4){0.f, 0.f, 0.f, 0.f};
        if (t0 > 0) p = ld_bf4((const bf16_t*)(F.ws + WS_XR) + (size_t)(m0 - 1) * D + col) * ss_rstd(SSb[m0 - 1]) * gv;
#pragma unroll 1
        for (int r0 = 0; r0 < 32; r0 += 16) {
            u32x2 raw[16]; float rs[16];
#pragma unroll
            for (int q = 0; q < 16; ++q) { raw[q] = *(const u32x2*)((const bf16_t*)(F.ws + WS_XR) + (size_t)(m0 + r0 + q) * D + col); rs[q] = ss_rstd(SSb[m0 + r0 + q]); }
#pragma unroll
            for (int q = 0; q < 16; ++q) { const int rr = r0 + q, m = m0 + rr;
                const f32x4 u = (f32x4){__uint_as_float(raw[q].x << 16), __uint_as_float(raw[q].x & 0xffff0000u), __uint_as_float(raw[q].y << 16), __uint_as_float(raw[q].y & 0xffff0000u)} * rs[q] * gv;
                const f32x4 dx = p - u;
#pragma unroll
                for (int s6 = 0; s6 < 6; ++s6) { const f32x4 o = u + dx * mu6[s6]; u32x2 wv; wv.x = cvt_pk_bf16(o.x, o.y); wv.y = cvt_pk_bf16(o.z, o.w); *(u32x2*)(mix6 + ((size_t)s6 * M + m) * D + col) = wv; }
                if (t0 + rr == SEQ - 1) *(f32x4*)(F.out + O_SHP + ((size_t)j * 2 + b) * D + col) = u;
                p = u; } }
    }
    zero_ss(ss_buf(F, site + 1), TID, BID); zero_ss(ss_buf(F, site + 2), TID, BID);
}

#ifndef GEMM_ALIGN
#define GEMM_ALIGN true
#endif
#ifndef GEMM_SP2
#define GEMM_SP2 true
#endif
constexpr int AT_KP = 144, AT_VP = 560, AT_PP = 336;
constexpr int AT_K = 0, AT_V = AT_K + 256 * AT_KP, AT_P = AT_V + 64 * AT_VP, AT_B = AT_P + 8 * 16 * AT_PP, AT_END = AT_B + 8 * 128 * 4;
static_assert(AT_END <= RING_BYTES, "attention LDS");
__device__ __forceinline__ void phase_attn(const Frame& F, int j) {
    int tid_ = threadIdx.x; asm volatile("" : "+v"(tid_)); int bid_ = blockIdx.x; asm volatile("" : "+s"(bid_));
    const int TID = tid_, LANE = tid_ & 63, WAVE = __builtin_amdgcn_readfirstlane(tid_ >> 6), BID = bid_; (void)TID; (void)LANE; (void)WAVE; (void)BID;

    const Args& a = *F.a;
    const bf16_t* QKV = (const bf16_t*)(F.ws + WS_QKV);
    LAS unsigned char* lds = F.lds;
    const int lane = LANE, g = WAVE, fr = lane & 15, fq = lane >> 4;
    for (int unit = BID; unit < 256 + 128; unit += gridDim.x) {
        const bool samp = unit >= 256;
        int b, kvh, qblk;
        if (!samp) { b = unit >> 7; kvh = (unit >> 5) & 3; qblk = unit & 31; } else { b = (unit - 256) >> 2; kvh = (unit - 256) & 3; qblk = 1; }
        __syncthreads();
        for (int i = TID; i < 8 * 128; i += NTHREADS) { const int gg = i >> 7, dist = i & 127;
            int bk = dist; if (dist >= 16) { bk = 16 + (int)(logf((float)dist * (1.0f / 16.0f)) / 2.0794415416798357f * 16.0f); bk = bk > 31 ? 31 : bk; }
            ((LAS float*)(lds + AT_B))[i] = a.in[I_RELB][bk * 32 + kvh * 8 + gg]; }
        for (int i = TID; i < 256 * 8; i += NTHREADS) { const int key = i >> 3, c8 = i & 7;
            u32x4 kv = (u32x4){0u, 0u, 0u, 0u}, vv = kv;
            if (!samp) { const int pos = qblk * 128 - 128 + key;
                if (pos >= 0) { const bf16_t* rp = QKV + (size_t)(b * SEQ + pos) * QKVD + D + kvh * 64 + c8 * 8; kv = *(const u32x4*)rp; vv = *(const u32x4*)(rp + 256);
                    if (qblk == 31 && key >= 128) {
                        float* ok = F.out + O_WKP + (((size_t)(j * 2 + b) * 128 + (key - 128)) * 4 + kvh) * 64 + c8 * 8; float* ov = F.out + O_WVP + (ok - (F.out + O_WKP));
                        *(f32x4*)ok = (f32x4){bf2f(kv.x & 0xffff), bf2f(kv.x >> 16), bf2f(kv.y & 0xffff), bf2f(kv.y >> 16)}; *(f32x4*)(ok + 4) = (f32x4){bf2f(kv.z & 0xffff), bf2f(kv.z >> 16), bf2f(kv.w & 0xffff), bf2f(kv.w >> 16)};
                        *(f32x4*)ov = (f32x4){bf2f(vv.x & 0xffff), bf2f(vv.x >> 16), bf2f(vv.y & 0xffff), bf2f(vv.y >> 16)}; *(f32x4*)(ov + 4) = (f32x4){bf2f(vv.z & 0xffff), bf2f(vv.z >> 16), bf2f(vv.w & 0xffff), bf2f(vv.w >> 16)}; } } }
            else if (key < 136) {
                f32x4 k0, k1, v0, v1;
                if (key < 128) { const size_t o = (((size_t)(j * 32 + b) * 128 + key) * 4 + kvh) * 64 + c8 * 8;
                    k0 = *(const f32x4*)(a.in[I_CK] + o); k1 = *(const f32x4*)(a.in[I_CK] + o + 4); v0 = *(const f32x4*)(a.in[I_CV] + o); v1 = *(const f32x4*)(a.in[I_CV] + o + 4);
                    kv.x = cvt_pk_bf16(k0.x, k0.y); kv.y = cvt_pk_bf16(k0.z, k0.w); kv.z = cvt_pk_bf16(k1.x, k1.y); kv.w = cvt_pk_bf16(k1.z, k1.w);
                    vv.x = cvt_pk_bf16(v0.x, v0.y); vv.y = cvt_pk_bf16(v0.z, v0.w); vv.z = cvt_pk_bf16(v1.x, v1.y); vv.w = cvt_pk_bf16(v1.z, v1.w); }
                else { const bf16_t* rp = QKV + (size_t)(MP + b * 8 + (key - 128)) * QKVD + D + kvh * 64 + c8 * 8; kv = *(const u32x4*)rp; vv = *(const u32x4*)(rp + 256);
                    k0 = (f32x4){bf2f(kv.x & 0xffff), bf2f(kv.x >> 16), bf2f(kv.y & 0xffff), bf2f(kv.y >> 16)}; k1 = (f32x4){bf2f(kv.z & 0xffff), bf2f(kv.z >> 16), bf2f(kv.w & 0xffff), bf2f(kv.w >> 16)};
                    v0 = (f32x4){bf2f(vv.x & 0xffff), bf2f(vv.x >> 16), bf2f(vv.y & 0xffff), bf2f(vv.y >> 16)}; v1 = (f32x4){bf2f(vv.z & 0xffff), bf2f(vv.z >> 16), bf2f(vv.w & 0xffff), bf2f(vv.w >> 16)}; }
                if (key >= 8) { const size_t o = (((size_t)(j * 32 + b) * 128 + (key - 8)) * 4 + kvh) * 64 + c8 * 8;
                    *(f32x4*)(F.out + O_WKS + o) = k0; *(f32x4*)(F.out + O_WKS + o + 4) = k1; *(f32x4*)(F.out + O_WVS + o) = v0; *(f32x4*)(F.out + O_WVS + o + 4) = v1; }
            }
            *(LAS u32x4*)(lds + AT_K + key * AT_KP + c8 * 16) = kv;
            const unsigned vw[4] = {vv.x, vv.y, vv.z, vv.w};
#pragma unroll
            for (int e = 0; e < 8; ++e) *(LAS unsigned short*)(lds + AT_V + (c8 * 8 + e) * AT_VP + key * 2) = (unsigned short)(e & 1 ? vw[e >> 1] >> 16 : vw[e >> 1] & 0xffff);
        }
        for (int i = TID; i < 64 * 24; i += NTHREADS) { const int dd = i / 24, kk = 256 + i % 24; *(LAS unsigned short*)(lds + AT_V + dd * AT_VP + kk * 2) = 0; }
        __syncthreads();
        const int hq = kvh * 8 + g;
        const float sink = a.in[I_SINK][j * 32 + hq];
        const LAS float* tbl = (const LAS float*)(lds + AT_B) + g * 128;
        LAS unsigned char* Pw = lds + AT_P + g * 16 * AT_PP;
        const int nqt = samp ? 1 : 8;
        for (int qt = 0; qt < nqt; ++qt) {
            int qrow; if (!samp) qrow = b * SEQ + qblk * 128 + qt * 16 + fr; else qrow = MP + b * 8 + (fr & 7);
            const bf16_t* qp = QKV + (size_t)qrow * QKVD + hq * 64 + fq * 8;
            const bf16x8 q0 = *(const bf16x8*)qp, q1 = *(const bf16x8*)(qp + 32);
            const int kb = 16 * qt;
            f32x4 sacc[9];
#pragma unroll
            for (int kt = 0; kt < 9; ++kt) { sacc[kt] = (f32x4){0.f, 0.f, 0.f, 0.f};
                const LAS unsigned char* kp = lds + AT_K + (kb + kt * 16 + fr) * AT_KP + fq * 16;
                const bf16x8 k0 = *(const LAS bf16x8*)kp, k1 = *(const LAS bf16x8*)(kp + 64);
                sacc[kt] = __builtin_amdgcn_mfma_f32_16x16x32_bf16(q0, k0, sacc[kt], 0, 0, 0);
                sacc[kt] = __builtin_amdgcn_mfma_f32_16x16x32_bf16(q1, k1, sacc[kt], 0, 0, 0); }
            float mx[4] = {-1e30f, -1e30f, -1e30f, -1e30f};
#pragma unroll
            for (int kt = 0; kt < 9; ++kt)
#pragma unroll
                for (int jj = 0; jj < 4; ++jj) { const int qi = qt * 16 + 4 * fq + jj, kj = kb + kt * 16 + fr, dist = qi + 128 - kj;
                    const bool valid = dist >= 0 && dist < 128 && (samp || qblk > 0 || kj >= 128);
                    const float s = valid ? sacc[kt][jj] * 0.125f + tbl[dist & 127] : -1e30f;
                    sacc[kt][jj] = s; mx[jj] = fmaxf(mx[jj], s); }
            float sm[4];
#pragma unroll
            for (int jj = 0; jj < 4; ++jj) { mx[jj] = fmaxf(row16_max(mx[jj]), sink); sm[jj] = 0.f; }
#pragma unroll
            for (int kt = 0; kt < 9; ++kt)
#pragma unroll
                for (int jj = 0; jj < 4; ++jj) { const float p = fast_exp(sacc[kt][jj] - mx[jj]); sm[jj] += p;
                    *(LAS unsigned short*)(Pw + (4 * fq + jj) * AT_PP + (kt * 16 + fr) * 2) = (unsigned short)(cvt_pk_bf16(p, 0.f) & 0xffff); }
#pragma unroll
            for (int jj = 0; jj < 4; ++jj) { *(LAS unsigned short*)(Pw + (4 * fq + jj) * AT_PP + (144 + fr) * 2) = 0; sm[jj] = row16_sum(sm[jj]) + fast_exp(sink - mx[jj]); }
            asm volatile("s_waitcnt lgkmcnt(0)" ::: "memory");
            f32x4 oacc[4];
#pragma unroll
            for (int dt = 0; dt < 4; ++dt) oacc[dt] = (f32x4){0.f, 0.f, 0.f, 0.f};
#pragma unroll
            for (int ks = 0; ks < 5; ++ks) { const bf16x8 pf = *(const LAS bf16x8*)(Pw + fr * AT_PP + (ks * 32 + fq * 8) * 2);
#pragma unroll
                for (int dt = 0; dt < 4; ++dt) { const bf16x8 vf = *(const LAS bf16x8*)(lds + AT_V + (dt * 16 + fr) * AT_VP + (kb + ks * 32 + fq * 8) * 2);
                    oacc[dt] = __builtin_amdgcn_mfma_f32_16x16x32_bf16(pf, vf, oacc[dt], 0, 0, 0); } }
#pragma unroll
            for (int jj = 0; jj < 4; ++jj) { const float inv = 1.0f / sm[jj]; const int ql = 4 * fq + jj;
                int orow; bool ok = true; if (!samp) orow = b * SEQ + qblk * 128 + qt * 16 + ql; else { orow = MP + b * 8 + (ql & 7); ok = ql < 8; }
                if (ok) {
#pragma unroll
                    for (int dt = 0; dt < 4; ++dt) F.XB[(size_t)orow * D + hq * 64 + dt * 16 + fr] = (bf16_t)(cvt_pk_bf16(oacc[dt][jj] * inv, 0.f) & 0xffff); } }
            asm volatile("s_waitcnt lgkmcnt(0)" ::: "memory");
        }
    }
}

constexpr int SC_TS = 32, SC_VEC = 0, SC_VQ = 5 * SC_TS * 64 * 4, SC_SC = SC_VQ + SC_TS * 16 * 4, SC_BUF = SC_SC + (SC_TS + 1) * 4 * 4 + 64;
static_assert(2 * SC_BUF <= RING_BYTES && SC_BUF % 16 == 0, "scan LDS");
struct ScanChunk { int m0, n, h, q; bool first, last, samp; int b; };
__device__ __forceinline__ ScanChunk scan_chunk(int ci, int w) {
    ScanChunk c;
    if (ci < 128) { const int pc = w & 63; c.b = pc >> 5; c.h = pc & 31; c.q = w >> 6; c.m0 = c.b * SEQ + ci * SC_TS; c.n = SC_TS; c.first = ci == 0; c.last = ci == 127; c.samp = false; }
    else { const int sc = (ci - 128) * 64 + (w & 63); c.q = w >> 6; c.b = sc >> 5; c.h = sc & 31; c.m0 = MP + c.b * 8; c.n = 8; c.first = true; c.last = true; c.samp = true; }
    return c;
}
struct ScanRegs { f32x4 r[2], k[2], w[2], a[2], v; };
template <int CTRL> __device__ __forceinline__ float dpp_t(float x) { return __int_as_float(__builtin_amdgcn_update_dpp(0, __float_as_int(x), CTRL, 0xf, 0xf, false)); }
__device__ __forceinline__ float oct_sum(float x) { x += dpp_t<0xB1>(x); x += dpp_t<0x4E>(x); x += dpp_t<0x141>(x); return x; }
__device__ __forceinline__ void scan_issue(const Frame& F, const ScanChunk& c, ScanRegs& g, const int ptid) {
    const bf16_t* R = (const bf16_t*)(F.ws + WS_RKV); const bf16_t* Kx = R + (size_t)M * D; const bf16_t* V = Kx + (size_t)M * D;
    const float* DEC = (const float*)(F.ws + WS_LUP); const float* AIC = DEC + (size_t)M * D;
    const int s = ptid >> 3, cg = ptid & 7;
    if (s < c.n) { const size_t base = (size_t)(c.m0 + s) * D + c.h * 64 + cg * 8;
#pragma unroll
        for (int e = 0; e < 2; ++e) { g.r[e] = ld_bf4(R + base + 4 * e); g.k[e] = ld_bf4(Kx + base + 4 * e); g.w[e] = *(const f32x4*)(DEC + base + 4 * e); g.a[e] = *(const f32x4*)(AIC + base + 4 * e); }
        g.v = ld_bf4(V + (size_t)(c.m0 + s) * D + c.h * 64 + c.q * 16 + (cg & 3) * 4); }
}
__device__ __forceinline__ void scan_derive(const Frame& F, const ScanChunk& c, const ScanRegs& g, LAS unsigned char* buf, int j, const int ptid) {
    const Args& a = *F.a;
    float* BON = (float*)(F.ws + WS_BONUS);
    const int s = ptid >> 3, cg = ptid & 7;
    if (s < c.n) {
        const size_t pc = (size_t)j * D + c.h * 64 + cg * 8;
        float n2 = 0.f, sbr = 0.f, kr = 0.f, bon = 0.f;
        LAS float* vec = (LAS float*)(buf + SC_VEC) + s * 64 + cg * 8;
#pragma unroll
        for (int e = 0; e < 2; ++e) {
            const f32x4 k_k = *(const f32x4*)(a.in[I_KK] + pc + 4 * e), k_a = *(const f32x4*)(a.in[I_KA] + pc + 4 * e), r_k = *(const f32x4*)(a.in[I_RK] + pc + 4 * e);
            const f32x4 r = g.r[e], k = g.k[e], w = g.w[e], ai = g.a[e];
            const f32x4 kk = k * k_k, km = k * ((ai - 1.0f) * k_a + 1.0f), bb = kk * ai, wr = w * r;
            const f32x4 t0 = kk * kk, t1 = bb * r, t2 = km * r, t3 = t2 * r_k;
            n2 += (t0.x + t0.y) + (t0.z + t0.w); sbr += (t1.x + t1.y) + (t1.z + t1.w); kr += (t2.x + t2.y) + (t2.z + t2.w); bon += (t3.x + t3.y) + (t3.z + t3.w);
            *(LAS f32x4*)(vec + (0 * SC_TS) * 64 + 4 * e) = kk; *(LAS f32x4*)(vec + (1 * SC_TS) * 64 + 4 * e) = wr; *(LAS f32x4*)(vec + (2 * SC_TS) * 64 + 4 * e) = w;
            *(LAS f32x4*)(vec + (3 * SC_TS) * 64 + 4 * e) = bb; *(LAS f32x4*)(vec + (4 * SC_TS) * 64 + 4 * e) = km;
        }
        n2 = oct_sum(n2); sbr = oct_sum(sbr); kr = oct_sum(kr); bon = oct_sum(bon);
        if (cg < 4) *(LAS f32x4*)((LAS float*)(buf + SC_VQ) + s * 16 + cg * 4) = g.v;
        if (cg == 0) { *(LAS f32x4*)((LAS float*)(buf + SC_SC) + s * 4) = (f32x4){1.0f / fmaxf(n2, 1e-24f), sbr, kr, 0.f}; if (c.q == 0) BON[(size_t)(c.m0 + s) * 32 + c.h] = bon; }
    }
}
__device__ __forceinline__ void phase_scan(const Frame& F, int j) {
    int tid_ = threadIdx.x; asm volatile("" : "+v"(tid_)); int bid_ = blockIdx.x; asm volatile("" : "+s"(bid_));
    const int LANE = tid_ & 63, WAVE = __builtin_amdgcn_readfirstlane(tid_ >> 6), BID = bid_;
    const Args& a = *F.a;
    float* Y = (float*)(F.ws + WS_Y);
    const int w = BID, lane = LANE, wave = WAVE, rg = lane >> 4, c4 = lane & 15;
    constexpr int CI0 = 128, NCH = 128 + 16;
    __syncthreads();
    if (wave >= 4) {
        const int ptid = tid_ - 256;
        ScanRegs ga, gb;
        { const ScanChunk c0 = scan_chunk(CI0, w); scan_issue(F, c0, ga, ptid); scan_derive(F, c0, ga, F.lds + (CI0 & 1) * SC_BUF, j, ptid); }
        { const ScanChunk c1 = scan_chunk(CI0 + 1, w); scan_issue(F, c1, ga, ptid); }
        __syncthreads();
        for (int ci = CI0; ci < NCH; ++ci) {
            if (ci + 2 < NCH) { const ScanChunk c2 = scan_chunk(ci + 2, w); scan_issue(F, c2, gb, ptid); }
            asm volatile("" ::: "memory");
            if (ci + 1 < NCH) { const ScanChunk c1 = scan_chunk(ci + 1, w); scan_derive(F, c1, ga, F.lds + ((ci + 1) & 1) * SC_BUF, j, ptid); }
            ga = gb;
            __syncthreads();
        }
    } else {
        const float* SW = a.in[I_SWKV] + (size_t)j * 32 * 32 * 4096;
        f32x4 Sn;
        { const ScanChunk c0 = scan_chunk(CI0, w); Sn = *(const f32x4*)(SW + (((size_t)c0.b * 32 + c0.h) * 64 + c0.q * 16 + wave * 4 + rg) * 64 + 4 * c4); }
        __syncthreads();
        f32x4 S = (f32x4){0.f, 0.f, 0.f, 0.f};
        for (int ci = CI0; ci < NCH; ++ci) {
            LAS unsigned char* buf = F.lds + (ci & 1) * SC_BUF;
            const ScanChunk c = scan_chunk(ci, w);
            const int row = c.q * 16 + wave * 4 + rg;
            const size_t soff = (((size_t)c.b * 32 + c.h) * 64 + row) * 64 + 4 * c4;
            if (c.first) { if (c.samp) S = Sn; else S = (f32x4){0.f, 0.f, 0.f, 0.f}; }
            if (ci + 1 < NCH) { const ScanChunk cn = scan_chunk(ci + 1, w); if (cn.samp) Sn = *(const f32x4*)(SW + (((size_t)cn.b * 32 + cn.h) * 64 + cn.q * 16 + wave * 4 + rg) * 64 + 4 * c4); }
            const LAS float* vec = (const LAS float*)(buf + SC_VEC) + 4 * c4; const LAS float* vq = (const LAS float*)(buf + SC_VQ) + wave * 4 + rg; const LAS float* scl = (const LAS float*)(buf + SC_SC);
            float* yp = Y + (size_t)(c.m0 + c4) * D + c.h * 64 + row;
            float ycap = 0.f;
            f32x4 Akk, Awr, Awd, Abb, Akm, Asc, Bkk, Bwr, Bwd, Bbb, Bkm, Bsc; float Avv, Bvv;
#define SC_LOAD(P, s_) do { P##kk = *(const LAS f32x4*)(vec + (0 * SC_TS + (s_)) * 64); P##wr = *(const LAS f32x4*)(vec + (1 * SC_TS + (s_)) * 64); P##wd = *(const LAS f32x4*)(vec + (2 * SC_TS + (s_)) * 64); \
        P##bb = *(const LAS f32x4*)(vec + (3 * SC_TS + (s_)) * 64); P##km = *(const LAS f32x4*)(vec + (4 * SC_TS + (s_)) * 64); P##sc = *(const LAS f32x4*)(scl + (s_) * 4); P##vv = vq[(s_) * 16]; } while (0)
#define SC_STEP(P, s_) do { float p = (S.x * P##kk.x + S.y * P##kk.y) + (S.z * P##kk.z + S.w * P##kk.w); float qv = (S.x * P##wr.x + S.y * P##wr.y) + (S.z * P##wr.z + S.w * P##wr.w); \
        p = row16_sum(p); qv = row16_sum(qv); const float sa2 = -P##sc.x * p; const float y = qv + sa2 * P##sc.y + P##vv * P##sc.z; \
        S = S * P##wd + P##bb * sa2 + P##km * P##vv; ycap = (((s_) & 15) == c4) ? y : ycap; } while (0)
            SC_LOAD(A, 0);
            for (int s = 0; s < c.n; s += 2) {
                SC_LOAD(B, s + 1);
                SC_STEP(A, s);
                SC_LOAD(A, s + 2);
                SC_STEP(B, s + 1);
                if (((s + 2) & 15) == 0 || s + 2 == c.n) { if (c4 < ((c.n < 16) ? c.n : 16)) yp[(size_t)((s + 2 - 1) & ~15) * D] = ycap; }
            }
#undef SC_LOAD
#undef SC_STEP
            if (c.last) { float* fo = F.out + (c.samp ? O_WKVS : O_WKVP) + soff; *(f32x4*)fo = S; }
            __syncthreads();
        }
    }
}

constexpr int CK_OPP = 144, CK_SLOT = 64 * CK_OPP, CK_FP = 65, CK_F0 = 14 * CK_SLOT, CK_F1 = CK_F0 + 64 * CK_FP * 4, CK_END = CK_F1 + 64 * CK_FP * 4;
static_assert(CK_END <= MISC_OFF, "chunk-scan LDS");
__device__ __forceinline__ void ck_mm(LAS unsigned char* lds, int aslot, int bslot, int rt, int ct0, int l15, int quad, f32x4 (&acc)[2]) {
    const LAS unsigned char* ap = lds + aslot * CK_SLOT + (rt * 16 + l15) * CK_OPP + quad * 16;
    const bf16x8 a0 = *(const LAS bf16x8*)ap, a1 = *(const LAS bf16x8*)(ap + 64);
#pragma unroll
    for (int cc = 0; cc < 2; ++cc) { const LAS unsigned char* bp = lds + bslot * CK_SLOT + ((ct0 + cc) * 16 + l15) * CK_OPP + quad * 16;
        const bf16x8 b0 = *(const LAS bf16x8*)bp, b1 = *(const LAS bf16x8*)(bp + 64);
        acc[cc] = __builtin_amdgcn_mfma_f32_16x16x32_bf16(a0, b0, acc[cc], 0, 0, 0);
        acc[cc] = __builtin_amdgcn_mfma_f32_16x16x32_bf16(a1, b1, acc[cc], 0, 0, 0); }
}
__device__ __forceinline__ void ck_mm_t(LAS unsigned char* lds, int aslot, int bslot, int rt, int ct0, int l15, int quad, f32x4 (&acc)[2]) {
    const LAS unsigned char* ap = lds + aslot * CK_SLOT + (rt * 16 + l15) * CK_OPP + quad * 16;
    const bf16x8 a0 = *(const LAS bf16x8*)ap, a1 = *(const LAS bf16x8*)(ap + 64);
#pragma unroll
    for (int cc = 0; cc < 2; ++cc) { const LAS unsigned char* bp = lds + bslot * CK_SLOT + ((ct0 + cc) * 16 + l15) * CK_OPP + quad * 16;
        const bf16x8 b0 = *(const LAS bf16x8*)bp, b1 = *(const LAS bf16x8*)(bp + 64);
        acc[cc] = __builtin_amdgcn_mfma_f32_16x16x32_bf16(b0, a0, acc[cc], 0, 0, 0);
        acc[cc] = __builtin_amdgcn_mfma_f32_16x16x32_bf16(b1, a1, acc[cc], 0, 0, 0); }
}
__device__ __forceinline__ void ck_st_rm(LAS unsigned char* lds, int slot, int rt, int ct, int l15, int quad, const f32x4& v) {
#pragma unroll
    for (int g = 0; g < 4; ++g) *(LAS unsigned short*)(lds + slot * CK_SLOT + (rt * 16 + quad * 4 + g) * CK_OPP + (ct * 16 + l15) * 2) = (unsigned short)(cvt_pk_bf16(v[g], 0.f) & 0xffffu);
}
__device__ __forceinline__ void ck_st_tr(LAS unsigned char* lds, int slot, int rt, int ct, int l15, int quad, const f32x4& v) {
    u32x2 w; w.x = cvt_pk_bf16(v[0], v[1]); w.y = cvt_pk_bf16(v[2], v[3]);
    *(LAS u32x2*)(lds + slot * CK_SLOT + (ct * 16 + l15) * CK_OPP + (rt * 16 + quad * 4) * 2) = w;
}
__device__ __forceinline__ void ck_st_rm_t(LAS unsigned char* lds, int slot, int rt, int ct, int l15, int quad, const f32x4& v) {
    u32x2 w; w.x = cvt_pk_bf16(v[0], v[1]); w.y = cvt_pk_bf16(v[2], v[3]);
    *(LAS u32x2*)(lds + slot * CK_SLOT + (rt * 16 + l15) * CK_OPP + (ct * 16 + quad * 4) * 2) = w;
}
#define CK_BAR() do { asm volatile("s_waitcnt lgkmcnt(0)" ::: "memory"); __builtin_amdgcn_s_barrier(); asm volatile("" ::: "memory"); } while (0)
__device__ __forceinline__ void phase_ck1(const Frame& F, int j) {
    int tid_ = threadIdx.x; asm volatile("" : "+v"(tid_)); int bid_ = blockIdx.x; asm volatile("" : "+s"(bid_));
    const int TID = tid_, LANE = tid_ & 63, WAVE = __builtin_amdgcn_readfirstlane(tid_ >> 6), BID = bid_;
    const Args& a = *F.a;
    LAS unsigned char* lds = F.lds;
    const bf16_t* R = (const bf16_t*)(F.ws + WS_RKV); const bf16_t* Kx = R + (size_t)M * D; const bf16_t* V = Kx + (size_t)M * D;
    const float* DEC = (const float*)(F.ws + WS_LUP); const float* AIC = DEC + (size_t)M * D;
    float* BON = (float*)(F.ws + WS_BONUS);
    float* CKA = (float*)(F.ws + WS_CKA); float* CKB = (float*)(F.ws + WS_CKB);
    LAS float* F0 = (LAS float*)(lds + CK_F0); LAS float* F1 = (LAS float*)(lds + CK_F1); LAS float* TOT = (LAS float*)(lds + 8 * CK_SLOT);
    const int t = TID >> 3, cg = TID & 7;
    const int seg = TID >> 6, jj = TID & 63;
    const int l15 = LANE & 15, quad = LANE >> 4, rt = WAVE >> 1, ct0 = (WAVE & 1) * 2;
    f32x4 nr[2], nk[2], nw[2], na[2], nv[2];
#define CK_FETCH(item_) do { const int pc_ = (item_) >> 6, c_ = (item_) & 63; const size_t base_ = (size_t)((pc_ >> 5) * SEQ + c_ * 64 + t) * D + (pc_ & 31) * 64 + cg * 8; \
        _Pragma("unroll") for (int e = 0; e < 2; ++e) { nr[e] = ld_bf4(R + base_ + 4 * e); nk[e] = ld_bf4(Kx + base_ + 4 * e); nw[e] = *(const f32x4*)(DEC + base_ + 4 * e); \
            na[e] = *(const f32x4*)(AIC + base_ + 4 * e); nv[e] = ld_bf4(V + base_ + 4 * e); } } while (0)
    CK_FETCH(BID);
    for (int it = 0; it < 16; ++it) {
        const int item = it * 256 + BID, pc = item >> 6, c = item & 63, b = pc >> 5, h = pc & 31, m0 = b * SEQ + c * 64;
        float kk[8], bb[8], km[8], rr[8], vv[8];
        { const size_t pb = (size_t)j * D + h * 64 + cg * 8;
          float n2 = 0.f, bon = 0.f;
#pragma unroll
          for (int e = 0; e < 2; ++e) {
              const f32x4 r4 = nr[e], k4 = nk[e], w4 = nw[e], a4 = na[e], v4 = nv[e];
              const f32x4 k_k = *(const f32x4*)(a.in[I_KK] + pb + 4 * e), k_a = *(const f32x4*)(a.in[I_KA] + pb + 4 * e), r_k = *(const f32x4*)(a.in[I_RK] + pb + 4 * e);
#pragma unroll
              for (int x = 0; x < 4; ++x) { const int i = 4 * e + x; const float kp = k4[x] * k_k[x]; kk[i] = kp; n2 += kp * kp; km[i] = k4[x] * (1.0f + (a4[x] - 1.0f) * k_a[x]); bb[i] = a4[x]; rr[i] = r4[x]; vv[i] = v4[x];
                  bon += r4[x] * km[i] * r_k[x]; F0[t * CK_FP + cg * 8 + i] = __builtin_amdgcn_logf(w4[x]); } }
          n2 = oct_sum(n2); bon = oct_sum(bon);
          const float inv = 1.0f / fmaxf(sqrtf(n2), 1e-12f);
#pragma unroll
          for (int i = 0; i < 8; ++i) { kk[i] *= inv; bb[i] *= kk[i]; }
          if (cg == 0) BON[(size_t)(m0 + t) * 32 + h] = bon; }
        if (it + 1 < 16) CK_FETCH(item + 256);
        CK_BAR();
        float xs[8];
#pragma unroll
        for (int i = 0; i < 8; ++i) { xs[i] = F0[(seg * 8 + i) * CK_FP + jj]; if (i) xs[i] += xs[i - 1]; }
        TOT[seg * 64 + jj] = xs[7];
        CK_BAR();
        { float off = 0.f;
#pragma unroll
          for (int s2 = 0; s2 < 7; ++s2) off += (s2 < seg) ? TOT[s2 * 64 + jj] : 0.f;
#pragma unroll
          for (int i = 0; i < 8; ++i) F0[(seg * 8 + i) * CK_FP + jj] = xs[i] + off; }
        CK_BAR();
        { unsigned pa[4], pbt[4], pk[4], pr[4], pkh[4];
          float av[8], bv[8], kv[8], rv[8], khv[8];
#pragma unroll
          for (int i = 0; i < 8; ++i) { const int col = cg * 8 + i;
              const float lgt = F0[t * CK_FP + col], lgp = t > 0 ? F0[(t - 1) * CK_FP + col] : 0.f, lgL = F0[63 * CK_FP + col];
              const float g = __builtin_amdgcn_exp2f(lgt), gp = __builtin_amdgcn_exp2f(lgp), gi = __builtin_amdgcn_exp2f(-lgt), gh = __builtin_amdgcn_exp2f(lgL - lgt);
              av[i] = -kk[i] * gp; bv[i] = bb[i] * gi; kv[i] = km[i] * gi; rv[i] = rr[i] * g; khv[i] = km[i] * gh;
              F1[t * CK_FP + col] = rv[i];
              *(LAS unsigned short*)(lds + 4 * CK_SLOT + col * CK_OPP + t * 2) = (unsigned short)(cvt_pk_bf16(av[i], 0.f) & 0xffffu);
              *(LAS unsigned short*)(lds + 5 * CK_SLOT + col * CK_OPP + t * 2) = (unsigned short)(cvt_pk_bf16(bb[i] * gh, 0.f) & 0xffffu);
              *(LAS unsigned short*)(lds + 6 * CK_SLOT + col * CK_OPP + t * 2) = (unsigned short)(cvt_pk_bf16(vv[i], 0.f) & 0xffffu); }
#pragma unroll
          for (int i = 0; i < 4; ++i) { pa[i] = cvt_pk_bf16(av[2 * i], av[2 * i + 1]); pbt[i] = cvt_pk_bf16(bv[2 * i], bv[2 * i + 1]); pk[i] = cvt_pk_bf16(kv[2 * i], kv[2 * i + 1]); pr[i] = cvt_pk_bf16(rv[2 * i], rv[2 * i + 1]); pkh[i] = cvt_pk_bf16(khv[2 * i], khv[2 * i + 1]); }
          const int ro = t * CK_OPP + cg * 16;
          *(LAS u32x4*)(lds + 0 * CK_SLOT + ro) = (u32x4){pa[0], pa[1], pa[2], pa[3]}; *(LAS u32x4*)(lds + 1 * CK_SLOT + ro) = (u32x4){pbt[0], pbt[1], pbt[2], pbt[3]};
          *(LAS u32x4*)(lds + 2 * CK_SLOT + ro) = (u32x4){pk[0], pk[1], pk[2], pk[3]}; *(LAS u32x4*)(lds + 3 * CK_SLOT + ro) = (u32x4){pr[0], pr[1], pr[2], pr[3]};
          *(LAS u32x4*)(lds + 7 * CK_SLOT + ro) = (u32x4){pkh[0], pkh[1], pkh[2], pkh[3]}; }
        CK_BAR();
        const f32x4 Z4 = (f32x4){0.f, 0.f, 0.f, 0.f};
        f32x4 TmN[2], TmR[2];
        { f32x4 gabn[2] = {Z4, Z4}, gabt[2] = {Z4, Z4}, gakt[2] = {Z4, Z4}, mbrn[2] = {Z4, Z4}, mkrt[2] = {Z4, Z4};
          ck_mm(lds, 1, 0, rt, ct0, l15, quad, gabn); ck_mm_t(lds, 1, 0, rt, ct0, l15, quad, gabt); ck_mm_t(lds, 2, 0, rt, ct0, l15, quad, gakt); ck_mm(lds, 1, 3, rt, ct0, l15, quad, mbrn); ck_mm_t(lds, 2, 3, rt, ct0, l15, quad, mkrt);
#pragma unroll
          for (int cc = 0; cc < 2; ++cc) { const int ct = ct0 + cc;
#pragma unroll
              for (int g = 0; g < 4; ++g) { const int rown = rt * 16 + quad * 4 + g, coln = ct * 16 + l15, rowt = rt * 16 + l15, colt = ct * 16 + quad * 4 + g;
                  gabn[cc][g] = rown < coln ? gabn[cc][g] : 0.f; mbrn[cc][g] = rown <= coln ? mbrn[cc][g] : 0.f;
                  gabt[cc][g] = rowt < colt ? gabt[cc][g] : 0.f; gakt[cc][g] = rowt < colt ? gakt[cc][g] : 0.f; mkrt[cc][g] = rowt <= colt ? mkrt[cc][g] : 0.f;
                  TmN[cc][g] = gabn[cc][g] + (rown == coln ? 1.0f : 0.f); TmR[cc][g] = gabt[cc][g] + (rowt == colt ? 1.0f : 0.f); }
              ck_st_rm_t(lds, 8, rt, ct, l15, quad, gabt[cc]); ck_st_tr(lds, 9, rt, ct, l15, quad, gabn[cc]); ck_st_rm_t(lds, 10, rt, ct, l15, quad, gakt[cc]);
              ck_st_tr(lds, 11, rt, ct, l15, quad, mbrn[cc]); ck_st_rm_t(lds, 12, rt, ct, l15, quad, mkrt[cc]); ck_st_rm_t(lds, 13, rt, ct, l15, quad, TmR[cc]); } }
        CK_BAR();
        { f32x4 x2n[2] = {Z4, Z4}, x2t[2] = {Z4, Z4};
          ck_mm(lds, 8, 9, rt, ct0, l15, quad, x2n); ck_mm_t(lds, 8, 9, rt, ct0, l15, quad, x2t);
#pragma unroll
          for (int cc = 0; cc < 2; ++cc) { ck_st_rm_t(lds, 0, rt, ct0 + cc, l15, quad, x2t[cc]); ck_st_tr(lds, 1, rt, ct0 + cc, l15, quad, x2n[cc]); } }
        CK_BAR();
#pragma unroll
        for (int k = 0; k < 4; ++k) {
            const int xin = (k & 1) ? 8 : 0, xout = (k & 1) ? 0 : 8, tin = (k & 1) ? 2 : 13, tout = (k & 1) ? 13 : 2;
            f32x4 x2n[2] = {Z4, Z4}, x2t[2] = {Z4, Z4}, tpn[2] = {Z4, Z4}, tpt[2] = {Z4, Z4};
            ck_mm(lds, xin, xin + 1, rt, ct0, l15, quad, x2n); ck_mm_t(lds, xin, xin + 1, rt, ct0, l15, quad, x2t); ck_mm(lds, tin, xin + 1, rt, ct0, l15, quad, tpn); ck_mm_t(lds, tin, xin + 1, rt, ct0, l15, quad, tpt);
#pragma unroll
            for (int cc = 0; cc < 2; ++cc) { TmN[cc] += tpn[cc]; TmR[cc] += tpt[cc];
                ck_st_rm_t(lds, xout, rt, ct0 + cc, l15, quad, x2t[cc]); ck_st_tr(lds, xout + 1, rt, ct0 + cc, l15, quad, x2n[cc]); ck_st_rm_t(lds, tout, rt, ct0 + cc, l15, quad, TmR[cc]); }
            CK_BAR();
        }
        { f32x4 tpn[2] = {Z4, Z4};
          ck_mm(lds, 13, 1, rt, ct0, l15, quad, tpn);
#pragma unroll
          for (int cc = 0; cc < 2; ++cc) { TmN[cc] += tpn[cc]; ck_st_tr(lds, 3, rt, ct0 + cc, l15, quad, TmN[cc]); } }
        CK_BAR();
        { f32x4 w1[2] = {Z4, Z4}, w2[2] = {Z4, Z4};
          ck_mm_t(lds, 4, 3, rt, ct0, l15, quad, w1); ck_mm_t(lds, 10, 3, rt, ct0, l15, quad, w2);
#pragma unroll
          for (int cc = 0; cc < 2; ++cc) { ck_st_rm_t(lds, 8, rt, ct0 + cc, l15, quad, w1[cc]); ck_st_rm_t(lds, 9, rt, ct0 + cc, l15, quad, w2[cc]); } }
        CK_BAR();
        { f32x4 pp[2] = {(f32x4){0.f, 0.f, 0.f, 0.f}, (f32x4){0.f, 0.f, 0.f, 0.f}}, zq[2] = {(f32x4){0.f, 0.f, 0.f, 0.f}, (f32x4){0.f, 0.f, 0.f, 0.f}},
                wh[2] = {(f32x4){0.f, 0.f, 0.f, 0.f}, (f32x4){0.f, 0.f, 0.f, 0.f}}, zy[2] = {(f32x4){0.f, 0.f, 0.f, 0.f}, (f32x4){0.f, 0.f, 0.f, 0.f}};
          ck_mm_t(lds, 8, 5, rt, ct0, l15, quad, pp); ck_mm(lds, 9, 5, rt, ct0, l15, quad, zq); ck_mm_t(lds, 8, 11, rt, ct0, l15, quad, wh); ck_mm(lds, 9, 11, rt, ct0, l15, quad, zy);
          float* gP = CKA + (size_t)item * 8192; float* gW = gP + 4096;
#pragma unroll
          for (int cc = 0; cc < 2; ++cc) { const int ct = ct0 + cc, col = ct * 16 + l15;
              { const int trow = rt * 16 + l15, tcol = ct * 16 + quad * 4;
                f32x4 pv = pp[cc], wv = wh[cc];
#pragma unroll
                for (int g = 0; g < 4; ++g) { pv[g] += (trow == tcol + g) ? __builtin_amdgcn_exp2f(F0[63 * CK_FP + trow]) : 0.f; wv[g] += F1[(tcol + g) * CK_FP + trow]; }
                *(f32x4*)(gP + trow * 64 + tcol) = pv; *(f32x4*)(gW + trow * 64 + tcol) = wv; }
#pragma unroll
              for (int g = 0; g < 4; ++g) { const int row = rt * 16 + quad * 4 + g;
                  zq[cc][g] += bf2f(*(const LAS unsigned short*)(lds + 7 * CK_SLOT + row * CK_OPP + col * 2));
                  zy[cc][g] += bf2f(*(const LAS unsigned short*)(lds + 12 * CK_SLOT + row * CK_OPP + col * 2)); }
              ck_st_tr(lds, 0, rt, ct, l15, quad, zq[cc]); ck_st_tr(lds, 1, rt, ct, l15, quad, zy[cc]); } }
        CK_BAR();
        { f32x4 qq[2] = {(f32x4){0.f, 0.f, 0.f, 0.f}, (f32x4){0.f, 0.f, 0.f, 0.f}}, yl[2] = {(f32x4){0.f, 0.f, 0.f, 0.f}, (f32x4){0.f, 0.f, 0.f, 0.f}};
          ck_mm_t(lds, 6, 0, rt, ct0, l15, quad, qq); ck_mm_t(lds, 6, 1, rt, ct0, l15, quad, yl);
          float* gQ = CKB + (size_t)item * 8192; float* gY = gQ + 4096;
#pragma unroll
          for (int cc = 0; cc < 2; ++cc) { const int o = (rt * 16 + l15) * 64 + (ct0 + cc) * 16 + quad * 4; *(f32x4*)(gQ + o) = qq[cc]; *(f32x4*)(gY + o) = yl[cc]; } }
        CK_BAR();
    }
#undef CK_FETCH
}
__device__ __forceinline__ void phase_ck2(const Frame& F, int j) {
    int tid_ = threadIdx.x; asm volatile("" : "+v"(tid_)); int bid_ = blockIdx.x; asm volatile("" : "+s"(bid_));
    const int LANE = tid_ & 63, WAVE = __builtin_amdgcn_readfirstlane(tid_ >> 6), BID = bid_;
    const float* CKA = (const float*)(F.ws + WS_CKA); const float* CKB = (const float*)(F.ws + WS_CKB);
    float* Y = (float*)(F.ws + WS_Y);
    const int pc = BID & 63, q = BID >> 6, b = pc >> 5, h = pc & 31, mat = WAVE >> 2, ct = WAVE & 3, l15 = LANE & 15, quad = LANE >> 4;
    constexpr int SP = 68;
    LAS float* Sb = (LAS float*)F.lds;
    for (int i = tid_; i < 2 * 16 * SP; i += NTHREADS) Sb[i] = 0.f;
    const float* opB = CKA + (size_t)(pc * 64) * 8192 + mat * 4096 + quad * 64 + ct * 16 + l15;
    const float* opC = CKB + (size_t)(pc * 64) * 8192 + mat * 4096 + (q * 16 + quad * 4) * 64 + ct * 16 + l15;
    float nb[16]; f32x4 nc;
#pragma unroll
    for (int ks = 0; ks < 16; ++ks) nb[ks] = opB[ks * 256];
#pragma unroll
    for (int g = 0; g < 4; ++g) nc[g] = opC[g * 64];
    CK_BAR();
    f32x4 acc = (f32x4){0.f, 0.f, 0.f, 0.f};
    for (int c = 0; c < 64; ++c) {
        float bcur[16];
#pragma unroll
        for (int ks = 0; ks < 16; ++ks) bcur[ks] = nb[ks];
        acc = nc;
        if (c + 1 < 64) {
#pragma unroll
            for (int ks = 0; ks < 16; ++ks) nb[ks] = opB[(size_t)(c + 1) * 8192 + ks * 256];
#pragma unroll
            for (int g = 0; g < 4; ++g) nc[g] = opC[(size_t)(c + 1) * 8192 + g * 64];
        }
        const LAS float* sa = Sb + (c & 1) * 16 * SP + l15 * SP + quad;
#pragma unroll
        for (int ks = 0; ks < 16; ++ks) acc = __builtin_amdgcn_mfma_f32_16x16x4f32(sa[4 * ks], bcur[ks], acc, 0, 0, 0);
        if (mat == 0) {
            LAS float* sn = Sb + ((c + 1) & 1) * 16 * SP + (quad * 4) * SP + ct * 16 + l15;
#pragma unroll
            for (int g = 0; g < 4; ++g) sn[g * SP] = acc[g];
        } else {
            float* yp = Y + (size_t)(b * SEQ + c * 64 + ct * 16 + l15) * D + h * 64 + q * 16 + quad * 4;
            *(f32x4*)yp = acc;
        }
        CK_BAR();
    }
    if (mat == 0) { float* fo = F.out + O_WKVP + (((size_t)b * 32 + h) * 64 + q * 16 + quad * 4) * 64 + ct * 16 + l15;
#pragma unroll
        for (int g = 0; g < 4; ++g) fo[g * 64] = acc[g]; }
}

__device__ __forceinline__ void phase_rwkvpost(const Frame& F, int j) {
    int tid_ = threadIdx.x; asm volatile("" : "+v"(tid_)); int bid_ = blockIdx.x; asm volatile("" : "+s"(bid_));
    const int TID = tid_, LANE = tid_ & 63, WAVE = __builtin_amdgcn_readfirstlane(tid_ >> 6), BID = bid_; (void)TID; (void)LANE; (void)WAVE; (void)BID;

    const Args& a = *F.a;
    const int gw = BID * NWAVES + WAVE, NGW = gridDim.x * NWAVES;
    const float* Y = (const float*)(F.ws + WS_Y); const bf16_t* V = (const bf16_t*)(F.ws + WS_RKV) + (size_t)2 * M * D; const bf16_t* G = (const bf16_t*)((const float*)(F.ws + WS_LUP) + (size_t)2 * M * D);
    const float* BON = (const float*)(F.ws + WS_BONUS);
    const float* lnw = a.in[I_LNW] + (size_t)j * D; const float* lnb = a.in[I_LNB] + (size_t)j * D;
    for (int m = gw; m < M; m += NGW) {
        f32x4 yv[8]; u32x2 gv[8], vv[8]; float bv[8];
#pragma unroll
        for (int jj = 0; jj < 8; ++jj) { const int col = 4 * (LANE + 64 * jj), head = col >> 6; const size_t off = (size_t)m * D + col;
            yv[jj] = *(const f32x4*)(Y + off); gv[jj] = *(const u32x2*)(G + off); vv[jj] = *(const u32x2*)(V + off); bv[jj] = BON[(size_t)m * 32 + head]; }
#pragma unroll
        for (int jj = 0; jj < 8; ++jj) { const int col = 4 * (LANE + 64 * jj); const size_t off = (size_t)m * D + col;
            const f32x4 y = yv[jj];
            const float mean = row16_sum((y.x + y.y) + (y.z + y.w)) * (1.0f / 64.0f);
            const f32x4 d = y - mean;
            const float var = row16_sum((d.x * d.x + d.y * d.y) + (d.z * d.z + d.w * d.w)) * (1.0f / 64.0f);
            const float rs = 1.0f / sqrtf(var + GN_EPS);
            const f32x4 yn = d * rs * *(const f32x4*)(lnw + col) + *(const f32x4*)(lnb + col);
            const float bon = bv[jj];
            const u32x2 gw2 = gv[jj]; const f32x4 gg = (f32x4){bf2f(gw2.x & 0xffff), bf2f(gw2.x >> 16), bf2f(gw2.y & 0xffff), bf2f(gw2.y >> 16)};
            const u32x2 vw = vv[jj]; const f32x4 v4 = (f32x4){__uint_as_float(vw.x << 16), __uint_as_float(vw.x & 0xffff0000u), __uint_as_float(vw.y << 16), __uint_as_float(vw.y & 0xffff0000u)};
            const f32x4 o = (yn + v4 * bon) * gg;
            u32x2 wv; wv.x = cvt_pk_bf16(o.x, o.y); wv.y = cvt_pk_bf16(o.z, o.w); *(u32x2*)(F.XB + off) = wv; }
    }
}

__global__ void __launch_bounds__(NTHREADS, 2) fwd_kernel(Args args) {
    extern __shared__ __attribute__((aligned(16))) unsigned char lds_raw[];
    Frame F;
    F.lds = (LAS unsigned char*)lds_raw;
    F.a = &args; F.ws = args.ws; F.out = args.out;
    F.X = (float*)(args.ws + WS_X); F.U = (float*)(args.ws + WS_U); F.XB = (bf16_t*)(args.ws + WS_XB);
    volatile LAS unsigned* MISC = (volatile LAS unsigned*)(F.lds + MISC_OFF);
    if (threadIdx.x < 64) MISC[threadIdx.x] = 0u;
    __syncthreads();
    unsigned* ctl = (unsigned*)(args.ws + WS_CTL);
    XcdBarrier bar; bar.bar = ctl + CW_BAR; bar.x = 0; bar.st = nullptr;
    const int lo = args.lo, hi = args.hi;
    const bool use_bar = (hi - lo) > 1;
    if (use_bar) bar = xcd_barrier_post(ctl + CW_BAR, MISC + 8);
    int ph = 0;
#define PHASE(...) do { if (ph >= lo && ph < hi) { { unsigned char* w_ = args.ws; asm volatile("" : "+s"(w_)); F.ws = w_; } __VA_ARGS__; if (ph + 1 < hi) xcd_barrier(bar); } ++ph; } while (0)
    const int G = gridDim.x;
#define c ((int)blockIdx.x)
#define PHASE_R(rep, ...) do { _Pragma("nounroll") for (int r_ = 0; r_ < (rep); ++r_) { PHASE(__VA_ARGS__); } } while (0)
    bf16_t* ACT = (bf16_t*)(F.ws + WS_ACT);

    bf16_t* XR = (bf16_t*)(F.ws + WS_XR);
    for (int l = 0; l < DEPTH; ++l) {
        const int kind = l % 3, j = l / 3, s0 = 3 * l;
        PHASE({ if (kind != 2) phase_convert(F, l, l == 0 ? 0 : 32); if (l == 0) phase_first(F); else phase_samplefold(F, s0, NP_DN); });
        for (int which = 0; which < 2; ++which) {
            if (which == 1) {
                if (kind == 0) {
                    PHASE({ phase_poolprep(F, l, s0 + 1, NP_DN); });
                    PHASE({ g8::Sched<1> S; S.T.init(MP / 256, D / 256, G, c); S.nt = 512 / 64; S.KS = KSE_POOL; S.Ksub = KSUB_POOL; S.A = (const char*)F.XB; S.B = (const char*)(F.ws + WS_WMIX + WM_POOL); S.lda = D; S.ldb = 512;
                            g8::EpiResid E{F.ws, nullptr, 1.0f, (s0 + 2) % 3, 1}; g8::gemm_phase<GEMM_ALIGN, GEMM_SP2, XR_POOL != 0>(F.lds, D, 512, S, E); });
                } else if (kind == 1) {
                    PHASE({ phase_samplefold(F, s0 + 1, NP_DN, true); });
                    PHASE({ g8::Sched<0> S; S.T.init(M / 256, QKVD / 256, G, c); S.nt = D / 64; S.KS = 0; S.Ksub = 0; S.A = (const char*)XR; S.B = (const char*)(F.ws + WS_WMIX + WM_QKV); S.lda = D; S.ldb = D;
                            g8::EpiQKV E{F.ws, args.in[I_ABQKV] + (size_t)j * QKVD, (s0 + 1) % 3}; g8::gemm_phase<GEMM_ALIGN, GEMM_SP2>(F.lds, D, D, S, E);
                            if (l + 1 < DEPTH && (l + 1) % 3 == 2) phase_convert(F, l + 1, QKV_FULL); });
                    PHASE({ phase_attn(F, j); });
                    PHASE({ g8::Sched<0> S; S.T.init(MP / 256, D / 256, G, c); S.nt = D / 64; S.KS = KSE_WO; S.Ksub = KSUB_WO; S.A = (const char*)F.XB; S.B = (const char*)(F.ws + WS_WMIX + WM_AO); S.lda = D; S.ldb = D;
                            g8::EpiResid E{F.ws, args.in[I_ABO] + (size_t)j * D, 1.0f, (s0 + 2) % 3, 1}; g8::gemm_phase<GEMM_ALIGN, GEMM_SP2, XR_WO != 0>(F.lds, D, D, S, E); });
                } else {
                    PHASE({ phase_rwkvmix(F, l, s0 + 1, NP_DN); });
                    PHASE({ g8::Sched<2> S; S.T.init(M / 256, 27, G, c); S.nt = D / 64; S.KS = 0; S.Ksub = 0; S.A = (const char*)(F.ws + WS_MIX6); S.B = (const char*)(F.ws + WS_WMIX2 + WM_RW); S.lda = D; S.ldb = D;
                            g8::EpiRwkv1 E{(float*)(F.ws + WS_RKV), (bf16_t*)(F.ws + WS_HL)}; g8::gemm_phase<GEMM_ALIGN, GEMM_SP2>(F.lds, D, D, S, E); });
                    PHASE({ g8::Sched<3> S; S.T.init((XR_LORA ? MP : M) / 256, 24, G, c); S.nt = 256 / 64;
                            S.KS = 0; S.Ksub = 0; S.A = (const char*)(F.ws + WS_HL); S.B = (const char*)(F.ws + WS_WMIX2 + WM_L2); S.lda = 768; S.ldb = 256;
                            g8::EpiLoraUp E{(float*)(F.ws + WS_LUP), args.in[I_W0] + (size_t)j * D, args.in[I_A0] + (size_t)j * D}; g8::gemm_phase<GEMM_ALIGN, GEMM_SP2, XR_LORA != 0>(F.lds, 768, 256, S, E); });
                    PHASE_R(REP_CK1, { phase_ck1(F, j); });
                    PHASE_R(REP_SCAN, { phase_ck2(F, j); phase_scan(F, j); });
                    PHASE({ phase_rwkvpost(F, j); });
                    PHASE({ g8::Sched<0> S; S.T.init(MP / 256, D / 256, G, c); S.nt = D / 64; S.KS = KSE_WO; S.Ksub = KSUB_WO; S.A = (const char*)F.XB; S.B = (const char*)(F.ws + WS_WMIX2 + WM_RO); S.lda = D; S.ldb = D;
                            g8::EpiResid E{F.ws, nullptr, 1.0f, (s0 + 2) % 3, 1}; g8::gemm_phase<GEMM_ALIGN, GEMM_SP2, XR_WO != 0>(F.lds, D, D, S, E); });
                }
                if (!(kind == 0 ? XR_POOL : XR_WO)) PHASE({ phase_samplefold(F, s0 + 2, kind == 0 ? NP_POOL : NP_WO); });
            }
            const int sin = s0 + (which ? 2 : 0);
            PHASE_R(REP_GU, { g8::Sched<0> S; S.T.init(M / 256, 2 * FF / 256, G, c); S.nt = D / 64; S.KS = 0; S.Ksub = 0; S.A = (const char*)XR; S.B = (const char*)(F.ws + WS_WGU + ((l & 1) * 2 + which) * WGU_BYTES); S.lda = D; S.ldb = D;
                    g8::EpiSwiGLU E{F.ws, sin % 3}; g8::gemm_phase<GEMM_ALIGN, GEMM_SP2>(F.lds, D, D, S, E);
                    if (EARLY_GU > 0 && l + which < DEPTH && (int)blockIdx.x >= GU_FULL) { const bool h0 = l == 0 && which == 0;
                        if (h0) early_convert(F, 0, 0, T_HALF0, T_HALF, GU_FULL);
                        early_convert(F, l + which, 1 - which, 0, h0 ? EARLY_GU0 : EARLY_GU, GU_FULL); } });
            PHASE({ g8::Sched<0> S; S.T.init(MP / 256, D / 256, G, c); S.nt = FF / 64; S.KS = KSE_DN; S.Ksub = KSUB_DN; S.A = (const char*)ACT; S.B = (const char*)(F.ws + WS_WD + ((l & 1) * 2 + which) * WD_BYTES); S.lda = FF; S.ldb = FF;
                    g8::EpiResid E{F.ws, nullptr, 0.5f, (sin + 1) % 3, (which == 0 ? kind == 1 : l + 1 < DEPTH) ? 1 : 0}; g8::gemm_phase<GEMM_ALIGN, GEMM_SP2, XR_DN != 0>(F.lds, FF, FF, S, E);
                    if (EARLY_TILES > EARLY_GU && l + which < DEPTH && (int)blockIdx.x >= DN_FULL) early_convert(F, l + which, 1 - which, (l == 0 && which == 0) ? EARLY_GU0 : EARLY_GU, EARLY_TILES, DN_FULL); });
        }
    }
    PHASE({ phase_final(F, 3 * DEPTH, NP_DN); });
#undef PHASE
#undef PHASE_R
#undef c
}

static int count_phases() { int n = 0; for (int l = 0; l < DEPTH; ++l) { const int kind = l % 3; n += 1 + 2 * (REP_GU + 1) + ((kind == 0 ? XR_POOL : XR_WO) ? 0 : 1) + (kind == 0 ? 2 : kind == 1 ? 4 : 5 + REP_SCAN + REP_CK1); } return n + 1; }
extern "C" void kernel_launch(void* const* d_in, const int* in_sizes, int n_in, void* d_out, int out_size, void* d_ws, size_t ws_size, hipStream_t stream) {
    static int ready = 0;
    if (ready == 0) {
        ready = -1;
        if (n_in != 40 || (size_t)out_size != O_END || ws_size < WS_END) { fprintf(stderr, "kernel_launch: unexpected shapes: n_in %d out %d (want %zu) ws %zu (need %zu)\n", n_in, out_size, (size_t)O_END, ws_size, (size_t)WS_END); return; }
        int dev = 0, cus = 0, per_cu = 0;
        if (hipGetDevice(&dev) != hipSuccess || hipDeviceGetAttribute(&cus, hipDeviceAttributeMultiprocessorCount, dev) != hipSuccess) { fprintf(stderr, "kernel_launch: device query failed\n"); return; }
        if (hipFuncSetAttribute((const void*)fwd_kernel, hipFuncAttributeMaxDynamicSharedMemorySize, LDS_BYTES) != hipSuccess) { fprintf(stderr, "kernel_launch: hipFuncSetAttribute failed\n"); return; }
        if (hipOccupancyMaxActiveBlocksPerMultiprocessor(&per_cu, (const void*)fwd_kernel, NTHREADS, LDS_BYTES) != hipSuccess || per_cu < 1) fprintf(stderr, "kernel_launch: occupancy query says %d blocks per CU\n", per_cu);
        (void)hipGetLastError();
        if (cus < GRID) { fprintf(stderr, "kernel_launch: needs %d CUs, device has %d\n", GRID, cus); return; }
        ready = 1;
    }
    if (ready < 0) return;
    (void)hipMemsetAsync((char*)d_ws + WS_CTL, 0, CTL_ZERO_BYTES, stream);
    Args a{};
    for (int i = 0; i < 40; ++i) a.in[i] = (const float*)d_in[i];
    a.out = (float*)d_out; a.ws = (unsigned char*)d_ws;
    const int NPH = count_phases();
#if N_LAUNCH_MODE == 1
    for (int p = 0; p < NPH; ++p) { a.lo = p; a.hi = p + 1; hipLaunchKernelGGL(fwd_kernel, dim3(GRID), dim3(NTHREADS), LDS_BYTES, stream, a); }
#else
    a.lo = 0; a.hi = NPH; hipLaunchKernelGGL(fwd_kernel, dim3(GRID), dim3(NTHREADS), LDS_BYTES, stream, a);
#endif
    const hipError_t le = hipPeekAtLastError();
    if (le != hipSuccess) fprintf(stderr, "kernel_launch: launch failed: %s\n", hipGetErrorName(le));
}
```

```cpp
#include <hip/hip_runtime.h>
#include <cstdio>
#include <cstdint>

#ifndef N_LAUNCH_MODE
#define N_LAUNCH_MODE 0
#endif

#ifndef REP_CONV
#define REP_CONV 1
#endif
#ifndef REP_GU
#define REP_GU 1
#endif
#ifndef REP_DN
#define REP_DN 1
#endif
#ifndef REP_SCAN
#define REP_SCAN 1
#endif
#ifndef REP_CK1
#define REP_CK1 1
#endif
#ifndef REP_OTHER
#define REP_OTHER 1
#endif
#define LAS __attribute__((address_space(3)))
typedef unsigned short bf16_t;
typedef short bf16x8 __attribute__((ext_vector_type(8)));
typedef float f32x4 __attribute__((ext_vector_type(4)));
typedef float f32x2 __attribute__((ext_vector_type(2)));
typedef unsigned u32x4 __attribute__((ext_vector_type(4)));
typedef unsigned u32x2 __attribute__((ext_vector_type(2)));
typedef unsigned long long u64;
constexpr int KS_DN = 11, KSUB_DN = 512, KS_WO = 4, KSUB_WO = 512, KS_POOL = 2, KSUB_POOL = 256;
#ifndef XR_DN
#define XR_DN 0
#endif
#ifndef XR_WO
#define XR_WO 1
#endif
#ifndef XR_POOL
#define XR_POOL 1
#endif
#ifndef XR_LORA
#define XR_LORA 1
#endif
static_assert(XR_DN == 0, "the extra-row epilogue updates x in place (no partial slab): the down projection keeps its split-K sample sub-units, whose idle workgroups convert weights");
constexpr int KSE_DN = XR_DN ? 0 : KS_DN, KSE_WO = XR_WO ? 0 : KS_WO, KSE_POOL = XR_POOL ? 0 : KS_POOL, NP_DN = XR_DN ? 1 : KS_DN, NP_WO = XR_WO ? 1 : KS_WO, NP_POOL = XR_POOL ? 1 : KS_POOL;
constexpr float SS_SCALE = 1048576.0f, SS_INV = 1.0f / 1048576.0f;
__device__ __forceinline__ float ss_rstd(u64 v) { return 1.0f / sqrtf((float)v * (SS_INV / 2048.0f) + 1e-6f); }

constexpr int D = 2048, FF = 5632, MP = 8192, MS = 256, M = MP + MS, SEQ = 4096, NWAVES = 8, NTHREADS = 512, GRID = 256;
constexpr int NHEAD = 32, HD = 64, QKVD = 2560, DEPTH = 4;
constexpr float RMS_EPS = 1e-6f, GN_EPS = 64e-5f;
constexpr size_t MIXPAD = 8192 + 128, MIXS = (size_t)M * D + MIXPAD;
constexpr size_t O_YP = 0, O_YS = O_YP + (size_t)MP * D, O_POOLP = O_YS + (size_t)MS * D, O_POOLS = O_POOLP + 2 * 2 * 15 * D, O_WKP = O_POOLS + (size_t)2 * 32 * 15 * D,
                 O_WVP = O_WKP + 2 * 128 * 256, O_WKS = O_WVP + 2 * 128 * 256, O_WVS = O_WKS + 32 * 128 * 256, O_SHP = O_WVS + 32 * 128 * 256, O_SHS = O_SHP + 2 * D,
                 O_WKVP = O_SHS + 32 * D, O_WKVS = O_WKVP + (size_t)2 * 32 * 4096, O_END = O_WKVS + (size_t)32 * 32 * 4096;
constexpr size_t MiB = 1u << 20;
constexpr size_t WS_CTL = 0, CTL_ZERO_BYTES = 1 * MiB;
constexpr size_t WS_WGU = 2 * MiB, WGU_BYTES = (size_t)2 * FF * D * 2;
constexpr size_t WS_WD = WS_WGU + 4 * WGU_BYTES, WD_BYTES = (size_t)D * FF * 2;
constexpr size_t WS_WMIX = WS_WD + 4 * WD_BYTES;
constexpr size_t WS_X = WS_WMIX + 40 * MiB, ROWF_BYTES = (size_t)M * D * 4;
constexpr size_t WS_WMIX2 = WS_X;
static_assert(ROWF_BYTES >= 40 * MiB, "second mixer-weight region");
constexpr size_t WS_U = WS_X + ROWF_BYTES;
constexpr size_t WS_XB = WS_U + ROWF_BYTES, ROWB_BYTES = (size_t)M * D * 2;
constexpr size_t WS_BIG = WS_XB + ROWB_BYTES;
constexpr size_t WS_ACT = WS_BIG, WS_QKV = WS_BIG, WS_MIX6 = WS_BIG;
constexpr size_t WS_RKV = WS_MIX6 + 6 * (ROWB_BYTES + MIXPAD * 2), WS_LUP = WS_RKV + 3 * ROWF_BYTES, WS_Y = WS_LUP + 3 * ROWF_BYTES, WS_HL = WS_Y + ROWF_BYTES,
                 WS_BONUS = WS_HL + (size_t)M * 768 * 2, WS_PART = WS_BONUS + 2 * MiB, WS_CKB = WS_PART + 24 * MiB, WS_XR = WS_CKB + 128 * MiB, WS_SS = WS_XR + ROWB_BYTES, WS_END = WS_SS + 1 * MiB;
static_assert((size_t)3 * M * 8 <= 1 * MiB, "SS buffers");
constexpr size_t WS_CKA = WS_MIX6;
static_assert(6 * ROWB_BYTES >= 128 * MiB, "CKA fits over MIX6");
constexpr size_t WM_POOL = 0;
constexpr size_t WM_QKV = 0, WM_AO = (size_t)QKVD * D * 2;
constexpr size_t WM_RW = 0, WM_L2 = (size_t)6912 * D * 2, WM_RO = WM_L2 + (size_t)6144 * 256 * 2;
static_assert(WM_RO + (size_t)D * D * 2 <= 40 * MiB, "mixer weights fit");
constexpr int RING_BYTES = 131072, LDS_BYTES = 163840, MISC_OFF = LDS_BYTES - 256;

constexpr int CW_BAR = 4096;

typedef __bf16 bf16x2_t __attribute__((ext_vector_type(2)));
__device__ __forceinline__ unsigned cvt_pk_bf16(float lo, float hi) { const f32x2 v = {lo, hi}; return __builtin_bit_cast(unsigned, __builtin_convertvector(v, bf16x2_t)); }
__device__ __forceinline__ float bf2f(unsigned short b) { return __uint_as_float(((unsigned)b) << 16); }
__device__ __forceinline__ f32x4 ld_bf4(const bf16_t* p) { const u32x2 w = *(const u32x2*)p; return (f32x4){__uint_as_float(w.x << 16), __uint_as_float(w.x & 0xffff0000u), __uint_as_float(w.y << 16), __uint_as_float(w.y & 0xffff0000u)}; }
__device__ __forceinline__ float wave_sum(float v) {
#pragma unroll
    for (int o = 1; o < 64; o <<= 1) v += __shfl_xor(v, o);
    return v;
}
__device__ __forceinline__ float dpp_ror(float x, int   n);
template <int N> __device__ __forceinline__ float dpp_ror_t(float x) { return __int_as_float(__builtin_amdgcn_update_dpp(0, __float_as_int(x), 0x120 + N, 0xf, 0xf, false)); }
__device__ __forceinline__ float row16_sum(float x) { x += dpp_ror_t<8>(x); x += dpp_ror_t<4>(x); x += dpp_ror_t<2>(x); x += dpp_ror_t<1>(x); return x; }
__device__ __forceinline__ float row16_max(float x) { x = fmaxf(x, dpp_ror_t<8>(x)); x = fmaxf(x, dpp_ror_t<4>(x)); x = fmaxf(x, dpp_ror_t<2>(x)); x = fmaxf(x, dpp_ror_t<1>(x)); return x; }
__device__ __forceinline__ float wave_sum_fast(float x) { x = row16_sum(x); x += __shfl_xor(x, 16); x += __shfl_xor(x, 32); return x; }
__device__ __forceinline__ float fast_exp(float x) { return __builtin_amdgcn_exp2f(x * 1.4426950408889634f); }
__device__ __forceinline__ float fast_sigmoid(float x) { return __builtin_amdgcn_rcpf(1.0f + fast_exp(-x)); }
__device__ __forceinline__ float fast_tanh(float x) { return 1.0f - 2.0f * __builtin_amdgcn_rcpf(1.0f + fast_exp(2.0f * x)); }

#define XB_TMO      128
#define XB_XCNT(j)  (256  + 64 * (j))
#define XB_XSUB(j)  (1280 + 64 * (j))
#define XB_XGEN(j)  (2304 + 64 * (j))
#define XB_TOP      3328
#define XB_TOPGEN   3392
#define XCD_BAR_WORDS 3456
#define XB_SPIN_CAP (1u << 18)
__device__ __forceinline__ unsigned xb_ld(unsigned* p)              { return __hip_atomic_load(p, __ATOMIC_RELAXED, __HIP_MEMORY_SCOPE_AGENT); }
__device__ __forceinline__ unsigned xb_add(unsigned* p, unsigned v) { return __hip_atomic_fetch_add(p, v, __ATOMIC_RELAXED, __HIP_MEMORY_SCOPE_AGENT); }
__device__ __forceinline__ unsigned xb_xcc_id() { return (unsigned)__builtin_amdgcn_s_getreg((3 << 11) | 20) & 0xFu; }
#define XB_SPIN(cond, bar) do { unsigned _sp = 0; while (cond) { __builtin_amdgcn_s_sleep(1); \
    if ((++_sp & 255u) == 0u) { if (xb_ld(&(bar)[XB_TMO])) break; if (_sp > XB_SPIN_CAP) { atomicAdd(&(bar)[XB_TMO], 1u); break; } } } } while (0)
struct XcdBarrier { unsigned* bar; unsigned x; volatile LAS unsigned* st; };
__device__ __forceinline__ XcdBarrier xcd_barrier_post(unsigned* bar, volatile LAS unsigned* st) {
    XcdBarrier b; b.bar = bar; b.x = xb_xcc_id(); b.st = st;
    if (threadIdx.x == 0) (void)xb_add(&bar[XB_XCNT(b.x)], 1u);
    return b;
}
__device__ __forceinline__ void xcd_barrier_complete(unsigned* bar, unsigned x, unsigned& nloc, unsigned& nx) {
    const unsigned G = gridDim.x * gridDim.y * gridDim.z;
    unsigned sum, cnt, mine, sp = 0u;
    for (;;) {
        sum = 0u; cnt = 0u; mine = 0u;
#pragma unroll
        for (unsigned j = 0; j < 16; ++j) { const unsigned c = xb_ld(&bar[XB_XCNT(j)]); sum += c; cnt += (c > 0u) ? 1u : 0u; mine = (j == x) ? c : mine; }
        if (sum == G) break;
        __builtin_amdgcn_s_sleep(1);
        if ((++sp & 255u) == 0u) { if (xb_ld(&bar[XB_TMO])) break; if (sp > XB_SPIN_CAP) { atomicAdd(&bar[XB_TMO], 1u); break; } }
    }
    nloc = mine > 0u ? mine : 1u; nx = cnt > 0u ? cnt : 1u;
}
__device__ __forceinline__ void xcd_barrier(const XcdBarrier& b) {
    asm volatile("s_waitcnt vmcnt(0)" ::: "memory");
    __syncthreads();
    if (threadIdx.x == 0) {
        unsigned* bar = b.bar; asm volatile("" : "+s"(bar));
        __builtin_amdgcn_s_waitcnt(0);
        unsigned nloc = b.st[0], nx = b.st[1];
        if (nloc == 0u) { xcd_barrier_complete(bar, b.x, nloc, nx); b.st[0] = nloc; b.st[1] = nx; }
        const unsigned old = xb_add(&bar[XB_XSUB(b.x)], 1u);
        const unsigned gen = old / nloc;
        if (old + 1u == (gen + 1u) * nloc) {
            __builtin_amdgcn_fence(__ATOMIC_RELEASE, "agent");
            asm volatile("s_waitcnt vmcnt(0)" ::: "memory");
            const unsigned og = xb_add(&bar[XB_TOP], 1u);
            const unsigned tg = og / nx;
            if (og + 1u == (tg + 1u) * nx) xb_add(&bar[XB_TOPGEN], 1u);
            else XB_SPIN(xb_ld(&bar[XB_TOPGEN]) == tg, bar);
            __builtin_amdgcn_fence(__ATOMIC_ACQUIRE, "agent");
            xb_add(&bar[XB_XGEN(b.x)], 1u);
            asm volatile("s_waitcnt vmcnt(0)" ::: "memory");
        } else {
            XB_SPIN(xb_ld(&bar[XB_XGEN(b.x)]) == gen, bar);
            __builtin_amdgcn_fence(__ATOMIC_ACQUIRE, "agent");
            asm volatile("s_waitcnt vmcnt(0)" ::: "memory");
        }
    }
    __syncthreads();
}

namespace g8 {
constexpr int BM = 256, BK = 64, HALF = 128, HTB = HALF * BK * 2, STAGE_BYTES = 8 * HTB, NXCD = 8, WGM = 8;
__host__ __device__ __forceinline__ int lds_byte(int r, int c) { const int st = (r >> 4) * 2 + (c >> 5), rr = r & 15, cc = c & 31, ob = rr * 64 + cc * 2; return st * 1024 + (ob ^ (((ob >> 9) & 1) << 5)); }
__host__ __device__ __forceinline__ void stage_rc(int b, int& R, int& C) { const int st = b / 1024, sb = b % 1024, swz = sb ^ (((sb >> 9) & 1) << 5); R = (st >> 1) * 16 + swz / 64; C = (st & 1) * 32 + (swz % 64) / 2; }
__host__ __device__ __forceinline__ int perm32(int rho) { const int n = rho >> 4, i = rho & 15; return 8 * (i >> 2) + 4 * n + (i & 3); }

struct Unit { const char* A; const char* B; int pm, pn, nt, part; };
struct Tiler {
    int nM, nN, nwg, G, c;
    __device__ void init(int nM_, int nN_, int G_, int c_) { nM = nM_; nN = nN_; nwg = nM * nN; G = G_; c = c_; }
    __device__ bool tile(int i, int& pm, int& pn) const {
        const long L = (long)i * G + c; if (L >= nwg) return false;
        int wgid = (int)L; { const int q = nwg / NXCD, r = nwg % NXCD, xcd = wgid % NXCD, off = wgid / NXCD; wgid = (xcd < r ? xcd * (q + 1) : r * (q + 1) + (xcd - r) * q) + off; }
        const int nig = WGM * nN, gid = wgid / nig, fm = gid * WGM, gsz = (nM - fm) < WGM ? (nM - fm) : WGM;
        pm = fm + ((wgid % nig) % gsz); pn = (wgid % nig) / gsz; return true;
    }
};
template <int MODE> struct Sched {
    Tiler T; const char* A; const char* B; int lda, ldb, nt;
    int KS, Ksub;
    __device__ __forceinline__ bool next(int i, Unit& u) const {
        int pm, pn;
        u.nt = nt; u.part = -1;
        if (KS > 0) {
            const long L = (long)i * T.G + T.c;
            if (L >= T.nwg) { const int sub = (int)(L - T.nwg); if (sub >= T.nN * KS) return false;
                pn = sub % T.nN; const int ks = sub / T.nN; u.pm = T.nM; u.pn = pn; u.nt = Ksub / BK; u.part = ks;
                size_t ao = (size_t)T.nM * BM * lda * 2 + (size_t)ks * Ksub * 2; if (MODE == 1) ao += (size_t)(pn >> 1) * 512 * 2;
                u.A = A + ao; u.B = B + (size_t)pn * BM * ldb * 2 + (size_t)ks * Ksub * 2; return true; }
        }
        if (!T.tile(i, pm, pn)) return false;
        u.pm = pm; u.pn = pn;
        size_t ao = (size_t)pm * BM * lda * 2;
        if (MODE == 1) ao += (size_t)(pn >> 1) * 512 * 2;
        if (MODE == 2) { const int slot = pn < 24 ? (pn >> 3) : (pn - 24 + 3); ao += (size_t)slot * MIXS * 2; }
        if (MODE == 3) ao += (size_t)(pn >> 3) * 256 * 2;
        u.A = A + ao; u.B = B + (size_t)pn * BM * ldb * 2; return true;
    }
};

constexpr int XBASE = 8 * HALF * BK * 2 + 8192, XBUF = 4096;
template <bool ALIGN_EPI, bool SP2, bool XROWS = false, class Epi, class SchedT>
__device__ __forceinline__ void gemm_phase(LAS unsigned char* lds, const int lda, const int ldb, const SchedT& S, const Epi& E) {
    static_assert(SP2 || !XROWS, "extra rows: two-phase schedule only");
    int tid = threadIdx.x; asm volatile("" : "+v"(tid));
    const int wid = __builtin_amdgcn_readfirstlane(tid >> 6), lane = tid & 63, wr = wid >> 2, wc = wid & 3, fr = lane & 15, fq = lane >> 4;
    unsigned voffA, voffB;
    { int R, C; stage_rc(tid * 16, R, C); const int Rb = Epi::PERM ? ((R & ~31) + perm32(R & 31)) : R;
        voffA = (unsigned)(R * lda + C) * 2u; voffB = (unsigned)(Rb * ldb + C) * 2u; }
    const size_t q64voffA = (size_t)64 * lda * 2, q64voffB = (size_t)64 * ldb * 2;
    const size_t kstep = (size_t)(BK * 2);
    const size_t hstepA = (size_t)HALF * lda * 2, hstepB = (size_t)HALF * ldb * 2;
    const unsigned ldsw = (unsigned)wid * 1024u;
    const int aoff = lds_byte(wr * 64 + fr, fq * 8), boff = lds_byte(wc * 32 + fr, fq * 8);
    long xoffu = 0; int ldsx = 0;
    if constexpr (XROWS) { const int sub = wid & 1, kt = (wid >> 1) & 1;
        xoffu = (long)kt * (BK * 2) - (long)(wid >> 1) * 16 * lda * 2; ldsx = XBASE + kt * 2048 + sub * 1024; }
#define PG8_XPTR(u) ((u).A + ((size_t)(MP - (u).pm * BM) + 8 * (u).pm) * lda * 2)
#define PG8_XSTAGE(buf, gbase) do { if constexpr (XROWS) __builtin_amdgcn_global_load_lds((const unsigned*)((const char*)(gbase) + xoffu + voffA), (LAS unsigned*)(lds + ldsx + (buf) * XBUF), 16, 0, 0); } while (0)
#define PG8_LDX(kt, k) do { if constexpr (XROWS) Ax = *(const LAS bf16x8*)(lds + (XBASE + xb * XBUF + (kt) * 2048 + (k) * 1024 - wc * 4096) + boff); } while (0)
#define PG8_XMMA(k) do { if constexpr (XROWS) { __builtin_amdgcn_s_setprio(1); if (wr == 0) { _Pragma("unroll") for (int n = 0; n < 2; ++n) xacc[n] = __builtin_amdgcn_mfma_f32_16x16x32_bf16(B0[n][k], Ax, xacc[n], 0, 0, 0); } \
        else { _Pragma("unroll") for (int n = 0; n < 2; ++n) xacc[n] = __builtin_amdgcn_mfma_f32_16x16x32_bf16(B1[n][k], Ax, xacc[n], 0, 0, 0); } __builtin_amdgcn_s_setprio(0); } } while (0)
#define PG8_SA(b, h) (((b) * 2 + (h)) * HTB)
#define PG8_SB(b, h) ((4 + (b) * 2 + (h)) * HTB)
#define PG8_STAGE(bufoff, gbase, voff) do { \
        __builtin_amdgcn_global_load_lds((const unsigned*)((const char*)(gbase) + (voff)), (LAS unsigned*)(lds + (bufoff) + ldsw), 16, 0, 0); \
        __builtin_amdgcn_global_load_lds((const unsigned*)((const char*)(gbase) + q64##voff + (voff)), (LAS unsigned*)(lds + (bufoff) + ldsw + 8192), 16, 0, 0); } while (0)
#define PG8_LDA(dst, b, h) do { _Pragma("unroll") for (int m = 0; m < 4; ++m) _Pragma("unroll") for (int k = 0; k < 2; ++k) dst[m][k] = *(const LAS bf16x8*)(lds + PG8_SA(b, h) + aoff + m * 2048 + k * 1024); } while (0)
#define PG8_LDB(dst, b, h) do { _Pragma("unroll") for (int n = 0; n < 2; ++n) _Pragma("unroll") for (int k = 0; k < 2; ++k) dst[n][k] = *(const LAS bf16x8*)(lds + PG8_SB(b, h) + boff + n * 2048 + k * 1024); } while (0)
#define PG8_MMA(ai, bj, At, Bt) do { __builtin_amdgcn_s_setprio(1); _Pragma("unroll") for (int m = 0; m < 4; ++m) _Pragma("unroll") for (int n = 0; n < 2; ++n) _Pragma("unroll") for (int k = 0; k < 2; ++k) \
        acc[ai][bj][m][n] = __builtin_amdgcn_mfma_f32_16x16x32_bf16(Bt[n][k], At[m][k], acc[ai][bj][m][n], 0, 0, 0); __builtin_amdgcn_s_setprio(0); } while (0)
#define PG8_WAIT_V(n) asm volatile("s_waitcnt vmcnt(" #n ")" ::: "memory")
#define PG8_WAIT_L(n) asm volatile("s_waitcnt lgkmcnt(" #n ")" ::: "memory")
#define PG8_BAR __builtin_amdgcn_s_barrier()
#define PG8_SCHED __builtin_amdgcn_sched_barrier(0)
    Unit cur, nxt; int ui = 0;
    E.prefetch(S, lds, tid);
    if (!S.next(0, cur)) return;
    f32x4 acc[2][2][4][2];
#pragma unroll
    for (int a = 0; a < 2; ++a)
#pragma unroll
        for (int b = 0; b < 2; ++b)
#pragma unroll
            for (int m = 0; m < 4; ++m)
#pragma unroll
                for (int n = 0; n < 2; ++n) acc[a][b][m][n] = (f32x4){0.f, 0.f, 0.f, 0.f};
    bf16x8 At[4][2], B0[2][2], B1[2][2];
    bf16x8 Ax; f32x4 xacc[2]; int xb = 0;
    if constexpr (XROWS) { xacc[0] = (f32x4){0.f, 0.f, 0.f, 0.f}; xacc[1] = (f32x4){0.f, 0.f, 0.f, 0.f}; }
    const char* cA = cur.A; const char* cB = cur.B;
    const char* cX = PG8_XPTR(cur);
    if constexpr (SP2) {
        PG8_XSTAGE(0, cX);
        PG8_STAGE(PG8_SB(0, 0), cB, voffB); PG8_STAGE(PG8_SB(0, 1), cB + hstepB, voffB); PG8_STAGE(PG8_SA(0, 0), cA, voffA); PG8_STAGE(PG8_SA(0, 1), cA + hstepA, voffA);
        if (wr == 1) PG8_BAR;
        PG8_WAIT_V(2); PG8_BAR;
        PG8_STAGE(PG8_SB(1, 0), cB + kstep, voffB); PG8_STAGE(PG8_SA(1, 0), cA + kstep, voffA); PG8_STAGE(PG8_SB(1, 1), cB + hstepB + kstep, voffB);
        PG8_WAIT_V(6); PG8_BAR;
    } else {
        PG8_STAGE(PG8_SB(0, 0), cB, voffB); PG8_STAGE(PG8_SA(0, 0), cA, voffA); PG8_STAGE(PG8_SB(0, 1), cB + hstepB, voffB); PG8_STAGE(PG8_SA(0, 1), cA + hstepA, voffA);
        if (wr == 1) PG8_BAR;
        PG8_WAIT_V(4); PG8_BAR;
        PG8_STAGE(PG8_SB(1, 0), cB + kstep, voffB); PG8_STAGE(PG8_SA(1, 0), cA + kstep, voffA); PG8_STAGE(PG8_SB(1, 1), cB + hstepB + kstep, voffB);
        PG8_WAIT_V(6); PG8_BAR;
    }
    for (;;) {
        const bool has_next = S.next(ui + 1, nxt);
        const char* nA = has_next ? nxt.A : cA; const char* nB = has_next ? nxt.B : cB;
        const char* nX = has_next ? PG8_XPTR(nxt) : cX;
        const int nt = cur.nt;
#pragma nounroll
        for (int t = 0; t < nt; t += 2) {
            const bool last = (t == nt - 2);
            const char* a1 = cA + (size_t)(t + 1) * kstep;
            const char* a2 = last ? nA : cA + (size_t)(t + 2) * kstep; const char* b2 = last ? nB : cB + (size_t)(t + 2) * kstep;
            const char* a3 = a2 + kstep; const char* b3 = b2 + kstep;
            if constexpr (SP2) {
            const char* x2 = last ? nX : cX + (size_t)(t + 2) * kstep;
            PG8_LDB(B0, 0, 0); PG8_LDB(B1, 0, 1); PG8_LDX(0, 0); PG8_SCHED; PG8_LDA(At, 0, 0); PG8_STAGE(PG8_SA(1, 1), a1 + hstepA, voffA); PG8_XSTAGE(xb ^ 1, x2);
            if constexpr (XROWS) PG8_WAIT_V(9); else PG8_WAIT_V(8);
            PG8_WAIT_L(0); PG8_BAR; PG8_MMA(0, 0, At, B0); PG8_MMA(0, 1, At, B1); PG8_XMMA(0); PG8_BAR; PG8_SCHED;
            PG8_LDA(At, 0, 1); PG8_LDX(0, 1); PG8_STAGE(PG8_SB(0, 0), b2, voffB); PG8_STAGE(PG8_SB(0, 1), b2 + hstepB, voffB); PG8_STAGE(PG8_SA(0, 0), a2, voffA);
            if constexpr (XROWS) PG8_WAIT_V(9); else PG8_WAIT_V(8);
            PG8_WAIT_L(0); PG8_BAR; PG8_MMA(1, 0, At, B0); PG8_MMA(1, 1, At, B1); PG8_XMMA(1); PG8_BAR; PG8_SCHED;
            PG8_LDB(B0, 1, 0); PG8_LDB(B1, 1, 1); PG8_LDX(1, 0); PG8_SCHED; PG8_LDA(At, 1, 0); PG8_STAGE(PG8_SA(0, 1), a2 + hstepA, voffA);
            PG8_WAIT_V(8); PG8_WAIT_L(0); PG8_BAR; PG8_MMA(0, 0, At, B0); PG8_MMA(0, 1, At, B1); PG8_XMMA(0); PG8_BAR; PG8_SCHED;
            PG8_LDA(At, 1, 1); PG8_LDX(1, 1); PG8_STAGE(PG8_SB(1, 0), b3, voffB); PG8_STAGE(PG8_SB(1, 1), b3 + hstepB, voffB); PG8_STAGE(PG8_SA(1, 0), a3, voffA);
            PG8_WAIT_V(8); PG8_WAIT_L(0); PG8_BAR; PG8_MMA(1, 0, At, B0); PG8_MMA(1, 1, At, B1); PG8_XMMA(1); PG8_BAR; PG8_SCHED;
            xb ^= 1;
            } else {
            PG8_LDB(B0, 0, 0); PG8_SCHED; PG8_LDA(At, 0, 0); PG8_STAGE(PG8_SA(1, 1), a1 + hstepA, voffA);
            PG8_WAIT_L(8); PG8_BAR; PG8_WAIT_L(0); PG8_MMA(0, 0, At, B0); PG8_BAR; PG8_SCHED;
            PG8_LDB(B1, 0, 1); PG8_STAGE(PG8_SB(0, 0), b2, voffB);
            PG8_BAR; PG8_WAIT_L(0); PG8_MMA(0, 1, At, B1); PG8_BAR;
            PG8_LDA(At, 0, 1); PG8_STAGE(PG8_SA(0, 0), a2, voffA);
            PG8_BAR; PG8_WAIT_L(0); PG8_MMA(1, 0, At, B0); PG8_BAR; PG8_SCHED;
            PG8_STAGE(PG8_SB(0, 1), b2 + hstepB, voffB);
            PG8_WAIT_V(6); PG8_BAR; PG8_MMA(1, 1, At, B1); PG8_BAR;
            PG8_LDB(B0, 1, 0); PG8_SCHED; PG8_LDA(At, 1, 0); PG8_STAGE(PG8_SA(0, 1), a2 + hstepA, voffA);
            PG8_WAIT_L(8); PG8_BAR; PG8_WAIT_L(0); PG8_MMA(0, 0, At, B0); PG8_BAR; PG8_SCHED;
            PG8_LDB(B1, 1, 1); PG8_STAGE(PG8_SB(1, 0), b3, voffB);
            PG8_BAR; PG8_WAIT_L(0); PG8_MMA(0, 1, At, B1); PG8_BAR;
            PG8_LDA(At, 1, 1); PG8_STAGE(PG8_SA(1, 0), a3, voffA);
            PG8_BAR; PG8_WAIT_L(0); PG8_MMA(1, 0, At, B0); PG8_BAR; PG8_SCHED;
            PG8_STAGE(PG8_SB(1, 1), b3 + hstepB, voffB);
            PG8_WAIT_V(6); PG8_BAR; PG8_MMA(1, 1, At, B1); PG8_BAR;
                    }
        }
        if constexpr (ALIGN_EPI) { if (wr == 0) PG8_BAR; }
        E(acc, cur, wr, wc, fr, fq, ui, lds);
        if constexpr (XROWS) { E.xrows(xacc, cur, wr, wc, fr, fq, ui, lds); xacc[0] = (f32x4){0.f, 0.f, 0.f, 0.f}; xacc[1] = (f32x4){0.f, 0.f, 0.f, 0.f}; }
        if (!has_next) break;
#pragma unroll
        for (int a = 0; a < 2; ++a)
#pragma unroll
            for (int b = 0; b < 2; ++b)
#pragma unroll
                for (int m = 0; m < 4; ++m)
#pragma unroll
                    for (int n = 0; n < 2; ++n) acc[a][b][m][n] = (f32x4){0.f, 0.f, 0.f, 0.f};
        cur = nxt; cA = nA; cB = nB; cX = nX; ++ui;
        if constexpr (ALIGN_EPI) { if (wr == 1) PG8_BAR; }
    }
    PG8_WAIT_V(0);
    if constexpr (!ALIGN_EPI) { if (wr == 0) PG8_BAR; }
    PG8_BAR;
#undef PG8_XPTR
#undef PG8_XSTAGE
#undef PG8_LDX
#undef PG8_XMMA
#undef PG8_SA
#undef PG8_SB
#undef PG8_STAGE
#undef PG8_LDA
#undef PG8_LDB
#undef PG8_MMA
#undef PG8_WAIT_V
#undef PG8_WAIT_L
#undef PG8_BAR
#undef PG8_SCHED
}

struct EpiSwiGLU {
    static constexpr bool PERM = true;
    template <class SchedT> __device__ __forceinline__ void prefetch(const SchedT& S, LAS unsigned char* lds, int tid) const {
        const u64* SS = (const u64*)(ws + WS_SS) + (size_t)ssidx * M; LAS float* RS = (LAS float*)(lds + STAGE_BYTES);
        for (int q = tid; q < 8 * 256; q += NTHREADS) { Unit u; if (S.next(q >> 8, u)) RS[q] = ss_rstd(SS[u.pm * BM + (q & 255)]); }
        asm volatile("s_waitcnt vmcnt(0) lgkmcnt(0)" ::: "memory");
    }
    unsigned char* ws; int ssidx;
    __device__ __forceinline__ void operator()(const f32x4 (&acc)[2][2][4][2], const Unit& u, int wr, int wc, int fr, int fq, int ui, LAS unsigned char* lds) const {
        bf16_t* O = (bf16_t*)(ws + WS_ACT);
        const int row0 = u.pm * BM + wr * 64 + fr, col0 = u.pn * 128 + wc * 32 + 8 * fq;
#pragma unroll
        for (int ai = 0; ai < 2; ++ai)
#pragma unroll
            for (int m = 0; m < 4; ++m) { bf16_t* rowp = O + (size_t)(row0 + ai * HALF + m * 16) * FF + col0;
                const float rs = ((const LAS float*)(lds + STAGE_BYTES))[ui * 256 + wr * 64 + fr + ai * HALF + m * 16];
                float h[8];
#pragma unroll
                for (int n = 0; n < 2; ++n)
#pragma unroll
                    for (int j = 0; j < 4; ++j) { const float g = acc[ai][0][m][n][j] * rs, up = acc[ai][1][m][n][j] * rs; h[n * 4 + j] = g * fast_sigmoid(g) * up; }
                u32x4 w; w.x = cvt_pk_bf16(h[0], h[1]); w.y = cvt_pk_bf16(h[2], h[3]); w.z = cvt_pk_bf16(h[4], h[5]); w.w = cvt_pk_bf16(h[6], h[7]);
                *(u32x4*)rowp = w; }
    }
};
struct EpiResid {
    static constexpr bool PERM = false;
    template <class SchedT> __device__ __forceinline__ void prefetch(const SchedT& S, LAS unsigned char* lds, int tid) const {
        if (bias) { LAS float* BS = (LAS float*)(lds + STAGE_BYTES);
            for (int q = tid; q < 8 * 256; q += NTHREADS) { Unit u; if (S.next(q >> 8, u)) BS[q] = u.part <= 0 ? bias[u.pn * BM + (q & 255)] : 0.f; }
            asm volatile("s_waitcnt vmcnt(0) lgkmcnt(0)" ::: "memory"); }
    }
    __device__ __forceinline__ void xrows(const f32x4 (&xacc)[2], const Unit& u, int wr, int wc, int fr, int fq, int ui, LAS unsigned char* lds) const {
        bf16_t* XR = (bf16_t*)(ws + WS_XR); u64* SS = (u64*)(ws + WS_SS) + (size_t)ssidx * M;
        const int row = MP + 8 * u.pm + (fr & 7);
        float ssq = 0.f;
        if (fr < 8) { bf16_t* p = XR + (size_t)row * D + u.pn * BM + wr * HALF + wc * 32 + 4 * fq;
            u32x2 o[2];
#pragma unroll
            for (int n = 0; n < 2; ++n) o[n] = *(const u32x2*)(p + n * 16);
#pragma unroll
            for (int n = 0; n < 2; ++n) { const f32x4 bv = bias ? *(const LAS f32x4*)((const LAS float*)(lds + STAGE_BYTES) + ui * 256 + wr * HALF + wc * 32 + n * 16 + 4 * fq) : (f32x4){0.f, 0.f, 0.f, 0.f};
                const f32x4 xold = (f32x4){__uint_as_float(o[n].x << 16), __uint_as_float(o[n].x & 0xffff0000u), __uint_as_float(o[n].y << 16), __uint_as_float(o[n].y & 0xffff0000u)};
                const f32x4 xn = xold + xacc[n] * alpha + bv;
                u32x2 w; w.x = cvt_pk_bf16(xn.x, xn.y); w.y = cvt_pk_bf16(xn.z, xn.w); *(u32x2*)(p + n * 16) = w;
                const f32x4 xr = (f32x4){__uint_as_float(w.x << 16), __uint_as_float(w.x & 0xffff0000u), __uint_as_float(w.y << 16), __uint_as_float(w.y & 0xffff0000u)};
                ssq += (xr.x * xr.x + xr.y * xr.y) + (xr.z * xr.z + xr.w * xr.w); } }
        ssq += __shfl_xor(ssq, 16); ssq += __shfl_xor(ssq, 32);
        if (fq == 0 && fr < 8) atomicAdd(SS + row, (u64)(ssq * SS_SCALE));
        asm volatile("" ::: "memory");
    }
    unsigned char* ws; const float* bias; float alpha; int ssidx; int wxr;
    __device__ __forceinline__ void operator()(const f32x4 (&acc)[2][2][4][2], const Unit& u, int wr, int wc, int fr, int fq, int ui, LAS unsigned char* lds) const {
        float* PART = (float*)(ws + WS_PART); bf16_t* XR = (bf16_t*)(ws + WS_XR); u64* SS = (u64*)(ws + WS_SS) + (size_t)ssidx * M;
        const int row0 = u.pm * BM + wr * 64 + fr, col0 = u.pn * BM + wc * 32 + 4 * fq;
        f32x4 bv[2][2];
#pragma unroll
        for (int bj = 0; bj < 2; ++bj)
#pragma unroll
            for (int n = 0; n < 2; ++n) bv[bj][n] = bias ? *(const LAS f32x4*)((const LAS float*)(lds + STAGE_BYTES) + ui * 256 + wc * 32 + 4 * fq + bj * HALF + n * 16) : (f32x4){0.f, 0.f, 0.f, 0.f};
        if (u.part >= 0) {
            float* base = PART + ((size_t)u.part * 256 + wr * 64 + fr) * D + col0;
#pragma unroll
            for (int ai = 0; ai < 2; ++ai)
#pragma unroll
                for (int m = 0; m < 4; ++m) { float* rowp = base + (size_t)(ai * HALF + m * 16) * D;
#pragma unroll
                    for (int bj = 0; bj < 2; ++bj)
#pragma unroll
                        for (int n = 0; n < 2; ++n) *(f32x4*)(rowp + bj * HALF + n * 16) = acc[ai][bj][m][n] * alpha + bv[bj][n]; }
            return;
        }
#pragma unroll
        for (int ai = 0; ai < 2; ++ai) {
            u32x2 xo[4][2][2];
#pragma unroll
            for (int m = 0; m < 4; ++m)
#pragma unroll
                for (int bj = 0; bj < 2; ++bj)
#pragma unroll
                    for (int n = 0; n < 2; ++n) xo[m][bj][n] = *(const u32x2*)(XR + (size_t)(row0 + ai * HALF + m * 16) * D + col0 + bj * HALF + n * 16);
#pragma unroll
            for (int m = 0; m < 4; ++m) { const size_t ro = (size_t)(row0 + ai * HALF + m * 16) * D + col0; float ssq = 0.f;
#pragma unroll
                for (int bj = 0; bj < 2; ++bj)
#pragma unroll
                    for (int n = 0; n < 2; ++n) { const u32x2 o = xo[m][bj][n];
                        const f32x4 xold = (f32x4){__uint_as_float(o.x << 16), __uint_as_float(o.x & 0xffff0000u), __uint_as_float(o.y << 16), __uint_as_float(o.y & 0xffff0000u)};
                        const f32x4 xn = xold + acc[ai][bj][m][n] * alpha + bv[bj][n];
                        u32x2 w; w.x = cvt_pk_bf16(xn.x, xn.y); w.y = cvt_pk_bf16(xn.z, xn.w); *(u32x2*)(XR + ro + bj * HALF + n * 16) = w;
                        const f32x4 xr = (f32x4){__uint_as_float(w.x << 16), __uint_as_float(w.x & 0xffff0000u), __uint_as_float(w.y << 16), __uint_as_float(w.y & 0xffff0000u)};
                        ssq += (xr.x * xr.x + xr.y * xr.y) + (xr.z * xr.z + xr.w * xr.w); }
                ssq += __shfl_xor(ssq, 16); ssq += __shfl_xor(ssq, 32);
                if (fq == 0) atomicAdd(SS + row0 + ai * HALF + m * 16, (u64)(ssq * SS_SCALE)); }
            asm volatile("" ::: "memory"); }
    }
};
struct EpiQKV {
    static constexpr bool PERM = true;
    template <class SchedT> __device__ __forceinline__ void prefetch(const SchedT& S, LAS unsigned char* lds, int tid) const {
        const u64* SS = (const u64*)(ws + WS_SS) + (size_t)ssidx * M; LAS float* RS = (LAS float*)(lds + STAGE_BYTES);
        for (int q = tid; q < 8 * 256; q += NTHREADS) { Unit u; if (S.next(q >> 8, u)) RS[q] = ss_rstd(SS[u.pm * BM + (q & 255)]); }
        asm volatile("s_waitcnt vmcnt(0) lgkmcnt(0)" ::: "memory");
    }
    unsigned char* ws; const float* bias; int ssidx;
    __device__ __forceinline__ void operator()(const f32x4 (&acc)[2][2][4][2], const Unit& u, int wr, int wc, int fr, int fq, int ui, LAS unsigned char* lds) const {
        bf16_t* O = (bf16_t*)(ws + WS_QKV);
        const int row0 = u.pm * BM + wr * 64 + fr, col0 = u.pn * BM + wc * 32 + 8 * fq;
        f32x4 bv[2][2];
#pragma unroll
        for (int bj = 0; bj < 2; ++bj)
#pragma unroll
            for (int n = 0; n < 2; ++n) bv[bj][n] = *(const f32x4*)(bias + col0 + bj * HALF + 4 * n);
#pragma unroll
        for (int ai = 0; ai < 2; ++ai)
#pragma unroll
            for (int m = 0; m < 4; ++m) { bf16_t* rowp = O + (size_t)(row0 + ai * HALF + m * 16) * QKVD + col0;
                const float rs = ((const LAS float*)(lds + STAGE_BYTES))[ui * 256 + wr * 64 + fr + ai * HALF + m * 16];
#pragma unroll
                for (int bj = 0; bj < 2; ++bj) { const f32x4 v0 = acc[ai][bj][m][0] * rs + bv[bj][0], v1 = acc[ai][bj][m][1] * rs + bv[bj][1];
                    u32x4 w; w.x = cvt_pk_bf16(v0[0], v0[1]); w.y = cvt_pk_bf16(v0[2], v0[3]); w.z = cvt_pk_bf16(v1[0], v1[1]); w.w = cvt_pk_bf16(v1[2], v1[3]);
                    *(u32x4*)(rowp + bj * HALF) = w; } }
    }
};
struct EpiRwkv1 {
    static constexpr bool PERM = false;
    template <class SchedT> __device__ __forceinline__ void prefetch(const SchedT&, LAS unsigned char*, int) const {}
    float* RKV; bf16_t* HL;
    __device__ __forceinline__ void operator()(const f32x4 (&acc)[2][2][4][2], const Unit& u, int wr, int wc, int fr, int fq, int ui, LAS unsigned char* lds) const {
        const int row0 = u.pm * BM + wr * 64 + fr, cin = wc * 32 + 4 * fq;
        if (u.pn < 24) {
            bf16_t* base = (bf16_t*)RKV + (size_t)(u.pn >> 3) * M * D + (u.pn & 7) * BM + cin;
#pragma unroll
            for (int ai = 0; ai < 2; ++ai)
#pragma unroll
                for (int m = 0; m < 4; ++m) { bf16_t* rowp = base + (size_t)(row0 + ai * HALF + m * 16) * D;
#pragma unroll
                    for (int bj = 0; bj < 2; ++bj)
#pragma unroll
                        for (int n = 0; n < 2; ++n) { const f32x4 v = acc[ai][bj][m][n]; u32x2 w; w.x = cvt_pk_bf16(v[0], v[1]); w.y = cvt_pk_bf16(v[2], v[3]); *(u32x2*)(rowp + bj * HALF + n * 16) = w; } }
        } else {
            const int which = u.pn - 24;
            bf16_t* base = HL + which * 256 + cin;
#pragma unroll
            for (int ai = 0; ai < 2; ++ai)
#pragma unroll
                for (int m = 0; m < 4; ++m) { bf16_t* rowp = base + (size_t)(row0 + ai * HALF + m * 16) * 768;
#pragma unroll
                    for (int bj = 0; bj < 2; ++bj)
#pragma unroll
                        for (int n = 0; n < 2; ++n) { f32x4 v = acc[ai][bj][m][n];
                            if (which == 0) {
#pragma unroll
                                for (int j = 0; j < 4; ++j) v[j] = fast_tanh(v[j]);
                            } else if (which == 2) {
#pragma unroll
                                for (int j = 0; j < 4; ++j) v[j] = fast_sigmoid(v[j]);
                            }
                            u32x2 w; w.x = cvt_pk_bf16(v[0], v[1]); w.y = cvt_pk_bf16(v[2], v[3]);
                            *(u32x2*)(rowp + bj * HALF + n * 16) = w; }
                    asm volatile("" ::: "memory"); }
        }
    }
};
struct EpiLoraUp {
    static constexpr bool PERM = false;
    template <class SchedT> __device__ __forceinline__ void prefetch(const SchedT&, LAS unsigned char*, int) const {}
    float* LUP; const float* w0; const float* a0;
    __device__ __forceinline__ void xrows(const f32x4 (&xacc)[2], const Unit& u, int wr, int wc, int fr, int fq, int ui, LAS unsigned char* lds) const {
        const int which = u.pn >> 3, row = MP + 8 * u.pm + (fr & 7), col0 = (u.pn & 7) * BM + wr * HALF + wc * 32 + 4 * fq;
        const float* addp = which == 0 ? w0 : a0;
        if (fr < 8) {
#pragma unroll
            for (int n = 0; n < 2; ++n) { f32x4 v = xacc[n]; if (which < 2) v += *(const f32x4*)(addp + col0 + n * 16);
                if (which < 2) {
#pragma unroll
                    for (int j = 0; j < 4; ++j) v[j] = fast_sigmoid(v[j]);
                    if (which == 0) {
#pragma unroll
                        for (int j = 0; j < 4; ++j) v[j] = fast_exp(-0.6065306597126334f * v[j]);
                    }
                    *(f32x4*)(LUP + (size_t)which * M * D + (size_t)row * D + col0 + n * 16) = v;
                } else { u32x2 w; w.x = cvt_pk_bf16(v[0], v[1]); w.y = cvt_pk_bf16(v[2], v[3]);
                    *(u32x2*)((bf16_t*)(LUP + (size_t)2 * M * D) + (size_t)row * D + col0 + n * 16) = w; } } }
        asm volatile("" ::: "memory");
    }
    __device__ __forceinline__ void operator()(const f32x4 (&acc)[2][2][4][2], const Unit& u, int wr, int wc, int fr, int fq, int ui, LAS unsigned char* lds) const {
        const int which = u.pn >> 3, row0 = u.pm * BM + wr * 64 + fr, col0 = (u.pn & 7) * BM + wc * 32 + 4 * fq;
        const float* addp = which == 0 ? w0 : a0;
        f32x4 bv[2][2];
#pragma unroll
        for (int bj = 0; bj < 2; ++bj)
#pragma unroll
            for (int n = 0; n < 2; ++n) bv[bj][n] = which < 2 ? *(const f32x4*)(addp + col0 + bj * HALF + n * 16) : (f32x4){0.f, 0.f, 0.f, 0.f};
        float* base = LUP + (size_t)which * M * D + col0;
#pragma unroll
        for (int ai = 0; ai < 2; ++ai)
#pragma unroll
            for (int m = 0; m < 4; ++m) { float* rowp = base + (size_t)(row0 + ai * HALF + m * 16) * D;
#pragma unroll
                for (int bj = 0; bj < 2; ++bj)
#pragma unroll
                    for (int n = 0; n < 2; ++n) { f32x4 v = acc[ai][bj][m][n] + bv[bj][n];
                        if (which < 2) {
#pragma unroll
                            for (int j = 0; j < 4; ++j) v[j] = fast_sigmoid(v[j]);
                            if (which == 0) {
#pragma unroll
                                for (int j = 0; j < 4; ++j) v[j] = fast_exp(-0.6065306597126334f * v[j]);
                            }
                            *(f32x4*)(rowp + bj * HALF + n * 16) = v;
                        } else {
                            u32x2 w; w.x = cvt_pk_bf16(v[0], v[1]); w.y = cvt_pk_bf16(v[2], v[3]);
                            *(u32x2*)((bf16_t*)(LUP + (size_t)2 * M * D) + (size_t)(row0 + ai * HALF + m * 16) * D + col0 + bj * HALF + n * 16) = w; } }
                asm volatile("" ::: "memory"); }
    }
};
}

struct Args { const float* in[40]; float* out; unsigned char* ws; int lo, hi; };
enum { I_XP = 0, I_XS, I_SPOOL, I_CK, I_CV, I_SSHIFT, I_SWKV, I_NF1, I_NMIX, I_NF2, I_NFIN, I_WG, I_WU, I_WDN, I_PW, I_PSC, I_AQKV, I_ABQKV, I_AWO, I_ABO, I_SINK, I_RELB,
       I_MU, I_RWR, I_RWK, I_RWV, I_RWO, I_W0, I_W1, I_W2, I_A0, I_A1, I_A2, I_G1, I_G2, I_KK, I_KA, I_RK, I_LNW, I_LNB };

struct Frame {
    LAS unsigned char* lds; const Args* a; unsigned char* ws; float* out;
    float* X; float* U; bf16_t* XB;
};

struct ConvT { f32x4 v[8]; const float* nscale; const float* kscale; bf16_t* dst; int dld, k0, n, Ns; };
__device__ __forceinline__ void conv_tile_load(ConvT& c, const float* __restrict__ src, int Ks, int Ns, int k0, int n0, bf16_t* __restrict__ dst, int dld, const float* __restrict__ nscale, int lane, const float* __restrict__ kscale) {
    const int kg = lane >> 3, ng = lane & 7, n = n0 + 4 * ng;
#pragma unroll
    for (int i = 0; i < 8; ++i) { const int k = k0 + 8 * kg + i; c.v[i] = (k < Ks && n < Ns) ? __builtin_nontemporal_load((const f32x4*)(src + (size_t)k * Ns + n)) : (f32x4){0.f, 0.f, 0.f, 0.f}; }
    c.nscale = nscale; c.kscale = kscale; c.dst = dst; c.dld = dld; c.k0 = k0; c.n = n; c.Ns = Ns;
}
__device__ __forceinline__ void conv_tile_finish(ConvT& c, int lane) {
    const int kg = lane >> 3, ng = lane & 7;
    if (c.kscale) {
        const f32x4 g0 = *(const f32x4*)(c.kscale + c.k0 + 8 * kg), g1 = *(const f32x4*)(c.kscale + c.k0 + 8 * kg + 4);
        c.v[0] *= g0.x; c.v[1] *= g0.y; c.v[2] *= g0.z; c.v[3] *= g0.w; c.v[4] *= g1.x; c.v[5] *= g1.y; c.v[6] *= g1.z; c.v[7] *= g1.w; }
    f32x4 sc = (f32x4){1.f, 1.f, 1.f, 1.f};
    if (c.nscale && c.n < c.Ns) sc = *(const f32x4*)(c.nscale + c.n);
#pragma unroll
    for (int s = 0; s < 4; ++s) { const float q = sc[s];
        u32x4 o; o.x = cvt_pk_bf16(c.v[0][s] * q, c.v[1][s] * q); o.y = cvt_pk_bf16(c.v[2][s] * q, c.v[3][s] * q); o.z = cvt_pk_bf16(c.v[4][s] * q, c.v[5][s] * q); o.w = cvt_pk_bf16(c.v[6][s] * q, c.v[7][s] * q);
        *(u32x4*)(c.dst + (size_t)(4 * ng + s) * c.dld + 8 * kg) = o; }
}
__device__ __forceinline__ void conv_tile(const float* __restrict__ src, int Ks, int Ns, int k0, int n0, bf16_t* __restrict__ dst, int dld, const float* __restrict__ nscale, int lane, const float* __restrict__ kscale = nullptr) {
    ConvT c; conv_tile_load(c, src, Ks, Ns, k0, n0, dst, dld, nscale, lane, kscale); conv_tile_finish(c, lane);
}
__device__ __forceinline__ void conv_plain(const float* src, int Ks, int Ns, int KT, int NT, bf16_t* dst, int dld, int it, int lane, const float* nscale = nullptr, const float* kscale = nullptr) {
    const int kb = it / NT, nb = it % NT;
    conv_tile(src, Ks, Ns, kb * 64, nb * 32, dst + (size_t)(nb * 32) * dld + kb * 64, dld, nscale, lane, kscale);
}
__device__ __forceinline__ void conv_gateup(const float* src, int half, bf16_t* dst, int it, int lane, const float* gain) {
    constexpr int NT = FF / 32; const int kb = it / NT, nb = it % NT, n0 = nb * 32;
    conv_tile(src, D, FF, kb * 64, n0, dst + (size_t)((n0 >> 7) * 256 + half * 128 + (n0 & 127)) * D + kb * 64, D, nullptr, lane, gain);
}

#ifndef EARLY_PCT
#define EARLY_PCT (XR_DN ? 100 : 50)
#endif
#ifndef EARLY2_PCT
#define EARLY2_PCT 100
#endif
constexpr int T_HALF = 3 * (D / 64) * (FF / 32), EARLY_GU = (int)((long long)T_HALF * EARLY_PCT / 100), EARLY_TILES = (int)((long long)T_HALF * EARLY2_PCT / 100);
constexpr int T_HALF0 = 2 * (D / 64) * (FF / 32), EARLY_GU0 = EARLY_GU - (T_HALF - T_HALF0) * 3 / 4;
static_assert(EARLY_GU0 > 0, "first-layer split");
static_assert(EARLY_GU <= EARLY_TILES && EARLY_TILES == T_HALF, "early conversion split: everything not done in the gate/up tail is done in the down tail");
constexpr int QKV_FULL = (M / 256) * (QKVD / 256) % GRID;
constexpr int DN_FULL = 8 * KS_DN;
constexpr int GU_UNITS = (M / 256) * (2 * FF / 256), GU_FULL = GU_UNITS % GRID;
static_assert(GU_FULL > 0, "idle workgroups in the last gate/up round");
__device__ __forceinline__ void conv_ffn_tile(const Frame& F, int l, int which, int r, int LANE) {
    const Args& a = *F.a;
    constexpr int T_GU = (D / 64) * (FF / 32);
    const size_t wo = (size_t)(l * 2 + which) * D * FF; const int wb = (l & 1) * 2 + which;
    bf16_t* wgu = (bf16_t*)(F.ws + WS_WGU + wb * WGU_BYTES); bf16_t* wd = (bf16_t*)(F.ws + WS_WD + wb * WD_BYTES);
    const float* gain = a.in[which == 0 ? I_NF1 : I_NF2] + (size_t)l * D;
    if (r < T_GU) { conv_gateup(a.in[I_WG] + wo, 0, wgu, r, LANE, gain); return; } r -= T_GU;
    if (r < T_GU) { conv_gateup(a.in[I_WU] + wo, 1, wgu, r, LANE, gain); return; } r -= T_GU;
    conv_plain(a.in[I_WDN] + wo, FF, D, FF / 64, D / 32, wd, FF, r, LANE);
}
__device__ __forceinline__ void conv_ffn_tile_load(ConvT& c, const Frame& F, int l, int which, int r, int LANE) {
    const Args& a = *F.a;
    constexpr int T_GU = (D / 64) * (FF / 32), NT = FF / 32;
    const size_t wo = (size_t)(l * 2 + which) * D * FF; const int wb = (l & 1) * 2 + which;
    bf16_t* wgu = (bf16_t*)(F.ws + WS_WGU + wb * WGU_BYTES); bf16_t* wd = (bf16_t*)(F.ws + WS_WD + wb * WD_BYTES);
    const float* gain = a.in[which == 0 ? I_NF1 : I_NF2] + (size_t)l * D;
    if (r < 2 * T_GU) { const int half = r >= T_GU ? 1 : 0; r -= half * T_GU; const int kb = r / NT, nb = r % NT, n0 = nb * 32;
        conv_tile_load(c, a.in[half ? I_WU : I_WG] + wo, D, FF, kb * 64, n0, wgu + (size_t)((n0 >> 7) * 256 + half * 128 + (n0 & 127)) * D + kb * 64, D, nullptr, LANE, gain); return; }
    r -= 2 * T_GU; { const int NTd = D / 32, kb = r / NTd, nb = r % NTd;
        conv_tile_load(c, a.in[I_WDN] + wo, FF, D, kb * 64, nb * 32, wd + (size_t)(nb * 32) * FF + kb * 64, FF, nullptr, LANE, nullptr); }
}
__device__ __forceinline__ void early_convert(const Frame& F, int lnext, int which, int first, int last, int wg0) {
    int tid_ = threadIdx.x; asm volatile("" : "+v"(tid_)); int bid_ = blockIdx.x; asm volatile("" : "+s"(bid_));
    const int LANE = tid_ & 63, WAVE = __builtin_amdgcn_readfirstlane(tid_ >> 6), BID = bid_;
    const int gw = (BID - wg0) * NWAVES + WAVE, NGW = (GRID - wg0) * NWAVES;
    for (int r = first + gw; r < last; r += 2 * NGW) {
        ConvT c0, c1; const bool two = r + NGW < last;
        conv_ffn_tile_load(c0, F, lnext, which, r, LANE);
        if (two) conv_ffn_tile_load(c1, F, lnext, which, r + NGW, LANE);
        conv_tile_finish(c0, LANE);
        if (two) conv_tile_finish(c1, LANE);
    }
}
__device__ __forceinline__ void phase_convert(const Frame& F, int l, int wg0) {
    int tid_ = threadIdx.x; asm volatile("" : "+v"(tid_)); int bid_ = blockIdx.x; asm volatile("" : "+s"(bid_));
    const int TID = tid_, LANE = tid_ & 63, WAVE = __builtin_amdgcn_readfirstlane(tid_ >> 6), BID = bid_; (void)TID; (void)LANE; (void)WAVE; (void)BID;

    const Args& a = *F.a; const int kind = l % 3, j = l / 3;
    if (BID < wg0) return;
    const int gw = (BID - wg0) * NWAVES + WAVE, NGW = (GRID - wg0) * NWAVES;
    constexpr int T_GU = (D / 64) * (FF / 32), T_DN = (FF / 64) * (D / 32);
    const int T_FFN = l == 0 ? T_HALF0 : 0;
    int nmix = 0;
    if (kind == 0) nmix = 4 * (512 / 64) * (512 / 32);
    else if (kind == 1) nmix = (D / 64) * (QKVD / 32) + (D / 64) * (D / 32);
    else nmix = 4 * (D / 64) * (D / 32) + 3 * (D / 64) * (256 / 32) + 3 * (256 / 64) * (D / 32);
    const int total = T_FFN + nmix;
    for (int it = gw; it < total; it += NGW) {
        int r = it;
        if (r < T_FFN) {
            conv_ffn_tile(F, l, 0, r, LANE); continue;
        }
        r -= T_FFN;
        unsigned char* wm = F.ws + (kind == 2 ? WS_WMIX2 : WS_WMIX);
        if (kind == 0) {
            const int g = r / 128; r -= g * 128;
            conv_plain(a.in[I_PW] + ((size_t)(j * 4 + g) * 512) * 512, 512, 512, 8, 16, (bf16_t*)(wm + WM_POOL) + (size_t)g * 512 * 512, 512, r, LANE, a.in[I_PSC] + (size_t)j * D + g * 512);
        } else if (kind == 1) {
            constexpr int T_Q = (D / 64) * (QKVD / 32);
            if (r < T_Q) { conv_plain(a.in[I_AQKV] + (size_t)j * D * QKVD, D, QKVD, D / 64, QKVD / 32, (bf16_t*)(wm + WM_QKV), D, r, LANE, nullptr, a.in[I_NMIX] + (size_t)l * D); continue; } r -= T_Q;
            conv_plain(a.in[I_AWO] + (size_t)j * D * D, D, D, D / 64, D / 32, (bf16_t*)(wm + WM_AO), D, r, LANE);
        } else {
            constexpr int T_SQ = (D / 64) * (D / 32), T_L1 = (D / 64) * (256 / 32), T_L2 = (256 / 64) * (D / 32);
            bf16_t* rw = (bf16_t*)(wm + WM_RW); bf16_t* l2 = (bf16_t*)(wm + WM_L2); bf16_t* ro = (bf16_t*)(wm + WM_RO);
            if (r < T_SQ) { conv_plain(a.in[I_RWR] + (size_t)j * D * D, D, D, D / 64, D / 32, rw, D, r, LANE); continue; } r -= T_SQ;
            if (r < T_SQ) { conv_plain(a.in[I_RWK] + (size_t)j * D * D, D, D, D / 64, D / 32, rw + (size_t)2048 * D, D, r, LANE); continue; } r -= T_SQ;
            if (r < T_SQ) { conv_plain(a.in[I_RWV] + (size_t)j * D * D, D, D, D / 64, D / 32, rw + (size_t)4096 * D, D, r, LANE); continue; } r -= T_SQ;
            if (r < T_SQ) { conv_plain(a.in[I_RWO] + (size_t)j * D * D, D, D, D / 64, D / 32, ro, D, r, LANE); continue; } r -= T_SQ;
            if (r < T_L1) { conv_plain(a.in[I_W1] + (size_t)j * D * 96, D, 96, D / 64, 8, rw + (size_t)6144 * D, D, r, LANE); continue; } r -= T_L1;
            if (r < T_L1) { conv_plain(a.in[I_A1] + (size_t)j * D * 96, D, 96, D / 64, 8, rw + (size_t)6400 * D, D, r, LANE); continue; } r -= T_L1;
            if (r < T_L1) { conv_plain(a.in[I_G1] + (size_t)j * D * 256, D, 256, D / 64, 8, rw + (size_t)6656 * D, D, r, LANE); continue; } r -= T_L1;
            if (r < T_L2) { conv_plain(a.in[I_W2] + (size_t)j * 96 * D, 96, D, 4, D / 32, l2, 256, r, LANE); continue; } r -= T_L2;
            if (r < T_L2) { conv_plain(a.in[I_A2] + (size_t)j * 96 * D, 96, D, 4, D / 32, l2 + (size_t)2048 * 256, 256, r, LANE); continue; } r -= T_L2;
            conv_plain(a.in[I_G2] + (size_t)j * 256 * D, 256, D, 4, D / 32, l2 + (size_t)4096 * 256, 256, r, LANE);
        }
    }
}

struct RowV { f32x4 v[8]; };
__device__ __forceinline__ float row_sumsq(const RowV& r) { float s = 0.f;
#pragma unroll
    for (int jj = 0; jj < 8; ++jj) s += (r.v[jj].x * r.v[jj].x + r.v[jj].y * r.v[jj].y) + (r.v[jj].z * r.v[jj].z + r.v[jj].w * r.v[jj].w);
    return wave_sum(s); }
__device__ __forceinline__ void row_store_x(const Frame& F, int m, const RowV& r, float ss, u64* SSb, int LANE, bool writeX) {
    bf16_t* XR = (bf16_t*)(F.ws + WS_XR);
#pragma unroll
    for (int jj = 0; jj < 8; ++jj) { const size_t off = (size_t)m * D + 4 * (LANE + 64 * jj);
        u32x2 w; w.x = cvt_pk_bf16(r.v[jj].x, r.v[jj].y); w.y = cvt_pk_bf16(r.v[jj].z, r.v[jj].w); *(u32x2*)(XR + off) = w; }
    if (LANE == 0) SSb[m] = (u64)(ss * SS_SCALE);
}
template <int NP> __device__ __forceinline__ float sample_fold_row_t(const Frame& F, int m, RowV& r, int LANE) {
    const float* pp = (const float*)(F.ws + WS_PART) + (size_t)(m - MP) * D;
#pragma unroll
    for (int e = 0; e < 8; ++e) r.v[e] = ld_bf4((const bf16_t*)(F.ws + WS_XR) + (size_t)m * D + 4 * (LANE + 64 * e));
#pragma unroll
    for (int jb = 0; jb < 3; ++jb) {
        f32x4 t[NP > 0 ? NP : 1][3];
#pragma unroll
        for (int p = 0; p < NP; ++p)
#pragma unroll
            for (int e = 0; e < 3; ++e) if (3 * jb + e < 8) t[p][e] = *(const f32x4*)(pp + (size_t)p * 256 * D + 4 * (LANE + 64 * (3 * jb + e)));
#pragma unroll
        for (int p = 0; p < NP; ++p)
#pragma unroll
            for (int e = 0; e < 3; ++e) if (3 * jb + e < 8) r.v[3 * jb + e] += t[p][e];
        asm volatile("" ::: "memory");
    }
    return row_sumsq(r);
}
__device__ __forceinline__ float sample_fold_row(const Frame& F, int m, int nparts, RowV& r, int LANE) {
    if (nparts == 1) return sample_fold_row_t<1>(F, m, r, LANE);
    if (nparts == KS_DN) return sample_fold_row_t<KS_DN>(F, m, r, LANE);
    if (nparts == KS_WO) return sample_fold_row_t<KS_WO>(F, m, r, LANE);
    return sample_fold_row_t<KS_POOL>(F, m, r, LANE);
}
__device__ __forceinline__ void zero_ss(u64* SSb, int TID, int BID) { for (int i = BID * NTHREADS + TID; i < M; i += GRID * NTHREADS) SSb[i] = 0ull; }
#define PH_IDS int tid_ = threadIdx.x; asm volatile("" : "+v"(tid_)); int bid_ = blockIdx.x; asm volatile("" : "+s"(bid_)); \
    const int TID = tid_, LANE = tid_ & 63, WAVE = __builtin_amdgcn_readfirstlane(tid_ >> 6), BID = bid_; (void)TID; (void)LANE; (void)WAVE; (void)BID;
__device__ __forceinline__ u64* ss_buf(const Frame& F, int site) { return (u64*)(F.ws + WS_SS) + (size_t)(site % 3) * M; }

__device__ __forceinline__ void phase_first(const Frame& F) {
    PH_IDS
    const Args& a = *F.a;
    const int gw = BID * NWAVES + WAVE, NGW = gridDim.x * NWAVES;
    for (int m = gw; m < M; m += NGW) {
        const float* src = m < MP ? a.in[I_XP] + (size_t)m * D : a.in[I_XS] + (size_t)(m - MP) * D;
        RowV r;
#pragma unroll
        for (int jj = 0; jj < 8; ++jj) r.v[jj] = *(const f32x4*)(src + 4 * (LANE + 64 * jj));
        const float ss = row_sumsq(r);
        row_store_x(F, m, r, ss, ss_buf(F, 0), LANE, true);
    }
    zero_ss(ss_buf(F, 1), TID, BID);
}
__device__ __forceinline__ void phase_samplefold(const Frame& F, int site, int nparts, bool zero2 = false) {
    PH_IDS
    if (BID < 32) { const int m = MP + BID * 8 + WAVE; RowV r; const float ss = sample_fold_row(F, m, nparts, r, LANE); row_store_x(F, m, r, ss, ss_buf(F, site), LANE, true); }
    zero_ss(ss_buf(F, site + 1), TID, BID);
    if (zero2) zero_ss(ss_buf(F, site + 2), TID, BID);
}
__device__ __forceinline__ void phase_final(const Frame& F, int site, int nparts) {
    PH_IDS
    const Args& a = *F.a;
    const int gw = BID * NWAVES + WAVE, NGW = gridDim.x * NWAVES;
    const u64* SSb = ss_buf(F, site);
    f32x4 g[8];
#pragma unroll
    for (int jj = 0; jj < 8; ++jj) g[jj] = *(const f32x4*)(a.in[I_NFIN] + 4 * (LANE + 64 * jj));
    const bf16_t* XRp = (const bf16_t*)(F.ws + WS_XR);
    if (gw < MS) { const int m = MP + gw; RowV r; const float ss = sample_fold_row(F, m, nparts, r, LANE); const float rstd = 1.0f / sqrtf(ss * (1.0f / D) + RMS_EPS);
#pragma unroll
        for (int jj = 0; jj < 8; ++jj) *(f32x4*)(F.out + (size_t)m * D + 4 * (LANE + 64 * jj)) = r.v[jj] * rstd * g[jj]; }
    static_assert(MP % (GRID * NWAVES) == 0, "prompt rows per wave");
    RowV r; float rstd = ss_rstd(SSb[gw]);
#pragma unroll
    for (int jj = 0; jj < 8; ++jj) r.v[jj] = ld_bf4(XRp + (size_t)gw * D + 4 * (LANE + 64 * jj));
    for (int m = gw; m < MP; m += NGW) {
        RowV rn; float rsn = 0.f; const int mn = m + NGW;
        if (mn < MP) { rsn = ss_rstd(SSb[mn]);
#pragma unroll
            for (int jj = 0; jj < 8; ++jj) rn.v[jj] = ld_bf4(XRp + (size_t)mn * D + 4 * (LANE + 64 * jj)); }
#pragma unroll
        for (int jj = 0; jj < 8; ++jj) *(f32x4*)(F.out + (size_t)m * D + 4 * (LANE + 64 * jj)) = r.v[jj] * rstd * g[jj];
        if (mn < MP) {
#pragma unroll
            for (int jj = 0; jj < 8; ++jj) r.v[jj] = rn.v[jj];
            rstd = rsn; }
    }
}

__device__ __forceinline__ void phase_poolprep(const Frame& F, int l, int site, int nparts) {
    PH_IDS
    const Args& a = *F.a; const int j = l / 3;
    const int gw = BID * NWAVES + WAVE, NGW = gridDim.x * NWAVES;
    const u64* SSb = ss_buf(F, site);
    const float* gain = a.in[I_NMIX] + (size_t)l * D;
    const float* prefix_all = a.in[I_SPOOL] + (size_t)j * 32 * 15 * D;
    f32x4 g[8];
#pragma unroll
    for (int jj = 0; jj < 8; ++jj) g[jj] = *(const f32x4*)(gain + 4 * (LANE + 64 * jj));
    if (BID < 32) {
        const int b = BID, t = WAVE, m = MP + b * 8 + t;
        RowV r; const float ss = sample_fold_row(F, m, nparts, r, LANE); row_store_x(F, m, r, ss, ss_buf(F, site), LANE, true);
        const float rstd = 1.0f / sqrtf(ss * (1.0f / D) + RMS_EPS);
        LAS float* U8 = (LAS float*)F.lds;
#pragma unroll
        for (int jj = 0; jj < 8; ++jj) { r.v[jj] = r.v[jj] * rstd * g[jj]; *(LAS f32x4*)(U8 + t * D + 4 * (LANE + 64 * jj)) = r.v[jj]; }
        __syncthreads();
        const float* pf = prefix_all + (size_t)b * 15 * D;
        float* ps = F.out + O_POOLS + ((size_t)(j * 32 + b) * 15) * D;
#pragma unroll
        for (int jj = 0; jj < 8; ++jj) { const int w = 2 << (jj >> 1); const int col = 4 * (LANE + 64 * jj);
            const f32x4 u = r.v[jj]; f32x4 sacc = u;
            for (int d = 1; d < w; ++d) { const int tt = t - d; sacc += tt >= 0 ? *(const LAS f32x4*)(U8 + tt * D + col) : *(const f32x4*)(pf + (size_t)(15 + tt) * D + col); }
            const f32x4 df = sacc * (1.0f / (float)w) - u;
            u32x2 wv; wv.x = cvt_pk_bf16(df.x, df.y); wv.y = cvt_pk_bf16(df.z, df.w); *(u32x2*)(F.XB + (size_t)m * D + col) = wv;
            *(f32x4*)(ps + (size_t)(7 + t) * D + col) = u;
            if (t < 7) *(f32x4*)(ps + (size_t)t * D + col) = *(const f32x4*)(pf + (size_t)(8 + t) * D + col); }
        __syncthreads();
    }
    {
        LAS f32x4* tile = (LAS f32x4*)F.lds;
        LAS float* rsl = (LAS float*)(F.lds + 47 * 2048);
        for (int rb = BID; rb < MP / 32; rb += gridDim.x) {
            const int m0 = rb * 32, b = m0 >> 12, t0 = m0 & 4095;
            if (TID < 47) { const int t = t0 - 15 + TID; rsl[TID] = t >= 0 ? ss_rstd(SSb[b * SEQ + t]) : 0.f; }
            u32x2 raw[12];
#define PP_LOAD(gi_) do { const int H_ = (2 << (gi_)) - 1, R_ = 32 + H_; _Pragma("unroll") for (int k = 0; k < 12; ++k) { const int idx = TID + k * NTHREADS, r = idx >> 7, c4 = idx & 127, t = t0 - H_ + r; \
                raw[k] = (u32x2){0u, 0u}; if (idx < R_ * 128 && t >= 0) raw[k] = *(const u32x2*)((const bf16_t*)(F.ws + WS_XR) + (size_t)(b * SEQ + t) * D + (gi_) * 512 + 4 * c4); } } while (0)
            PP_LOAD(0);
            __syncthreads();
#pragma unroll 1
            for (int gi = 0; gi < 4; ++gi) {
                const int w = 2 << gi, H = w - 1, R = 32 + H;
#pragma unroll
                for (int k = 0; k < 12; ++k) { const int idx = TID + k * NTHREADS, r = idx >> 7;
                    if (idx < R * 128) tile[idx] = (f32x4){__uint_as_float(raw[k].x << 16), __uint_as_float(raw[k].x & 0xffff0000u), __uint_as_float(raw[k].y << 16), __uint_as_float(raw[k].y & 0xffff0000u)} * rsl[15 - H + r]; }
                __syncthreads();
                if (gi < 3) PP_LOAD(gi + 1);
                { const int c4 = TID & 127, rq = TID >> 7, col = gi * 512 + 4 * c4;
                  const f32x4 gv = *(const f32x4*)(gain + col);
                  f32x4 sacc = (f32x4){0.f, 0.f, 0.f, 0.f};
                  for (int d = 0; d < H; ++d) sacc += tile[(rq * 8 + d) * 128 + c4];
#pragma unroll
                  for (int rr = 0; rr < 8; ++rr) { const int r = rq * 8 + rr + H, t = t0 + rq * 8 + rr, m = m0 + rq * 8 + rr;
                      const f32x4 u = tile[r * 128 + c4];
                      sacc += u;
                      const int cnt = t + 1 < w ? t + 1 : w;
                      const f32x4 ug = u * gv, df = sacc * gv * (1.0f / (float)cnt) - ug;
                      u32x2 wv; wv.x = cvt_pk_bf16(df.x, df.y); wv.y = cvt_pk_bf16(df.z, df.w); *(u32x2*)(F.XB + (size_t)m * D + col) = wv;
                      if (t >= SEQ - 15) *(f32x4*)(F.out + O_POOLP + ((size_t)(j * 2 + b) * 15 + (t - (SEQ - 15))) * D + col) = ug;
                      sacc -= tile[(r - H) * 128 + c4]; } }
                __syncthreads();
            }
#undef PP_LOAD
        }
    }
    zero_ss(ss_buf(F, site + 1), TID, BID); zero_ss(ss_buf(F, site + 2), TID, BID);
}

__device__ __forceinline__ void rwkv_mix_store(const Frame& F, int m, int col, const f32x4& u, const f32x4& p, const float* mu) {
    bf16_t* mix6 = (bf16_t*)(F.ws + WS_MIX6);
    const f32x4 dx = p - u;
#pragma unroll
    for (int s = 0; s < 6; ++s) { const int mi = s == 0 ? 0 : s == 1 ? 2 : s == 2 ? 3 : s == 3 ? 1 : s;
        const f32x4 o = u + dx * *(const f32x4*)(mu + (size_t)mi * D + col);
        u32x2 wv; wv.x = cvt_pk_bf16(o.x, o.y); wv.y = cvt_pk_bf16(o.z, o.w); *(u32x2*)(mix6 + (size_t)s * MIXS + (size_t)m * D + col) = wv; }
}
__device__ __forceinline__ void phase_rwkvmix(const Frame& F, int l, int site, int nparts) {
    PH_IDS
    const Args& a = *F.a; const int j = l / 3;
    const int gw = BID * NWAVES + WAVE, NGW = gridDim.x * NWAVES;
    const u64* SSb = ss_buf(F, site);
    const float* gain = a.in[I_NMIX] + (size_t)l * D;
    const float* mu = a.in[I_MU] + (size_t)j * 6 * D;
    f32x4 g[8];
#pragma unroll
    for (int jj = 0; jj < 8; ++jj) g[jj] = *(const f32x4*)(gain + 4 * (LANE + 64 * jj));
    if (BID < 32) {
        const int b = BID, t = WAVE, m = MP + b * 8 + t;
        RowV r; const float ss = sample_fold_row(F, m, nparts, r, LANE); row_store_x(F, m, r, ss, ss_buf(F, site), LANE, true);
        const float rstd = 1.0f / sqrtf(ss * (1.0f / D) + RMS_EPS);
        LAS float* U8 = (LAS float*)F.lds;
#pragma unroll
        for (int jj = 0; jj < 8; ++jj) { r.v[jj] = r.v[jj] * rstd * g[jj]; *(LAS f32x4*)(U8 + t * D + 4 * (LANE + 64 * jj)) = r.v[jj]; }
        __syncthreads();
#pragma unroll
        for (int jj = 0; jj < 8; ++jj) { const int col = 4 * (LANE + 64 * jj);
            const f32x4 p = t > 0 ? *(const LAS f32x4*)(U8 + (t - 1) * D + col) : *(const f32x4*)(a.in[I_SSHIFT] + ((size_t)j * 32 + b) * D + col);
            rwkv_mix_store(F, m, col, r.v[jj], p, mu);
            if (t == 7) *(f32x4*)(F.out + O_SHS + ((size_t)j * 32 + b) * D + col) = r.v[jj]; }
        __syncthreads();
    }
    for (int rb = BID; rb < MP / 32; rb += gridDim.x) {
        const int half = WAVE >> 2, wq = WAVE & 3, col = 8 * (LANE + 64 * wq);
        const int m0 = rb * 32 + 16 * half, b = m0 >> 12, t0 = m0 & 4095;
        bf16_t* mix6 = (bf16_t*)(F.ws + WS_MIX6); const bf16_t* XRp = (const bf16_t*)(F.ws + WS_XR);
        f32x4 mu6[6][2];
#pragma unroll
        for (int s6 = 0; s6 < 6; ++s6) { const int mi = s6 == 0 ? 0 : s6 == 1 ? 2 : s6 == 2 ? 3 : s6 == 3 ? 1 : s6; mu6[s6][0] = *(const f32x4*)(mu + (size_t)mi * D + col); mu6[s6][1] = *(const f32x4*)(mu + (size_t)mi * D + col + 4); }
        const f32x4 gv0 = *(const f32x4*)(gain + col), gv1 = *(const f32x4*)(gain + col + 4);
#define RM_UNPACK(w_, lo_, hi_) do { lo_ = (f32x4){__uint_as_float((w_).x << 16), __uint_as_float((w_).x & 0xffff0000u), __uint_as_float((w_).y << 16), __uint_as_float((w_).y & 0xffff0000u)}; \
        hi_ = (f32x4){__uint_as_float((w_).z << 16), __uint_as_float((w_).z & 0xffff0000u), __uint_as_float((w_).w << 16), __uint_as_float((w_).w & 0xffff0000u)}; } while (0)
        u32x4 raw[16]; float rs[16]; u32x4 rawp = (u32x4){0u, 0u, 0u, 0u}; float rsp = 0.f;
        if (t0 > 0) { rawp = *(const u32x4*)(XRp + (size_t)(m0 - 1) * D + col); rsp = ss_rstd(SSb[m0 - 1]); }
#pragma unroll
        for (int q = 0; q < 16; ++q) { raw[q] = *(const u32x4*)(XRp + (size_t)(m0 + q) * D + col); rs[q] = ss_rstd(SSb[m0 + q]); }
        f32x4 p0, p1; RM_UNPACK(rawp, p0, p1); p0 = p0 * rsp * gv0; p1 = p1 * rsp * gv1;
#pragma unroll
        for (int q = 0; q < 16; ++q) { const int m = m0 + q;
            f32x4 u0, u1; RM_UNPACK(raw[q], u0, u1); u0 = u0 * rs[q] * gv0; u1 = u1 * rs[q] * gv1;
            const f32x4 d0 = p0 - u0, d1 = p1 - u1;
#pragma unroll
            for (int s6 = 0; s6 < 6; ++s6) { const f32x4 o0 = u0 + d0 * mu6[s6][0], o1 = u1 + d1 * mu6[s6][1];
                u32x4 wv; wv.x = cvt_pk_bf16(o0.x, o0.y); wv.y = cvt_pk_bf16(o0.z, o0.w); wv.z = cvt_pk_bf16(o1.x, o1.y); wv.w = cvt_pk_bf16(o1.z, o1.w); *(u32x4*)(mix6 + (size_t)s6 * MIXS + (size_t)m * D + col) = wv; }
            if (t0 + q == SEQ - 1) { float* so = F.out + O_SHP + ((size_t)j * 2 + b) * D + col; *(f32x4*)so = u0; *(f32x4*)(so + 4) = u1; }
            p0 = u0; p1 = u1; }
#undef RM_UNPACK
    }
    zero_ss(ss_buf(F, site + 1), TID, BID); zero_ss(ss_buf(F, site + 2), TID, BID);
}

#ifndef GEMM_ALIGN
#define GEMM_ALIGN true
#endif
#ifndef GEMM_SP2
#define GEMM_SP2 true
#endif
constexpr int AT_KP = 144, AT_VP = 560, AT_PP = 336;
constexpr int AT_K = 0, AT_V = AT_K + 256 * AT_KP, AT_P = AT_V + 64 * AT_VP, AT_B = AT_P + 8 * 16 * AT_PP, AT_END = AT_B + 8 * 128 * 4;
static_assert(AT_END <= RING_BYTES, "attention LDS");
__device__ __forceinline__ void phase_attn(const Frame& F, int j) {
    int tid_ = threadIdx.x; asm volatile("" : "+v"(tid_)); int bid_ = blockIdx.x; asm volatile("" : "+s"(bid_));
    const int TID = tid_, LANE = tid_ & 63, WAVE = __builtin_amdgcn_readfirstlane(tid_ >> 6), BID = bid_; (void)TID; (void)LANE; (void)WAVE; (void)BID;

    const Args& a = *F.a;
    const bf16_t* QKV = (const bf16_t*)(F.ws + WS_QKV);
    LAS unsigned char* lds = F.lds;
    const int lane = LANE, g = WAVE, fr = lane & 15, fq = lane >> 4;
    for (int unit = BID; unit < 256 + 128; unit += gridDim.x) {
        const bool samp = unit >= 256;
        int b, kvh, qblk;
        if (!samp) { b = unit >> 7; kvh = (unit >> 5) & 3; qblk = unit & 31; } else { b = (unit - 256) >> 2; kvh = (unit - 256) & 3; qblk = 1; }
        __syncthreads();
        for (int i = TID; i < 8 * 128; i += NTHREADS) { const int gg = i >> 7, dist = i & 127;
            int bk = dist; if (dist >= 16) { bk = 16 + (int)(logf((float)dist * (1.0f / 16.0f)) / 2.0794415416798357f * 16.0f); bk = bk > 31 ? 31 : bk; }
            ((LAS float*)(lds + AT_B))[i] = a.in[I_RELB][bk * 32 + kvh * 8 + gg]; }
        static_assert(256 * 8 == 4 * NTHREADS, "K/V staging pieces per thread");
#pragma unroll 1
        for (int ih = 0; ih < 2; ++ih) {
        u32x4 kva[2], vva[2];
        if (!samp) {
#pragma unroll
            for (int it = 0; it < 2; ++it) { const int i = TID + (2 * ih + it) * NTHREADS, key = i >> 3, c8 = i & 7, pos = qblk * 128 - 128 + key;
                kva[it] = (u32x4){0u, 0u, 0u, 0u}; vva[it] = kva[it];
                if (pos >= 0) { const bf16_t* rp = QKV + (size_t)(b * SEQ + pos) * QKVD + D + kvh * 64 + c8 * 8; kva[it] = *(const u32x4*)rp; vva[it] = *(const u32x4*)(rp + 256); } } }
#pragma unroll
        for (int it = 0; it < 2; ++it) { const int i = TID + (2 * ih + it) * NTHREADS; const int key = i >> 3, c8 = i & 7;
            u32x4 kv = (u32x4){0u, 0u, 0u, 0u}, vv = kv;
            if (!samp) { const int pos = qblk * 128 - 128 + key;
                if (pos >= 0) { kv = kva[it]; vv = vva[it];
                    if (qblk == 31 && key >= 128) {
                        float* ok = F.out + O_WKP + (((size_t)(j * 2 + b) * 128 + (key - 128)) * 4 + kvh) * 64 + c8 * 8; float* ov = F.out + O_WVP + (ok - (F.out + O_WKP));
                        *(f32x4*)ok = (f32x4){bf2f(kv.x & 0xffff), bf2f(kv.x >> 16), bf2f(kv.y & 0xffff), bf2f(kv.y >> 16)}; *(f32x4*)(ok + 4) = (f32x4){bf2f(kv.z & 0xffff), bf2f(kv.z >> 16), bf2f(kv.w & 0xffff), bf2f(kv.w >> 16)};
                        *(f32x4*)ov = (f32x4){bf2f(vv.x & 0xffff), bf2f(vv.x >> 16), bf2f(vv.y & 0xffff), bf2f(vv.y >> 16)}; *(f32x4*)(ov + 4) = (f32x4){bf2f(vv.z & 0xffff), bf2f(vv.z >> 16), bf2f(vv.w & 0xffff), bf2f(vv.w >> 16)}; } } }
            else if (key < 136) {
                f32x4 k0, k1, v0, v1;
                if (key < 128) { const size_t o = (((size_t)(j * 32 + b) * 128 + key) * 4 + kvh) * 64 + c8 * 8;
                    k0 = *(const f32x4*)(a.in[I_CK] + o); k1 = *(const f32x4*)(a.in[I_CK] + o + 4); v0 = *(const f32x4*)(a.in[I_CV] + o); v1 = *(const f32x4*)(a.in[I_CV] + o + 4);
                    kv.x = cvt_pk_bf16(k0.x, k0.y); kv.y = cvt_pk_bf16(k0.z, k0.w); kv.z = cvt_pk_bf16(k1.x, k1.y); kv.w = cvt_pk_bf16(k1.z, k1.w);
                    vv.x = cvt_pk_bf16(v0.x, v0.y); vv.y = cvt_pk_bf16(v0.z, v0.w); vv.z = cvt_pk_bf16(v1.x, v1.y); vv.w = cvt_pk_bf16(v1.z, v1.w); }
                else { const bf16_t* rp = QKV + (size_t)(MP + b * 8 + (key - 128)) * QKVD + D + kvh * 64 + c8 * 8; kv = *(const u32x4*)rp; vv = *(const u32x4*)(rp + 256);
                    k0 = (f32x4){bf2f(kv.x & 0xffff), bf2f(kv.x >> 16), bf2f(kv.y & 0xffff), bf2f(kv.y >> 16)}; k1 = (f32x4){bf2f(kv.z & 0xffff), bf2f(kv.z >> 16), bf2f(kv.w & 0xffff), bf2f(kv.w >> 16)};
                    v0 = (f32x4){bf2f(vv.x & 0xffff), bf2f(vv.x >> 16), bf2f(vv.y & 0xffff), bf2f(vv.y >> 16)}; v1 = (f32x4){bf2f(vv.z & 0xffff), bf2f(vv.z >> 16), bf2f(vv.w & 0xffff), bf2f(vv.w >> 16)}; }
                if (key >= 8) { const size_t o = (((size_t)(j * 32 + b) * 128 + (key - 8)) * 4 + kvh) * 64 + c8 * 8;
                    *(f32x4*)(F.out + O_WKS + o) = k0; *(f32x4*)(F.out + O_WKS + o + 4) = k1; *(f32x4*)(F.out + O_WVS + o) = v0; *(f32x4*)(F.out + O_WVS + o + 4) = v1; }
            }
            *(LAS u32x4*)(lds + AT_K + key * AT_KP + c8 * 16) = kv;
            const unsigned vw[4] = {vv.x, vv.y, vv.z, vv.w};
#pragma unroll
            for (int e = 0; e < 8; ++e) *(LAS unsigned short*)(lds + AT_V + (c8 * 8 + e) * AT_VP + key * 2) = (unsigned short)(e & 1 ? vw[e >> 1] >> 16 : vw[e >> 1] & 0xffff);
        }
        }
        for (int i = TID; i < 64 * 24; i += NTHREADS) { const int dd = i / 24, kk = 256 + i % 24; *(LAS unsigned short*)(lds + AT_V + dd * AT_VP + kk * 2) = 0; }
        __syncthreads();
        const int hq = kvh * 8 + g;
        const float sink = a.in[I_SINK][j * 32 + hq];
        const LAS float* tbl = (const LAS float*)(lds + AT_B) + g * 128;
        LAS unsigned char* Pw = lds + AT_P + g * 16 * AT_PP;
        const int nqt = samp ? 1 : 8;
        for (int qt = 0; qt < nqt; ++qt) {
            int qrow; if (!samp) qrow = b * SEQ + qblk * 128 + qt * 16 + fr; else qrow = MP + b * 8 + (fr & 7);
            const bf16_t* qp = QKV + (size_t)qrow * QKVD + hq * 64 + fq * 8;
            const bf16x8 q0 = *(const bf16x8*)qp, q1 = *(const bf16x8*)(qp + 32);
            const int kb = 16 * qt;
            f32x4 sacc[9];
#pragma unroll
            for (int kt = 0; kt < 9; ++kt) { sacc[kt] = (f32x4){0.f, 0.f, 0.f, 0.f};
                const LAS unsigned char* kp = lds + AT_K + (kb + kt * 16 + fr) * AT_KP + fq * 16;
                const bf16x8 k0 = *(const LAS bf16x8*)kp, k1 = *(const LAS bf16x8*)(kp + 64);
                sacc[kt] = __builtin_amdgcn_mfma_f32_16x16x32_bf16(q0, k0, sacc[kt], 0, 0, 0);
                sacc[kt] = __builtin_amdgcn_mfma_f32_16x16x32_bf16(q1, k1, sacc[kt], 0, 0, 0); }
            float mx[4] = {-1e30f, -1e30f, -1e30f, -1e30f};
#pragma unroll
            for (int kt = 0; kt < 9; ++kt)
#pragma unroll
                for (int jj = 0; jj < 4; ++jj) { const int qi = qt * 16 + 4 * fq + jj, kj = kb + kt * 16 + fr, dist = qi + 128 - kj;
                    const bool valid = dist >= 0 && dist < 128 && (samp || qblk > 0 || kj >= 128);
                    const float s = valid ? sacc[kt][jj] * 0.125f + tbl[dist & 127] : -1e30f;
                    sacc[kt][jj] = s; mx[jj] = fmaxf(mx[jj], s); }
            float sm[4];
#pragma unroll
            for (int jj = 0; jj < 4; ++jj) { mx[jj] = fmaxf(row16_max(mx[jj]), sink); sm[jj] = 0.f; }
#pragma unroll
            for (int kt = 0; kt < 9; ++kt)
#pragma unroll
                for (int jj = 0; jj < 4; ++jj) { const float p = fast_exp(sacc[kt][jj] - mx[jj]); sm[jj] += p;
                    *(LAS unsigned short*)(Pw + (4 * fq + jj) * AT_PP + (kt * 16 + fr) * 2) = (unsigned short)(cvt_pk_bf16(p, 0.f) & 0xffff); }
#pragma unroll
            for (int jj = 0; jj < 4; ++jj) { *(LAS unsigned short*)(Pw + (4 * fq + jj) * AT_PP + (144 + fr) * 2) = 0; sm[jj] = row16_sum(sm[jj]) + fast_exp(sink - mx[jj]); }
            asm volatile("s_waitcnt lgkmcnt(0)" ::: "memory");
            f32x4 oacc[4];
#pragma unroll
            for (int dt = 0; dt < 4; ++dt) oacc[dt] = (f32x4){0.f, 0.f, 0.f, 0.f};
#pragma unroll
            for (int ks = 0; ks < 5; ++ks) { const bf16x8 pf = *(const LAS bf16x8*)(Pw + fr * AT_PP + (ks * 32 + fq * 8) * 2);
#pragma unroll
                for (int dt = 0; dt < 4; ++dt) { const bf16x8 vf = *(const LAS bf16x8*)(lds + AT_V + (dt * 16 + fr) * AT_VP + (kb + ks * 32 + fq * 8) * 2);
                    oacc[dt] = __builtin_amdgcn_mfma_f32_16x16x32_bf16(pf, vf, oacc[dt], 0, 0, 0); } }
#pragma unroll
            for (int jj = 0; jj < 4; ++jj) { const float inv = 1.0f / sm[jj]; const int ql = 4 * fq + jj;
                int orow; bool ok = true; if (!samp) orow = b * SEQ + qblk * 128 + qt * 16 + ql; else { orow = MP + b * 8 + (ql & 7); ok = ql < 8; }
                if (ok) {
#pragma unroll
                    for (int dt = 0; dt < 4; ++dt) F.XB[(size_t)orow * D + hq * 64 + dt * 16 + fr] = (bf16_t)(cvt_pk_bf16(oacc[dt][jj] * inv, 0.f) & 0xffff); } }
            asm volatile("s_waitcnt lgkmcnt(0)" ::: "memory");
        }
    }
}

constexpr int SC_TS = 32, SC_VEC = 0, SC_VQ = 5 * SC_TS * 64 * 4, SC_SC = SC_VQ + SC_TS * 16 * 4, SC_BUF = SC_SC + (SC_TS + 1) * 4 * 4 + 64;
static_assert(2 * SC_BUF <= RING_BYTES && SC_BUF % 16 == 0, "scan LDS");
struct ScanChunk { int m0, n, h, q; bool first, last, samp; int b; };
__device__ __forceinline__ ScanChunk scan_chunk(int ci, int w) {
    ScanChunk c;
    if (ci < 128) { const int pc = w & 63; c.b = pc >> 5; c.h = pc & 31; c.q = w >> 6; c.m0 = c.b * SEQ + ci * SC_TS; c.n = SC_TS; c.first = ci == 0; c.last = ci == 127; c.samp = false; }
    else { const int sc = (ci - 128) * 64 + (w & 63); c.q = w >> 6; c.b = sc >> 5; c.h = sc & 31; c.m0 = MP + c.b * 8; c.n = 8; c.first = true; c.last = true; c.samp = true; }
    return c;
}
struct ScanRegs { f32x4 r[2], k[2], w[2], a[2], v; };
template <int CTRL> __device__ __forceinline__ float dpp_t(float x) { return __int_as_float(__builtin_amdgcn_update_dpp(0, __float_as_int(x), CTRL, 0xf, 0xf, false)); }
__device__ __forceinline__ float oct_sum(float x) { x += dpp_t<0xB1>(x); x += dpp_t<0x4E>(x); x += dpp_t<0x141>(x); return x; }
__device__ __forceinline__ void scan_issue(const Frame& F, const ScanChunk& c, ScanRegs& g, const int ptid) {
    const bf16_t* R = (const bf16_t*)(F.ws + WS_RKV); const bf16_t* Kx = R + (size_t)M * D; const bf16_t* V = Kx + (size_t)M * D;
    const float* DEC = (const float*)(F.ws + WS_LUP); const float* AIC = DEC + (size_t)M * D;
    const int s = ptid >> 3, cg = ptid & 7;
    if (s < c.n) { const size_t base = (size_t)(c.m0 + s) * D + c.h * 64 + cg * 8;
#pragma unroll
        for (int e = 0; e < 2; ++e) { g.r[e] = ld_bf4(R + base + 4 * e); g.k[e] = ld_bf4(Kx + base + 4 * e); g.w[e] = *(const f32x4*)(DEC + base + 4 * e); g.a[e] = *(const f32x4*)(AIC + base + 4 * e); }
        g.v = ld_bf4(V + (size_t)(c.m0 + s) * D + c.h * 64 + c.q * 16 + (cg & 3) * 4); }
}
__device__ __forceinline__ void scan_derive(const Frame& F, const ScanChunk& c, const ScanRegs& g, LAS unsigned char* buf, int j, const int ptid) {
    const Args& a = *F.a;
    float* BON = (float*)(F.ws + WS_BONUS);
    const int s = ptid >> 3, cg = ptid & 7;
    if (s < c.n) {
        const size_t pc = (size_t)j * D + c.h * 64 + cg * 8;
        float n2 = 0.f, sbr = 0.f, kr = 0.f, bon = 0.f;
        LAS float* vec = (LAS float*)(buf + SC_VEC) + s * 64 + cg * 8;
#pragma unroll
        for (int e = 0; e < 2; ++e) {
            const f32x4 k_k = *(const f32x4*)(a.in[I_KK] + pc + 4 * e), k_a = *(const f32x4*)(a.in[I_KA] + pc + 4 * e), r_k = *(const f32x4*)(a.in[I_RK] + pc + 4 * e);
            const f32x4 r = g.r[e], k = g.k[e], w = g.w[e], ai = g.a[e];
            const f32x4 kk = k * k_k, km = k * ((ai - 1.0f) * k_a + 1.0f), bb = kk * ai, wr = w * r;
            const f32x4 t0 = kk * kk, t1 = bb * r, t2 = km * r, t3 = t2 * r_k;
            n2 += (t0.x + t0.y) + (t0.z + t0.w); sbr += (t1.x + t1.y) + (t1.z + t1.w); kr += (t2.x + t2.y) + (t2.z + t2.w); bon += (t3.x + t3.y) + (t3.z + t3.w);
            *(LAS f32x4*)(vec + (0 * SC_TS) * 64 + 4 * e) = kk; *(LAS f32x4*)(vec + (1 * SC_TS) * 64 + 4 * e) = wr; *(LAS f32x4*)(vec + (2 * SC_TS) * 64 + 4 * e) = w;
            *(LAS f32x4*)(vec + (3 * SC_TS) * 64 + 4 * e) = bb; *(LAS f32x4*)(vec + (4 * SC_TS) * 64 + 4 * e) = km;
        }
        n2 = oct_sum(n2); sbr = oct_sum(sbr); kr = oct_sum(kr); bon = oct_sum(bon);
        if (cg < 4) *(LAS f32x4*)((LAS float*)(buf + SC_VQ) + s * 16 + cg * 4) = g.v;
        if (cg == 0) { *(LAS f32x4*)((LAS float*)(buf + SC_SC) + s * 4) = (f32x4){1.0f / fmaxf(n2, 1e-24f), sbr, kr, 0.f}; if (c.q == 0) BON[(size_t)(c.m0 + s) * 32 + c.h] = bon; }
    }
}
__device__ __forceinline__ void phase_scan(const Frame& F, int j) {
    int tid_ = threadIdx.x; asm volatile("" : "+v"(tid_)); int bid_ = blockIdx.x; asm volatile("" : "+s"(bid_));
    const int LANE = tid_ & 63, WAVE = __builtin_amdgcn_readfirstlane(tid_ >> 6), BID = bid_;
    const Args& a = *F.a;
    float* Y = (float*)(F.ws + WS_Y);
    const int w = BID, lane = LANE, wave = WAVE, rg = lane >> 4, c4 = lane & 15;
    constexpr int CI0 = 128, NCH = 128 + 16;
    __syncthreads();
    if (wave >= 4) {
        const int ptid = tid_ - 256;
        ScanRegs ga, gb;
        { const ScanChunk c0 = scan_chunk(CI0, w); scan_issue(F, c0, ga, ptid); scan_derive(F, c0, ga, F.lds + (CI0 & 1) * SC_BUF, j, ptid); }
        { const ScanChunk c1 = scan_chunk(CI0 + 1, w); scan_issue(F, c1, ga, ptid); }
        __syncthreads();
        for (int ci = CI0; ci < NCH; ++ci) {
            if (ci + 2 < NCH) { const ScanChunk c2 = scan_chunk(ci + 2, w); scan_issue(F, c2, gb, ptid); }
            asm volatile("" ::: "memory");
            if (ci + 1 < NCH) { const ScanChunk c1 = scan_chunk(ci + 1, w); scan_derive(F, c1, ga, F.lds + ((ci + 1) & 1) * SC_BUF, j, ptid); }
            ga = gb;
            __syncthreads();
        }
    } else {
        const float* SW = a.in[I_SWKV] + (size_t)j * 32 * 32 * 4096;
        f32x4 Sn;
        { const ScanChunk c0 = scan_chunk(CI0, w); Sn = *(const f32x4*)(SW + (((size_t)c0.b * 32 + c0.h) * 64 + c0.q * 16 + wave * 4 + rg) * 64 + 4 * c4); }
        __syncthreads();
        f32x4 S = (f32x4){0.f, 0.f, 0.f, 0.f};
        for (int ci = CI0; ci < NCH; ++ci) {
            LAS unsigned char* buf = F.lds + (ci & 1) * SC_BUF;
            const ScanChunk c = scan_chunk(ci, w);
            const int row = c.q * 16 + wave * 4 + rg;
            const size_t soff = (((size_t)c.b * 32 + c.h) * 64 + row) * 64 + 4 * c4;
            if (c.first) { if (c.samp) S = Sn; else S = (f32x4){0.f, 0.f, 0.f, 0.f}; }
            if (ci + 1 < NCH) { const ScanChunk cn = scan_chunk(ci + 1, w); if (cn.samp) Sn = *(const f32x4*)(SW + (((size_t)cn.b * 32 + cn.h) * 64 + cn.q * 16 + wave * 4 + rg) * 64 + 4 * c4); }
            const LAS float* vec = (const LAS float*)(buf + SC_VEC) + 4 * c4; const LAS float* vq = (const LAS float*)(buf + SC_VQ) + wave * 4 + rg; const LAS float* scl = (const LAS float*)(buf + SC_SC);
            float* yp = Y + (size_t)(c.m0 + c4) * D + c.h * 64 + row;
            float ycap = 0.f;
            f32x4 Akk, Awr, Awd, Abb, Akm, Asc, Bkk, Bwr, Bwd, Bbb, Bkm, Bsc; float Avv, Bvv;
#define SC_LOAD(P, s_) do { P##kk = *(const LAS f32x4*)(vec + (0 * SC_TS + (s_)) * 64); P##wr = *(const LAS f32x4*)(vec + (1 * SC_TS + (s_)) * 64); P##wd = *(const LAS f32x4*)(vec + (2 * SC_TS + (s_)) * 64); \
        P##bb = *(const LAS f32x4*)(vec + (3 * SC_TS + (s_)) * 64); P##km = *(const LAS f32x4*)(vec + (4 * SC_TS + (s_)) * 64); P##sc = *(const LAS f32x4*)(scl + (s_) * 4); P##vv = vq[(s_) * 16]; } while (0)
#define SC_STEP(P, s_) do { float p = (S.x * P##kk.x + S.y * P##kk.y) + (S.z * P##kk.z + S.w * P##kk.w); float qv = (S.x * P##wr.x + S.y * P##wr.y) + (S.z * P##wr.z + S.w * P##wr.w); \
        p = row16_sum(p); qv = row16_sum(qv); const float sa2 = -P##sc.x * p; const float y = qv + sa2 * P##sc.y + P##vv * P##sc.z; \
        S = S * P##wd + P##bb * sa2 + P##km * P##vv; ycap = (((s_) & 15) == c4) ? y : ycap; } while (0)
            SC_LOAD(A, 0);
            for (int s = 0; s < c.n; s += 2) {
                SC_LOAD(B, s + 1);
                SC_STEP(A, s);
                SC_LOAD(A, s + 2);
                SC_STEP(B, s + 1);
                if (((s + 2) & 15) == 0 || s + 2 == c.n) { if (c4 < ((c.n < 16) ? c.n : 16)) yp[(size_t)((s + 2 - 1) & ~15) * D] = ycap; }
            }
#undef SC_LOAD
#undef SC_STEP
            if (c.last) { float* fo = F.out + (c.samp ? O_WKVS : O_WKVP) + soff; *(f32x4*)fo = S; }
            __syncthreads();
        }
    }
}

constexpr int CK_OPP = 144, CK_SLOT = 64 * CK_OPP, CK_FP = 65, CK_F0 = 14 * CK_SLOT, CK_F1 = CK_F0 + 64 * CK_FP * 4, CK_END = CK_F1 + 64 * CK_FP * 4;
static_assert(CK_END <= MISC_OFF, "chunk-scan LDS");
__device__ __forceinline__ void ck_mm(LAS unsigned char* lds, int aslot, int bslot, int rt, int ct0, int l15, int quad, f32x4 (&acc)[2]) {
    const LAS unsigned char* ap = lds + aslot * CK_SLOT + (rt * 16 + l15) * CK_OPP + quad * 16;
    const bf16x8 a0 = *(const LAS bf16x8*)ap, a1 = *(const LAS bf16x8*)(ap + 64);
#pragma unroll
    for (int cc = 0; cc < 2; ++cc) { const LAS unsigned char* bp = lds + bslot * CK_SLOT + ((ct0 + cc) * 16 + l15) * CK_OPP + quad * 16;
        const bf16x8 b0 = *(const LAS bf16x8*)bp, b1 = *(const LAS bf16x8*)(bp + 64);
        acc[cc] = __builtin_amdgcn_mfma_f32_16x16x32_bf16(a0, b0, acc[cc], 0, 0, 0);
        acc[cc] = __builtin_amdgcn_mfma_f32_16x16x32_bf16(a1, b1, acc[cc], 0, 0, 0); }
}
__device__ __forceinline__ void ck_mm_t(LAS unsigned char* lds, int aslot, int bslot, int rt, int ct0, int l15, int quad, f32x4 (&acc)[2]) {
    const LAS unsigned char* ap = lds + aslot * CK_SLOT + (rt * 16 + l15) * CK_OPP + quad * 16;
    const bf16x8 a0 = *(const LAS bf16x8*)ap, a1 = *(const LAS bf16x8*)(ap + 64);
#pragma unroll
    for (int cc = 0; cc < 2; ++cc) { const LAS unsigned char* bp = lds + bslot * CK_SLOT + ((ct0 + cc) * 16 + l15) * CK_OPP + quad * 16;
        const bf16x8 b0 = *(const LAS bf16x8*)bp, b1 = *(const LAS bf16x8*)(bp + 64);
        acc[cc] = __builtin_amdgcn_mfma_f32_16x16x32_bf16(b0, a0, acc[cc], 0, 0, 0);
        acc[cc] = __builtin_amdgcn_mfma_f32_16x16x32_bf16(b1, a1, acc[cc], 0, 0, 0); }
}
__device__ __forceinline__ void ck_st_rm(LAS unsigned char* lds, int slot, int rt, int ct, int l15, int quad, const f32x4& v) {
#pragma unroll
    for (int g = 0; g < 4; ++g) *(LAS unsigned short*)(lds + slot * CK_SLOT + (rt * 16 + quad * 4 + g) * CK_OPP + (ct * 16 + l15) * 2) = (unsigned short)(cvt_pk_bf16(v[g], 0.f) & 0xffffu);
}
__device__ __forceinline__ void ck_st_tr(LAS unsigned char* lds, int slot, int rt, int ct, int l15, int quad, const f32x4& v) {
    u32x2 w; w.x = cvt_pk_bf16(v[0], v[1]); w.y = cvt_pk_bf16(v[2], v[3]);
    *(LAS u32x2*)(lds + slot * CK_SLOT + (ct * 16 + l15) * CK_OPP + (rt * 16 + quad * 4) * 2) = w;
}
__device__ __forceinline__ void ck_st_rm_t(LAS unsigned char* lds, int slot, int rt, int ct, int l15, int quad, const f32x4& v) {
    u32x2 w; w.x = cvt_pk_bf16(v[0], v[1]); w.y = cvt_pk_bf16(v[2], v[3]);
    *(LAS u32x2*)(lds + slot * CK_SLOT + (rt * 16 + l15) * CK_OPP + (ct * 16 + quad * 4) * 2) = w;
}
#define CK_BAR() do { asm volatile("s_waitcnt lgkmcnt(0)" ::: "memory"); __builtin_amdgcn_s_barrier(); asm volatile("" ::: "memory"); } while (0)
__device__ __forceinline__ void phase_ck1(const Frame& F, int j) {
    int tid_ = threadIdx.x; asm volatile("" : "+v"(tid_)); int bid_ = blockIdx.x; asm volatile("" : "+s"(bid_));
    const int TID = tid_, LANE = tid_ & 63, WAVE = __builtin_amdgcn_readfirstlane(tid_ >> 6), BID = bid_;
    const Args& a = *F.a;
    LAS unsigned char* lds = F.lds;
    const bf16_t* R = (const bf16_t*)(F.ws + WS_RKV); const bf16_t* Kx = R + (size_t)M * D; const bf16_t* V = Kx + (size_t)M * D;
    const float* DEC = (const float*)(F.ws + WS_LUP); const float* AIC = DEC + (size_t)M * D;
    float* BON = (float*)(F.ws + WS_BONUS);
    float* CKA = (float*)(F.ws + WS_CKA); float* CKB = (float*)(F.ws + WS_CKB);
    LAS float* F0 = (LAS float*)(lds + CK_F0); LAS float* F1 = (LAS float*)(lds + CK_F1); LAS float* TOT = (LAS float*)(lds + 8 * CK_SLOT);
    const int t = TID >> 3, cg = TID & 7;
    const int seg = TID >> 6, jj = TID & 63;
    const int l15 = LANE & 15, quad = LANE >> 4, rt = WAVE >> 1, ct0 = (WAVE & 1) * 2;
    f32x4 nr[2], nk[2], nw[2], na[2], nv[2], nkk[2], nka[2], nrk[2];
#define CK_FETCH(item_) do { const int pc_ = (item_) >> 6, c_ = (item_) & 63; const size_t base_ = (size_t)((pc_ >> 5) * SEQ + c_ * 64 + t) * D + (pc_ & 31) * 64 + cg * 8; \
        _Pragma("unroll") for (int e = 0; e < 2; ++e) { nr[e] = ld_bf4(R + base_ + 4 * e); nk[e] = ld_bf4(Kx + base_ + 4 * e); nw[e] = *(const f32x4*)(DEC + base_ + 4 * e); \
            na[e] = *(const f32x4*)(AIC + base_ + 4 * e); nv[e] = ld_bf4(V + base_ + 4 * e); \
            const size_t pb_ = (size_t)j * D + (pc_ & 31) * 64 + cg * 8 + 4 * e; nkk[e] = *(const f32x4*)(a.in[I_KK] + pb_); nka[e] = *(const f32x4*)(a.in[I_KA] + pb_); nrk[e] = *(const f32x4*)(a.in[I_RK] + pb_); } } while (0)
    CK_FETCH(BID);
    for (int it = 0; it < 16; ++it) {
        const int item = it * 256 + BID, pc = item >> 6, c = item & 63, b = pc >> 5, h = pc & 31, m0 = b * SEQ + c * 64;
        float kk[8], bb[8], km[8], rr[8], vv[8];
        { const size_t pb = (size_t)j * D + h * 64 + cg * 8;
          float n2 = 0.f, bon = 0.f;
#pragma unroll
          for (int e = 0; e < 2; ++e) {
              const f32x4 r4 = nr[e], k4 = nk[e], w4 = nw[e], a4 = na[e], v4 = nv[e];
              const f32x4 k_k = nkk[e], k_a = nka[e], r_k = nrk[e];
#pragma unroll
              for (int x = 0; x < 4; ++x) { const int i = 4 * e + x; const float kp = k4[x] * k_k[x]; kk[i] = kp; n2 += kp * kp; km[i] = k4[x] * (1.0f + (a4[x] - 1.0f) * k_a[x]); bb[i] = a4[x]; rr[i] = r4[x]; vv[i] = v4[x];
                  bon += r4[x] * km[i] * r_k[x]; F0[t * CK_FP + cg * 8 + i] = __builtin_amdgcn_logf(w4[x]); } }
          n2 = oct_sum(n2); bon = oct_sum(bon);
          const float inv = 1.0f / fmaxf(sqrtf(n2), 1e-12f);
#pragma unroll
          for (int i = 0; i < 8; ++i) { kk[i] *= inv; bb[i] *= kk[i]; }
          if (cg == 0) BON[(size_t)(m0 + t) * 32 + h] = bon; }
        if (it + 1 < 16) CK_FETCH(item + 256);
        CK_BAR();
        float xs[8];
#pragma unroll
        for (int i = 0; i < 8; ++i) { xs[i] = F0[(seg * 8 + i) * CK_FP + jj]; if (i) xs[i] += xs[i - 1]; }
        TOT[seg * 64 + jj] = xs[7];
        CK_BAR();
        { float off = 0.f;
#pragma unroll
          for (int s2 = 0; s2 < 7; ++s2) off += (s2 < seg) ? TOT[s2 * 64 + jj] : 0.f;
#pragma unroll
          for (int i = 0; i < 8; ++i) F0[(seg * 8 + i) * CK_FP + jj] = xs[i] + off; }
        CK_BAR();
        { unsigned pa[4], pbt[4], pk[4], pr[4], pkh[4];
          float av[8], bv[8], kv[8], rv[8], khv[8];
#pragma unroll
          for (int i = 0; i < 8; ++i) { const int col = cg * 8 + i;
              const float lgt = F0[t * CK_FP + col], lgp = t > 0 ? F0[(t - 1) * CK_FP + col] : 0.f, lgL = F0[63 * CK_FP + col];
              const float g = __builtin_amdgcn_exp2f(lgt), gp = __builtin_amdgcn_exp2f(lgp), gi = __builtin_amdgcn_exp2f(-lgt), gh = __builtin_amdgcn_exp2f(lgL - lgt);
              av[i] = -kk[i] * gp; bv[i] = bb[i] * gi; kv[i] = km[i] * gi; rv[i] = rr[i] * g; khv[i] = km[i] * gh;
              F1[t * CK_FP + col] = rv[i];
              *(LAS unsigned short*)(lds + 4 * CK_SLOT + col * CK_OPP + t * 2) = (unsigned short)(cvt_pk_bf16(av[i], 0.f) & 0xffffu);
              *(LAS unsigned short*)(lds + 5 * CK_SLOT + col * CK_OPP + t * 2) = (unsigned short)(cvt_pk_bf16(bb[i] * gh, 0.f) & 0xffffu);
              *(LAS unsigned short*)(lds + 6 * CK_SLOT + col * CK_OPP + t * 2) = (unsigned short)(cvt_pk_bf16(vv[i], 0.f) & 0xffffu); }
#pragma unroll
          for (int i = 0; i < 4; ++i) { pa[i] = cvt_pk_bf16(av[2 * i], av[2 * i + 1]); pbt[i] = cvt_pk_bf16(bv[2 * i], bv[2 * i + 1]); pk[i] = cvt_pk_bf16(kv[2 * i], kv[2 * i + 1]); pr[i] = cvt_pk_bf16(rv[2 * i], rv[2 * i + 1]); pkh[i] = cvt_pk_bf16(khv[2 * i], khv[2 * i + 1]); }
          const int ro = t * CK_OPP + cg * 16;
          *(LAS u32x4*)(lds + 0 * CK_SLOT + ro) = (u32x4){pa[0], pa[1], pa[2], pa[3]}; *(LAS u32x4*)(lds + 1 * CK_SLOT + ro) = (u32x4){pbt[0], pbt[1], pbt[2], pbt[3]};
          *(LAS u32x4*)(lds + 2 * CK_SLOT + ro) = (u32x4){pk[0], pk[1], pk[2], pk[3]}; *(LAS u32x4*)(lds + 3 * CK_SLOT + ro) = (u32x4){pr[0], pr[1], pr[2], pr[3]};
          *(LAS u32x4*)(lds + 7 * CK_SLOT + ro) = (u32x4){pkh[0], pkh[1], pkh[2], pkh[3]}; }
        CK_BAR();
        const f32x4 Z4 = (f32x4){0.f, 0.f, 0.f, 0.f};
        f32x4 TmN[2], TmR[2];
        { f32x4 gabn[2] = {Z4, Z4}, gabt[2] = {Z4, Z4}, gakt[2] = {Z4, Z4}, mbrn[2] = {Z4, Z4}, mkrt[2] = {Z4, Z4};
          ck_mm(lds, 1, 0, rt, ct0, l15, quad, gabn); ck_mm_t(lds, 1, 0, rt, ct0, l15, quad, gabt); ck_mm_t(lds, 2, 0, rt, ct0, l15, quad, gakt); ck_mm(lds, 1, 3, rt, ct0, l15, quad, mbrn); ck_mm_t(lds, 2, 3, rt, ct0, l15, quad, mkrt);
#pragma unroll
          for (int cc = 0; cc < 2; ++cc) { const int ct = ct0 + cc;
#pragma unroll
              for (int g = 0; g < 4; ++g) { const int rown = rt * 16 + quad * 4 + g, coln = ct * 16 + l15, rowt = rt * 16 + l15, colt = ct * 16 + quad * 4 + g;
                  gabn[cc][g] = rown < coln ? gabn[cc][g] : 0.f; mbrn[cc][g] = rown <= coln ? mbrn[cc][g] : 0.f;
                  gabt[cc][g] = rowt < colt ? gabt[cc][g] : 0.f; gakt[cc][g] = rowt < colt ? gakt[cc][g] : 0.f; mkrt[cc][g] = rowt <= colt ? mkrt[cc][g] : 0.f;
                  TmN[cc][g] = gabn[cc][g] + (rown == coln ? 1.0f : 0.f); TmR[cc][g] = gabt[cc][g] + (rowt == colt ? 1.0f : 0.f); }
              ck_st_rm_t(lds, 8, rt, ct, l15, quad, gabt[cc]); ck_st_tr(lds, 9, rt, ct, l15, quad, gabn[cc]); ck_st_rm_t(lds, 10, rt, ct, l15, quad, gakt[cc]);
              ck_st_tr(lds, 11, rt, ct, l15, quad, mbrn[cc]); ck_st_rm_t(lds, 12, rt, ct, l15, quad, mkrt[cc]); ck_st_rm_t(lds, 13, rt, ct, l15, quad, TmR[cc]); } }
        CK_BAR();
        { f32x4 x2n[2] = {Z4, Z4}, x2t[2] = {Z4, Z4};
          ck_mm(lds, 8, 9, rt, ct0, l15, quad, x2n); ck_mm_t(lds, 8, 9, rt, ct0, l15, quad, x2t);
#pragma unroll
          for (int cc = 0; cc < 2; ++cc) { ck_st_rm_t(lds, 0, rt, ct0 + cc, l15, quad, x2t[cc]); ck_st_tr(lds, 1, rt, ct0 + cc, l15, quad, x2n[cc]); } }
        CK_BAR();
#pragma unroll
        for (int k = 0; k < 4; ++k) {
            const int xin = (k & 1) ? 8 : 0, xout = (k & 1) ? 0 : 8, tin = (k & 1) ? 2 : 13, tout = (k & 1) ? 13 : 2;
            f32x4 x2n[2] = {Z4, Z4}, x2t[2] = {Z4, Z4}, tpn[2] = {Z4, Z4}, tpt[2] = {Z4, Z4};
            ck_mm(lds, xin, xin + 1, rt, ct0, l15, quad, x2n); ck_mm_t(lds, xin, xin + 1, rt, ct0, l15, quad, x2t); ck_mm(lds, tin, xin + 1, rt, ct0, l15, quad, tpn); ck_mm_t(lds, tin, xin + 1, rt, ct0, l15, quad, tpt);
#pragma unroll
            for (int cc = 0; cc < 2; ++cc) { TmN[cc] += tpn[cc]; TmR[cc] += tpt[cc];
                ck_st_rm_t(lds, xout, rt, ct0 + cc, l15, quad, x2t[cc]); ck_st_tr(lds, xout + 1, rt, ct0 + cc, l15, quad, x2n[cc]); ck_st_rm_t(lds, tout, rt, ct0 + cc, l15, quad, TmR[cc]); }
            CK_BAR();
        }
        { f32x4 tpn[2] = {Z4, Z4};
          ck_mm(lds, 13, 1, rt, ct0, l15, quad, tpn);
#pragma unroll
          for (int cc = 0; cc < 2; ++cc) { TmN[cc] += tpn[cc]; ck_st_tr(lds, 3, rt, ct0 + cc, l15, quad, TmN[cc]); } }
        CK_BAR();
        { f32x4 w1[2] = {Z4, Z4}, w2[2] = {Z4, Z4};
          ck_mm_t(lds, 4, 3, rt, ct0, l15, quad, w1); ck_mm_t(lds, 10, 3, rt, ct0, l15, quad, w2);
#pragma unroll
          for (int cc = 0; cc < 2; ++cc) { ck_st_rm_t(lds, 8, rt, ct0 + cc, l15, quad, w1[cc]); ck_st_rm_t(lds, 9, rt, ct0 + cc, l15, quad, w2[cc]); } }
        CK_BAR();
        { f32x4 pp[2] = {(f32x4){0.f, 0.f, 0.f, 0.f}, (f32x4){0.f, 0.f, 0.f, 0.f}}, zq[2] = {(f32x4){0.f, 0.f, 0.f, 0.f}, (f32x4){0.f, 0.f, 0.f, 0.f}},
                wh[2] = {(f32x4){0.f, 0.f, 0.f, 0.f}, (f32x4){0.f, 0.f, 0.f, 0.f}}, zy[2] = {(f32x4){0.f, 0.f, 0.f, 0.f}, (f32x4){0.f, 0.f, 0.f, 0.f}};
          ck_mm_t(lds, 8, 5, rt, ct0, l15, quad, pp); ck_mm(lds, 9, 5, rt, ct0, l15, quad, zq); ck_mm_t(lds, 8, 11, rt, ct0, l15, quad, wh); ck_mm(lds, 9, 11, rt, ct0, l15, quad, zy);
          float* gP = CKA + (size_t)item * 8192; float* gW = gP + 4096;
#pragma unroll
          for (int cc = 0; cc < 2; ++cc) { const int ct = ct0 + cc, col = ct * 16 + l15;
              { const int trow = rt * 16 + l15, tcol = ct * 16 + quad * 4;
                f32x4 pv = pp[cc], wv = wh[cc];
#pragma unroll
                for (int g = 0; g < 4; ++g) { pv[g] += (trow == tcol + g) ? __builtin_amdgcn_exp2f(F0[63 * CK_FP + trow]) : 0.f; wv[g] += F1[(tcol + g) * CK_FP + trow]; }
                *(f32x4*)(gP + trow * 64 + tcol) = pv; *(f32x4*)(gW + trow * 64 + tcol) = wv; }
#pragma unroll
              for (int g = 0; g < 4; ++g) { const int row = rt * 16 + quad * 4 + g;
                  zq[cc][g] += bf2f(*(const LAS unsigned short*)(lds + 7 * CK_SLOT + row * CK_OPP + col * 2));
                  zy[cc][g] += bf2f(*(const LAS unsigned short*)(lds + 12 * CK_SLOT + row * CK_OPP + col * 2)); }
              ck_st_tr(lds, 0, rt, ct, l15, quad, zq[cc]); ck_st_tr(lds, 1, rt, ct, l15, quad, zy[cc]); } }
        CK_BAR();
        { f32x4 qq[2] = {(f32x4){0.f, 0.f, 0.f, 0.f}, (f32x4){0.f, 0.f, 0.f, 0.f}}, yl[2] = {(f32x4){0.f, 0.f, 0.f, 0.f}, (f32x4){0.f, 0.f, 0.f, 0.f}};
          ck_mm_t(lds, 6, 0, rt, ct0, l15, quad, qq); ck_mm_t(lds, 6, 1, rt, ct0, l15, quad, yl);
          float* gQ = CKB + (size_t)item * 8192; float* gY = gQ + 4096;
#pragma unroll
          for (int cc = 0; cc < 2; ++cc) { const int o = (rt * 16 + l15) * 64 + (ct0 + cc) * 16 + quad * 4; *(f32x4*)(gQ + o) = qq[cc]; *(f32x4*)(gY + o) = yl[cc]; } }
        CK_BAR();
    }
#undef CK_FETCH
}
__device__ __forceinline__ void phase_ck2(const Frame& F, int j) {
    int tid_ = threadIdx.x; asm volatile("" : "+v"(tid_)); int bid_ = blockIdx.x; asm volatile("" : "+s"(bid_));
    const int LANE = tid_ & 63, WAVE = __builtin_amdgcn_readfirstlane(tid_ >> 6), BID = bid_;
    const float* CKA = (const float*)(F.ws + WS_CKA); const float* CKB = (const float*)(F.ws + WS_CKB);
    float* Y = (float*)(F.ws + WS_Y);
    const int pc = BID & 63, q = BID >> 6, b = pc >> 5, h = pc & 31, mat = WAVE >> 2, ct = WAVE & 3, l15 = LANE & 15, quad = LANE >> 4;
    constexpr int SP = 68;
    LAS float* Sb = (LAS float*)F.lds;
    for (int i = tid_; i < 2 * 16 * SP; i += NTHREADS) Sb[i] = 0.f;
    const float* opB = CKA + (size_t)(pc * 64) * 8192 + mat * 4096 + quad * 64 + ct * 16 + l15;
    const float* opC = CKB + (size_t)(pc * 64) * 8192 + mat * 4096 + (q * 16 + quad * 4) * 64 + ct * 16 + l15;
    float nb[16]; f32x4 nc;
#pragma unroll
    for (int ks = 0; ks < 16; ++ks) nb[ks] = opB[ks * 256];
#pragma unroll
    for (int g = 0; g < 4; ++g) nc[g] = opC[g * 64];
    CK_BAR();
    f32x4 acc = (f32x4){0.f, 0.f, 0.f, 0.f};
    for (int c = 0; c < 64; ++c) {
        float bcur[16];
#pragma unroll
        for (int ks = 0; ks < 16; ++ks) bcur[ks] = nb[ks];
        acc = nc;
        if (c + 1 < 64) {
#pragma unroll
            for (int ks = 0; ks < 16; ++ks) nb[ks] = opB[(size_t)(c + 1) * 8192 + ks * 256];
#pragma unroll
            for (int g = 0; g < 4; ++g) nc[g] = opC[(size_t)(c + 1) * 8192 + g * 64];
        }
        const LAS float* sa = Sb + (c & 1) * 16 * SP + l15 * SP + quad;
        f32x4 acc1 = (f32x4){0.f, 0.f, 0.f, 0.f};
#pragma unroll
        for (int ks = 0; ks < 16; ks += 2) { acc = __builtin_amdgcn_mfma_f32_16x16x4f32(sa[4 * ks], bcur[ks], acc, 0, 0, 0); acc1 = __builtin_amdgcn_mfma_f32_16x16x4f32(sa[4 * ks + 4], bcur[ks + 1], acc1, 0, 0, 0); }
        acc += acc1;
        if (mat == 0) {
            LAS float* sn = Sb + ((c + 1) & 1) * 16 * SP + (quad * 4) * SP + ct * 16 + l15;
#pragma unroll
            for (int g = 0; g < 4; ++g) sn[g * SP] = acc[g];
        } else {
            float* yp = Y + (size_t)(b * SEQ + c * 64 + ct * 16 + l15) * D + h * 64 + q * 16 + quad * 4;
            *(f32x4*)yp = acc;
        }
        CK_BAR();
    }
    if (mat == 0) { float* fo = F.out + O_WKVP + (((size_t)b * 32 + h) * 64 + q * 16 + quad * 4) * 64 + ct * 16 + l15;
#pragma unroll
        for (int g = 0; g < 4; ++g) fo[g * 64] = acc[g]; }
}

__device__ __forceinline__ void phase_rwkvpost(const Frame& F, int j) {
    int tid_ = threadIdx.x; asm volatile("" : "+v"(tid_)); int bid_ = blockIdx.x; asm volatile("" : "+s"(bid_));
    const int TID = tid_, LANE = tid_ & 63, WAVE = __builtin_amdgcn_readfirstlane(tid_ >> 6), BID = bid_; (void)TID; (void)LANE; (void)WAVE; (void)BID;

    const Args& a = *F.a;
    const int gw = BID * NWAVES + WAVE, NGW = gridDim.x * NWAVES;
    const float* Y = (const float*)(F.ws + WS_Y); const bf16_t* V = (const bf16_t*)(F.ws + WS_RKV) + (size_t)2 * M * D; const bf16_t* G = (const bf16_t*)((const float*)(F.ws + WS_LUP) + (size_t)2 * M * D);
    const float* BON = (const float*)(F.ws + WS_BONUS);
    const float* lnw = a.in[I_LNW] + (size_t)j * D; const float* lnb = a.in[I_LNB] + (size_t)j * D;
    for (int m = gw; m < M; m += NGW) {
        f32x4 yv[8]; u32x2 gv[8], vv[8]; float bv[8];
#pragma unroll
        for (int jj = 0; jj < 8; ++jj) { const int col = 4 * (LANE + 64 * jj), head = col >> 6; const size_t off = (size_t)m * D + col;
            yv[jj] = *(const f32x4*)(Y + off); gv[jj] = *(const u32x2*)(G + off); vv[jj] = *(const u32x2*)(V + off); bv[jj] = BON[(size_t)m * 32 + head]; }
#pragma unroll
        for (int jj = 0; jj < 8; ++jj) { const int col = 4 * (LANE + 64 * jj); const size_t off = (size_t)m * D + col;
            const f32x4 y = yv[jj];
            const float mean = row16_sum((y.x + y.y) + (y.z + y.w)) * (1.0f / 64.0f);
            const f32x4 d = y - mean;
            const float var = row16_sum((d.x * d.x + d.y * d.y) + (d.z * d.z + d.w * d.w)) * (1.0f / 64.0f);
            const float rs = 1.0f / sqrtf(var + GN_EPS);
            const f32x4 yn = d * rs * *(const f32x4*)(lnw + col) + *(const f32x4*)(lnb + col);
            const float bon = bv[jj];
            const u32x2 gw2 = gv[jj]; const f32x4 gg = (f32x4){bf2f(gw2.x & 0xffff), bf2f(gw2.x >> 16), bf2f(gw2.y & 0xffff), bf2f(gw2.y >> 16)};
            const u32x2 vw = vv[jj]; const f32x4 v4 = (f32x4){__uint_as_float(vw.x << 16), __uint_as_float(vw.x & 0xffff0000u), __uint_as_float(vw.y << 16), __uint_as_float(vw.y & 0xffff0000u)};
            const f32x4 o = (yn + v4 * bon) * gg;
            u32x2 wv; wv.x = cvt_pk_bf16(o.x, o.y); wv.y = cvt_pk_bf16(o.z, o.w); *(u32x2*)(F.XB + off) = wv; }
    }
}

__global__ void __launch_bounds__(NTHREADS, 2) fwd_kernel(Args args) {
    extern __shared__ __attribute__((aligned(16))) unsigned char lds_raw[];
    Frame F;
    F.lds = (LAS unsigned char*)lds_raw;
    F.a = &args; F.ws = args.ws; F.out = args.out;
    F.X = (float*)(args.ws + WS_X); F.U = (float*)(args.ws + WS_U); F.XB = (bf16_t*)(args.ws + WS_XB);
    volatile LAS unsigned* MISC = (volatile LAS unsigned*)(F.lds + MISC_OFF);
    if (threadIdx.x < 64) MISC[threadIdx.x] = 0u;
    __syncthreads();
    unsigned* ctl = (unsigned*)(args.ws + WS_CTL);
    XcdBarrier bar; bar.bar = ctl + CW_BAR; bar.x = 0; bar.st = nullptr;
    const int lo = args.lo, hi = args.hi;
    const bool use_bar = (hi - lo) > 1;
    if (use_bar) bar = xcd_barrier_post(ctl + CW_BAR, MISC + 8);
    int ph = 0;
#define PHASE(...) do { if (ph >= lo && ph < hi) { { unsigned char* w_ = args.ws; asm volatile("" : "+s"(w_)); F.ws = w_; } __VA_ARGS__; if (ph + 1 < hi) xcd_barrier(bar); } ++ph; } while (0)
    const int G = gridDim.x;
#define c ((int)blockIdx.x)
#define PHASE_R(rep, ...) do { _Pragma("nounroll") for (int r_ = 0; r_ < (rep); ++r_) { PHASE(__VA_ARGS__); } } while (0)
    bf16_t* ACT = (bf16_t*)(F.ws + WS_ACT);

    bf16_t* XR = (bf16_t*)(F.ws + WS_XR);
    for (int l = 0; l < DEPTH; ++l) {
        const int kind = l % 3, j = l / 3, s0 = 3 * l;
        PHASE({ if (kind != 2) phase_convert(F, l, l == 0 ? 0 : 32); if (l == 0) phase_first(F); else phase_samplefold(F, s0, NP_DN); });
        for (int which = 0; which < 2; ++which) {
            if (which == 1) {
                if (kind == 0) {
                    PHASE({ phase_poolprep(F, l, s0 + 1, NP_DN); });
                    PHASE({ g8::Sched<1> S; S.T.init(MP / 256, D / 256, G, c); S.nt = 512 / 64; S.KS = KSE_POOL; S.Ksub = KSUB_POOL; S.A = (const char*)F.XB; S.B = (const char*)(F.ws + WS_WMIX + WM_POOL); S.lda = D; S.ldb = 512;
                            g8::EpiResid E{F.ws, nullptr, 1.0f, (s0 + 2) % 3, 1}; g8::gemm_phase<GEMM_ALIGN, GEMM_SP2, XR_POOL != 0>(F.lds, D, 512, S, E); });
                } else if (kind == 1) {
                    PHASE({ phase_samplefold(F, s0 + 1, NP_DN, true); });
                    PHASE({ g8::Sched<0> S; S.T.init(M / 256, QKVD / 256, G, c); S.nt = D / 64; S.KS = 0; S.Ksub = 0; S.A = (const char*)XR; S.B = (const char*)(F.ws + WS_WMIX + WM_QKV); S.lda = D; S.ldb = D;
                            g8::EpiQKV E{F.ws, args.in[I_ABQKV] + (size_t)j * QKVD, (s0 + 1) % 3}; g8::gemm_phase<GEMM_ALIGN, GEMM_SP2>(F.lds, D, D, S, E);
                            if (l + 1 < DEPTH && (l + 1) % 3 == 2) phase_convert(F, l + 1, QKV_FULL); });
                    PHASE({ phase_attn(F, j); });
                    PHASE({ g8::Sched<0> S; S.T.init(MP / 256, D / 256, G, c); S.nt = D / 64; S.KS = KSE_WO; S.Ksub = KSUB_WO; S.A = (const char*)F.XB; S.B = (const char*)(F.ws + WS_WMIX + WM_AO); S.lda = D; S.ldb = D;
                            g8::EpiResid E{F.ws, args.in[I_ABO] + (size_t)j * D, 1.0f, (s0 + 2) % 3, 1}; g8::gemm_phase<GEMM_ALIGN, GEMM_SP2, XR_WO != 0>(F.lds, D, D, S, E); });
                } else {
                    PHASE({ phase_rwkvmix(F, l, s0 + 1, NP_DN); });
                    PHASE({ g8::Sched<2> S; S.T.init(M / 256, 27, G, c); S.nt = D / 64; S.KS = 0; S.Ksub = 0; S.A = (const char*)(F.ws + WS_MIX6); S.B = (const char*)(F.ws + WS_WMIX2 + WM_RW); S.lda = D; S.ldb = D;
                            g8::EpiRwkv1 E{(float*)(F.ws + WS_RKV), (bf16_t*)(F.ws + WS_HL)}; g8::gemm_phase<GEMM_ALIGN, GEMM_SP2>(F.lds, D, D, S, E); });
                    PHASE({ g8::Sched<3> S; S.T.init((XR_LORA ? MP : M) / 256, 24, G, c); S.nt = 256 / 64;
                            S.KS = 0; S.Ksub = 0; S.A = (const char*)(F.ws + WS_HL); S.B = (const char*)(F.ws + WS_WMIX2 + WM_L2); S.lda = 768; S.ldb = 256;
                            g8::EpiLoraUp E{(float*)(F.ws + WS_LUP), args.in[I_W0] + (size_t)j * D, args.in[I_A0] + (size_t)j * D}; g8::gemm_phase<GEMM_ALIGN, GEMM_SP2, XR_LORA != 0>(F.lds, 768, 256, S, E); });
                    PHASE_R(REP_CK1, { phase_ck1(F, j); });
                    PHASE_R(REP_SCAN, { phase_ck2(F, j); phase_scan(F, j); });
                    PHASE({ phase_rwkvpost(F, j); });
                    PHASE({ g8::Sched<0> S; S.T.init(MP / 256, D / 256, G, c); S.nt = D / 64; S.KS = KSE_WO; S.Ksub = KSUB_WO; S.A = (const char*)F.XB; S.B = (const char*)(F.ws + WS_WMIX2 + WM_RO); S.lda = D; S.ldb = D;
                            g8::EpiResid E{F.ws, nullptr, 1.0f, (s0 + 2) % 3, 1}; g8::gemm_phase<GEMM_ALIGN, GEMM_SP2, XR_WO != 0>(F.lds, D, D, S, E); });
                }
                if (!(kind == 0 ? XR_POOL : XR_WO)) PHASE({ phase_samplefold(F, s0 + 2, kind == 0 ? NP_POOL : NP_WO); });
            }
            const int sin = s0 + (which ? 2 : 0);
            PHASE_R(REP_GU, { g8::Sched<0> S; S.T.init(M / 256, 2 * FF / 256, G, c); S.nt = D / 64; S.KS = 0; S.Ksub = 0; S.A = (const char*)XR; S.B = (const char*)(F.ws + WS_WGU + ((l & 1) * 2 + which) * WGU_BYTES); S.lda = D; S.ldb = D;
                    g8::EpiSwiGLU E{F.ws, sin % 3}; g8::gemm_phase<GEMM_ALIGN, GEMM_SP2>(F.lds, D, D, S, E);
                    if (EARLY_GU > 0 && l + which < DEPTH && (int)blockIdx.x >= GU_FULL) { const bool h0 = l == 0 && which == 0;
                        if (h0) early_convert(F, 0, 0, T_HALF0, T_HALF, GU_FULL);
                        early_convert(F, l + which, 1 - which, 0, h0 ? EARLY_GU0 : EARLY_GU, GU_FULL); } });
            PHASE({ g8::Sched<0> S; S.T.init(MP / 256, D / 256, G, c); S.nt = FF / 64; S.KS = KSE_DN; S.Ksub = KSUB_DN; S.A = (const char*)ACT; S.B = (const char*)(F.ws + WS_WD + ((l & 1) * 2 + which) * WD_BYTES); S.lda = FF; S.ldb = FF;
                    g8::EpiResid E{F.ws, nullptr, 0.5f, (sin + 1) % 3, (which == 0 ? kind == 1 : l + 1 < DEPTH) ? 1 : 0}; g8::gemm_phase<GEMM_ALIGN, GEMM_SP2, XR_DN != 0>(F.lds, FF, FF, S, E);
                    if (EARLY_TILES > EARLY_GU && l + which < DEPTH && (int)blockIdx.x >= DN_FULL) early_convert(F, l + which, 1 - which, (l == 0 && which == 0) ? EARLY_GU0 : EARLY_GU, EARLY_TILES, DN_FULL); });
        }
    }
    PHASE({ phase_final(F, 3 * DEPTH, NP_DN); });
#undef PHASE
#undef PHASE_R
#undef c
}

static int count_phases() { int n = 0; for (int l = 0; l < DEPTH; ++l) { const int kind = l % 3; n += 1 + 2 * (REP_GU + 1) + ((kind == 0 ? XR_POOL : XR_WO) ? 0 : 1) + (kind == 0 ? 2 : kind == 1 ? 4 : 5 + REP_SCAN + REP_CK1); } return n + 1; }
extern "C" void kernel_launch(void* const* d_in, const int* in_sizes, int n_in, void* d_out, int out_size, void* d_ws, size_t ws_size, hipStream_t stream) {
    static int ready = 0;
    if (ready == 0) {
        ready = -1;
        if (n_in != 40 || (size_t)out_size != O_END || ws_size < WS_END) { fprintf(stderr, "kernel_launch: unexpected shapes: n_in %d out %d (want %zu) ws %zu (need %zu)\n", n_in, out_size, (size_t)O_END, ws_size, (size_t)WS_END); return; }
        int dev = 0, cus = 0, per_cu = 0;
        if (hipGetDevice(&dev) != hipSuccess || hipDeviceGetAttribute(&cus, hipDeviceAttributeMultiprocessorCount, dev) != hipSuccess) { fprintf(stderr, "kernel_launch: device query failed\n"); return; }
        if (hipFuncSetAttribute((const void*)fwd_kernel, hipFuncAttributeMaxDynamicSharedMemorySize, LDS_BYTES) != hipSuccess) { fprintf(stderr, "kernel_launch: hipFuncSetAttribute failed\n"); return; }
        if (hipOccupancyMaxActiveBlocksPerMultiprocessor(&per_cu, (const void*)fwd_kernel, NTHREADS, LDS_BYTES) != hipSuccess || per_cu < 1) fprintf(stderr, "kernel_launch: occupancy query says %d blocks per CU\n", per_cu);
        (void)hipGetLastError();
        if (cus < GRID) { fprintf(stderr, "kernel_launch: needs %d CUs, device has %d\n", GRID, cus); return; }
        ready = 1;
    }
    if (ready < 0) return;
    (void)hipMemsetAsync((char*)d_ws + WS_CTL, 0, CTL_ZERO_BYTES, stream);
    Args a{};
    for (int i = 0; i < 40; ++i) a.in[i] = (const float*)d_in[i];
    a.out = (float*)d_out; a.ws = (unsigned char*)d_ws;
    const int NPH = count_phases();
#if N_LAUNCH_MODE == 1
    for (int p = 0; p < NPH; ++p) { a.lo = p; a.hi = p + 1; hipLaunchKernelGGL(fwd_kernel, dim3(GRID), dim3(NTHREADS), LDS_BYTES, stream, a); }
#else
    a.lo = 0; a.hi = NPH; hipLaunchKernelGGL(fwd_kernel, dim3(GRID), dim3(NTHREADS), LDS_BYTES, stream, a);
#endif
    const hipError_t le = hipPeekAtLastError();
    if (le != hipSuccess) fprintf(stderr, "kernel_launch: launch failed: %s\n", hipGetErrorName(le));
}
```
